# Optimizing an MI355X kernel written in HIP

```python
import math
import jax, jax.numpy as jnp
from jax import lax
import numpy as np

D_MODEL = 2048
BATCH = 8
SEQ = 4096
DEPTH = 2

ROPE_THETA = 10000.0
NORM_EPS = 1e-6
MASK_VALUE = -1e30
FORCE_SCORE = 1e6
BAND_BLOCK = 128
N_BRANCHES = 3

NSA_HEADS = 8
NSA_KV_HEADS = 2
NSA_HEAD_DIM = 128
NSA_N_BRANCH = 3
NSA_CMP_STRIDE = 16
NSA_CMP_LEN = 2 * NSA_CMP_STRIDE
NSA_CMP_HIDDEN = 256
NSA_SLC_BLOCK = 64
NSA_SLC_TOPK = 16
NSA_SLC_Q_BLOCK = 32
NSA_WINDOW = 512

SSM_D_INNER = D_MODEL // 2
SSM_HEAD_DIM = 64
SSM_HEADS = SSM_D_INNER // SSM_HEAD_DIM
SSM_GROUPS = 2
SSM_D_STATE = 128
SSM_CONV = 4
SSM_CHUNK = 128

SWA_HEADS = 16
SWA_KV_HEADS = 2
SWA_HEAD_DIM = 64
SWA_WINDOW = 128

MOE_GROUPS = 4
MOE_EXPERTS_PER_GROUP = 8
MOE_TOPK = 2
MOE_D_FF = 512

NSA_Q_DIM = NSA_HEADS * NSA_HEAD_DIM
NSA_KV_DIM = NSA_N_BRANCH * 2 * NSA_KV_HEADS * NSA_HEAD_DIM
NSA_GATE_DIM = NSA_HEADS * NSA_N_BRANCH
SSM_CONV_DIM = SSM_D_INNER + 2 * SSM_GROUPS * SSM_D_STATE
SWA_Q_DIM = SWA_HEADS * SWA_HEAD_DIM
SWA_KV_DIM = 2 * SWA_KV_HEADS * SWA_HEAD_DIM
IN_SPLITS = (NSA_Q_DIM, NSA_KV_DIM, NSA_GATE_DIM, SSM_D_INNER, SSM_CONV_DIM, SSM_HEADS,
             SWA_Q_DIM, SWA_KV_DIM, N_BRANCHES * D_MODEL)
IN_DIM = sum(IN_SPLITS)

kernel_name = 'hybrid_nsa_ssd_swa_hmoe'


def rmsnorm(x, w):
    xf = x.astype(jnp.float32)
    y = xf * lax.rsqrt(jnp.mean(xf * xf, axis=-1, keepdims=True) + NORM_EPS)
    return (y * w.astype(jnp.float32)).astype(x.dtype)


def rope_tables(seq, dim):
    inv = 1.0 / (ROPE_THETA ** (jnp.arange(0, dim, 2, dtype=jnp.float32) / dim))
    ang = jnp.arange(seq, dtype=jnp.float32)[:, None] * inv[None, :]
    return jnp.cos(ang), jnp.sin(ang)


def apply_rope(x, cos, sin):
    half = x.shape[-1] // 2
    shape = (1, x.shape[1]) + (1,) * (x.ndim - 3) + (half,)
    c, s = cos.reshape(shape), sin.reshape(shape)
    xf = x.astype(jnp.float32)
    x1, x2 = xf[..., :half], xf[..., half:]
    return jnp.concatenate([x1 * c - x2 * s, x2 * c + x1 * s], axis=-1).astype(x.dtype)


def banded_attention(q, k, v, window, sinks=None):
    B, S, G, R, dh = q.shape
    nb = S // BAND_BLOCK
    span = window + BAND_BLOCK
    pad = ((0, 0), (window, 0), (0, 0), (0, 0))
    kp, vp = jnp.pad(k, pad), jnp.pad(v, pad)
    scale = dh ** -0.5
    oq = jnp.arange(BAND_BLOCK)
    ok = jnp.arange(span)
    diff = (oq[:, None] + window) - ok[None, :]

    def block(b):
        start = b * BAND_BLOCK
        qb = lax.dynamic_slice_in_dim(q, start, BAND_BLOCK, axis=1)
        kb = lax.dynamic_slice_in_dim(kp, start, span, axis=1)
        vb = lax.dynamic_slice_in_dim(vp, start, span, axis=1)
        s = jnp.einsum('bqgrd,bkgd->bgrqk', qb, kb).astype(jnp.float32) * scale
        kpos = start - window + ok
        mask = (diff >= 0) & (diff < window) & (kpos[None, :] >= 0)
        s = jnp.where(mask, s, MASK_VALUE)
        if sinks is None:
            p = jax.nn.softmax(s, axis=-1)
        else:
            sk = sinks.astype(jnp.float32)[None, :, :, None, None]
            m = jnp.maximum(jnp.max(s, axis=-1, keepdims=True), sk)
            e = jnp.exp(s - m)
            p = e / (jnp.sum(e, axis=-1, keepdims=True) + jnp.exp(sk - m))
        return jnp.einsum('bgrqk,bkgd->bqgrd', p.astype(vb.dtype), vb)

    out = lax.map(block, jnp.arange(nb))
    return jnp.moveaxis(out, 0, 1).reshape(B, S, G, R, dh)


def nsa_mixer(q_cols, kv_cols, gate_cols, cos, sin, cmp_pos, cmp_w1, cmp_b1, cmp_w2):
    B, S, _ = q_cols.shape
    G = NSA_KV_HEADS
    R = NSA_HEADS // G
    dh = NSA_HEAD_DIM
    scale = dh ** -0.5
    q = q_cols.reshape(B, S, G, R, dh)
    kv = kv_cols.reshape(B, S, NSA_N_BRANCH, 2, G, dh)
    pos = jnp.arange(S)

    n_chunk = S // NSA_CMP_STRIDE
    n_cmp = n_chunk - 1
    kvc = jnp.moveaxis(kv[:, :, 0], 2, 0).reshape(2, B, n_chunk, NSA_CMP_STRIDE, G, dh)
    blocks = jnp.concatenate([kvc[:, :, :-1], kvc[:, :, 1:]], axis=3) + cmp_pos[:, None, None, :, None, :]
    flat = jnp.moveaxis(blocks, 4, 3).reshape(2, B, n_cmp, G, NSA_CMP_LEN * dh)
    hid = jax.nn.silu(jnp.einsum('cbngi,cih->cbngh', flat, cmp_w1) + cmp_b1[:, None, None, None, :])
    comp = jnp.einsum('cbngh,chd->cbngd', hid, cmp_w2)
    k_cmp, v_cmp = comp[0], comp[1]
    cmp_start = jnp.arange(n_cmp) * NSA_CMP_STRIDE
    cmp_end = cmp_start + NSA_CMP_LEN - 1
    vis = cmp_end[None, :] <= pos[:, None]
    s = jnp.einsum('bsgrd,bngd->bgrsn', q, k_cmp).astype(jnp.float32) * scale
    p_cmp = jax.nn.softmax(jnp.where(vis, s, MASK_VALUE), axis=-1) * vis
    o_cmp = jnp.einsum('bgrsn,bngd->bsgrd', p_cmp.astype(v_cmp.dtype), v_cmp)

    n_sel = S // NSA_SLC_BLOCK
    sel_start = jnp.arange(n_sel) * NSA_SLC_BLOCK
    overlap = ((cmp_start[:, None] <= sel_start[None, :] + NSA_SLC_BLOCK - 1)
               & (cmp_end[:, None] >= sel_start[None, :])).astype(jnp.float32)
    imp = jnp.einsum('bgrsn,nj->bgsj', p_cmp, overlap)
    q_blk = pos // NSA_SLC_BLOCK
    jj = jnp.arange(n_sel)
    causal_blk = sel_start[None, :] <= pos[:, None]
    forced = (jj[None, :] == 0) | (jj[None, :] == q_blk[:, None]) | (jj[None, :] == q_blk[:, None] - 1)
    imp = jnp.where(causal_blk, imp, MASK_VALUE)
    imp = jnp.where(forced, FORCE_SCORE, imp)
    topk = min(NSA_SLC_TOPK, n_sel)
    _, idx = lax.top_k(imp, topk)

    q_r = apply_rope(q, cos, sin)
    k_slc = apply_rope(kv[:, :, 1, 0], cos, sin)
    k_win = apply_rope(kv[:, :, 2, 0], cos, sin)
    kb = k_slc.reshape(B, n_sel, NSA_SLC_BLOCK, G, dh).transpose(0, 3, 1, 2, 4)
    vb = kv[:, :, 1, 1].reshape(B, n_sel, NSA_SLC_BLOCK, G, dh).transpose(0, 3, 1, 2, 4)
    gather = jax.vmap(jax.vmap(lambda a, i: a[i]))
    Qc = NSA_SLC_Q_BLOCK
    in_blk = jnp.arange(NSA_SLC_BLOCK)

    def slc_block(c):
        start = c * Qc
        qc = lax.dynamic_slice_in_dim(q_r, start, Qc, axis=1)
        ic = lax.dynamic_slice_in_dim(idx, start, Qc, axis=2)
        kg = gather(kb, ic)
        vg = gather(vb, ic)
        sc = jnp.einsum('bqgrd,bgqkjd->bgrqkj', qc, kg).astype(jnp.float32) * scale
        kpos = ic[..., None] * NSA_SLC_BLOCK + in_blk
        qpos = start + jnp.arange(Qc)
        m = kpos <= qpos[None, None, :, None, None]
        sc = jnp.where(m[:, :, None], sc, MASK_VALUE)
        p = jax.nn.softmax(sc.reshape(sc.shape[:4] + (-1,)), axis=-1).reshape(sc.shape)
        return jnp.einsum('bgrqkj,bgqkjd->bqgrd', p.astype(vg.dtype), vg)

    o_slc = lax.map(slc_block, jnp.arange(S // Qc))
    o_slc = jnp.moveaxis(o_slc, 0, 1).reshape(B, S, G, R, dh)

    o_win = banded_attention(q_r, k_win, kv[:, :, 2, 1], NSA_WINDOW)

    g = jax.nn.sigmoid(gate_cols.astype(jnp.float32)).astype(q.dtype).reshape(B, S, G, R, NSA_N_BRANCH)
    o = g[..., 0:1] * o_cmp + g[..., 1:2] * o_slc + g[..., 2:3] * o_win
    return o.reshape(B, S, NSA_Q_DIM)


def ssd_mixer(z, xbc, dt, conv_w, conv_b, dt_bias, a_log, d_skip, norm_w):
    B, S, _ = z.shape
    C = xbc.shape[-1]
    xbc = lax.conv_general_dilated(xbc, conv_w[:, None, :], window_strides=(1,),
                                   padding=[(SSM_CONV - 1, 0)],
                                   dimension_numbers=('NWC', 'WIO', 'NWC'),
                                   feature_group_count=C) + conv_b
    xbc = jax.nn.silu(xbc)
    G, N, P, L = SSM_GROUPS, SSM_D_STATE, SSM_HEAD_DIM, SSM_CHUNK
    R = SSM_HEADS // G
    nc = S // L
    xs = xbc[..., :SSM_D_INNER].reshape(B, S, G, R, P).astype(jnp.float32)
    Bm = xbc[..., SSM_D_INNER:SSM_D_INNER + G * N].reshape(B, nc, L, G, N).astype(jnp.float32)
    Cm = xbc[..., SSM_D_INNER + G * N:].reshape(B, nc, L, G, N).astype(jnp.float32)
    dt = jax.nn.softplus(dt.astype(jnp.float32) + dt_bias.astype(jnp.float32)).reshape(B, S, G, R)
    A = -jnp.exp(a_log.astype(jnp.float32)).reshape(G, R)
    X = (xs * dt[..., None]).reshape(B, nc, L, G, R, P)
    a_cs = jnp.cumsum((dt * A).reshape(B, nc, L, G, R), axis=2)

    seg = a_cs[:, :, :, None] - a_cs[:, :, None, :]
    causal = jnp.tril(jnp.ones((L, L), dtype=bool))[None, None, :, :, None, None]
    decay = jnp.exp(jnp.where(causal, seg, -jnp.inf))
    cb = jnp.einsum('bclgn,bcsgn->bclsg', Cm, Bm)
    y_diag = jnp.einsum('bclsg,bclsgr,bcsgrp->bclgrp', cb, decay, X)

    decay_to_end = jnp.exp(a_cs[:, :, -1:] - a_cs)
    states = jnp.einsum('bclgn,bclgr,bclgrp->bcgrpn', Bm, decay_to_end, X)
    chunk_decay = jnp.exp(a_cs[:, :, -1])

    def step(h, inp):
        st, dec = inp
        return h * dec[..., None, None] + st, h

    h0 = jnp.zeros((B, G, R, P, N), jnp.float32)
    _, h_in = lax.scan(step, h0, (jnp.moveaxis(states, 1, 0), jnp.moveaxis(chunk_decay, 1, 0)))
    h_in = jnp.moveaxis(h_in, 0, 1)
    y_off = jnp.einsum('bclgn,bcgrpn,bclgr->bclgrp', Cm, h_in, jnp.exp(a_cs))

    y = (y_diag + y_off).reshape(B, S, G, R, P) + xs * d_skip.astype(jnp.float32).reshape(G, R)[..., None]
    y = y.reshape(B, S, SSM_D_INNER) * jax.nn.silu(z.astype(jnp.float32))
    yg = y.reshape(B, S, G, -1)
    yg = yg * lax.rsqrt(jnp.mean(yg * yg, axis=-1, keepdims=True) + NORM_EPS)
    y = yg.reshape(B, S, SSM_D_INNER) * norm_w.astype(jnp.float32)
    return y.astype(z.dtype)


def swa_mixer(q_cols, kv_cols, cos, sin, sinks):
    B, S, _ = q_cols.shape
    G = SWA_KV_HEADS
    R = SWA_HEADS // G
    dh = SWA_HEAD_DIM
    q = apply_rope(q_cols.reshape(B, S, SWA_HEADS, dh), cos, sin).reshape(B, S, G, R, dh)
    kv = kv_cols.reshape(B, S, 2, G, dh)
    k = apply_rope(kv[:, :, 0], cos, sin)
    o = banded_attention(q, k, kv[:, :, 1], SWA_WINDOW, sinks.reshape(G, R))
    return o.reshape(B, S, SWA_Q_DIM)


def mixer_block(h, cos_a, sin_a, cos_c, sin_c, w_in, nsa_cmp_pos, nsa_cmp_w1, nsa_cmp_b1, nsa_cmp_w2,
                ssm_conv_w, ssm_conv_b, ssm_dt_bias, ssm_a_log, ssm_d, ssm_norm, swa_sinks,
                proj_nsa, proj_ssm, proj_swa, w_out):
    B, S, D = h.shape
    u = h @ w_in
    (nsa_q, nsa_kv, nsa_g, ssm_z, ssm_xbc, ssm_dt, swa_q, swa_kv, merge_g) = jnp.split(
        u, np.cumsum(IN_SPLITS)[:-1].tolist(), axis=-1)
    o_a = nsa_mixer(nsa_q, nsa_kv, nsa_g, cos_a, sin_a, nsa_cmp_pos, nsa_cmp_w1, nsa_cmp_b1, nsa_cmp_w2)
    o_b = ssd_mixer(ssm_z, ssm_xbc, ssm_dt, ssm_conv_w, ssm_conv_b, ssm_dt_bias, ssm_a_log, ssm_d, ssm_norm)
    o_c = swa_mixer(swa_q, swa_kv, cos_c, sin_c, swa_sinks)
    gate = jax.nn.sigmoid(merge_g.astype(jnp.float32)).astype(h.dtype).reshape(B, S, N_BRANCHES, D)
    y = gate[:, :, 0] * (o_a @ proj_nsa) + gate[:, :, 1] * (o_b @ proj_ssm) + gate[:, :, 2] * (o_c @ proj_swa)
    return y @ w_out


def hier_moe(h, group_router, group_bias, expert_router, expert_bias, w_gate, w_up, w_down):
    B, S, D = h.shape
    t = h.reshape(-1, D)
    g_prob = jax.nn.softmax((t @ group_router).astype(jnp.float32) + group_bias.astype(jnp.float32), axis=-1)
    g_w, g_idx = lax.top_k(g_prob, 1)
    g_onehot = jax.nn.one_hot(g_idx[:, 0], MOE_GROUPS, dtype=jnp.float32)
    e_logits = ((t @ expert_router).astype(jnp.float32) + expert_bias.astype(jnp.float32)).reshape(
        -1, MOE_GROUPS, MOE_EXPERTS_PER_GROUP)
    e_sel = jnp.sum(e_logits * g_onehot[:, :, None], axis=1)
    e_val, e_idx = lax.top_k(e_sel, MOE_TOPK)
    e_w = jax.nn.softmax(e_val, axis=-1)
    in_group = jnp.sum(e_w[..., None] * jax.nn.one_hot(e_idx, MOE_EXPERTS_PER_GROUP, dtype=jnp.float32), axis=1)
    comb = g_onehot[:, :, None] * (g_w * in_group)[:, None, :]
    out = jnp.zeros(t.shape, jnp.float32)
    for g in range(MOE_GROUPS):
        hg = jax.nn.silu(jnp.einsum('td,edf->tef', t, w_gate[g])) * jnp.einsum('td,edf->tef', t, w_up[g])
        hg = hg * comb[:, g, :, None].astype(hg.dtype)
        out = out + jnp.einsum('tef,efd->td', hg, w_down[g]).astype(jnp.float32)
    return out.astype(h.dtype).reshape(B, S, D)


def setup_inputs(seed: int = 0) -> dict:
    key = jax.random.key(seed)
    k = jax.random.split(key, 27)
    f32 = jnp.float32
    L = DEPTH
    NE = MOE_EXPERTS_PER_GROUP

    def nrm(kk, shape, scale):
        return jax.random.normal(kk, shape, f32) * scale

    dt = jnp.exp(jax.random.uniform(k[10], (L, SSM_HEADS), f32, math.log(1e-3), math.log(1e-1)))
    return {
        'x': nrm(k[0], (BATCH, SEQ, D_MODEL), 1.0),
        'norm_mix': 1.0 + nrm(k[1], (L, D_MODEL), 0.05),
        'norm_ffn': 1.0 + nrm(k[2], (L, D_MODEL), 0.05),
        'w_in': nrm(k[3], (L, D_MODEL, IN_DIM), D_MODEL ** -0.5),
        'nsa_cmp_pos': nrm(k[4], (L, 2, NSA_CMP_LEN, NSA_HEAD_DIM), 0.1),
        'nsa_cmp_w1': nrm(k[5], (L, 2, NSA_CMP_LEN * NSA_HEAD_DIM, NSA_CMP_HIDDEN), (NSA_CMP_LEN * NSA_HEAD_DIM) ** -0.5),
        'nsa_cmp_b1': nrm(k[6], (L, 2, NSA_CMP_HIDDEN), 0.01),
        'nsa_cmp_w2': nrm(k[7], (L, 2, NSA_CMP_HIDDEN, NSA_HEAD_DIM), NSA_CMP_HIDDEN ** -0.5),
        'ssm_conv_w': nrm(k[8], (L, SSM_CONV, SSM_CONV_DIM), SSM_CONV ** -0.5),
        'ssm_conv_b': nrm(k[9], (L, SSM_CONV_DIM), 0.01),
        'ssm_dt_bias': dt + jnp.log(-jnp.expm1(-dt)),
        'ssm_a_log': jnp.log(jax.random.uniform(k[11], (L, SSM_HEADS), f32, 1.0, 16.0)),
        'ssm_d': 1.0 + nrm(k[12], (L, SSM_HEADS), 0.1),
        'ssm_norm': 1.0 + nrm(k[13], (L, SSM_D_INNER), 0.05),
        'swa_sinks': nrm(k[14], (L, SWA_HEADS), 0.5),
        'proj_nsa': nrm(k[15], (L, NSA_Q_DIM, D_MODEL), NSA_Q_DIM ** -0.5),
        'proj_ssm': nrm(k[16], (L, SSM_D_INNER, D_MODEL), SSM_D_INNER ** -0.5),
        'proj_swa': nrm(k[17], (L, SWA_Q_DIM, D_MODEL), SWA_Q_DIM ** -0.5),
        'w_out': nrm(k[18], (L, D_MODEL, D_MODEL), D_MODEL ** -0.5),
        'moe_group_router': nrm(k[19], (L, D_MODEL, MOE_GROUPS), D_MODEL ** -0.5),
        'moe_group_bias': nrm(k[20], (L, MOE_GROUPS), 0.01),
        'moe_expert_router': nrm(k[21], (L, D_MODEL, MOE_GROUPS * NE), D_MODEL ** -0.5),
        'moe_expert_bias': nrm(k[22], (L, MOE_GROUPS * NE), 0.01),
        'moe_w_gate': nrm(k[23], (L, MOE_GROUPS, NE, D_MODEL, MOE_D_FF), D_MODEL ** -0.5),
        'moe_w_up': nrm(k[24], (L, MOE_GROUPS, NE, D_MODEL, MOE_D_FF), D_MODEL ** -0.5),
        'moe_w_down': nrm(k[25], (L, MOE_GROUPS, NE, MOE_D_FF, D_MODEL), MOE_D_FF ** -0.5),
        'final_norm': 1.0 + nrm(k[26], (D_MODEL,), 0.05),
    }


def reference(x, norm_mix, norm_ffn, w_in, nsa_cmp_pos, nsa_cmp_w1, nsa_cmp_b1, nsa_cmp_w2,
              ssm_conv_w, ssm_conv_b, ssm_dt_bias, ssm_a_log, ssm_d, ssm_norm, swa_sinks,
              proj_nsa, proj_ssm, proj_swa, w_out, moe_group_router, moe_group_bias,
              moe_expert_router, moe_expert_bias, moe_w_gate, moe_w_up, moe_w_down, final_norm):
    S = x.shape[1]
    cos_a, sin_a = rope_tables(S, NSA_HEAD_DIM)
    cos_c, sin_c = rope_tables(S, SWA_HEAD_DIM)
    for l in range(DEPTH):
        h = rmsnorm(x, norm_mix[l])
        x = x + mixer_block(h, cos_a, sin_a, cos_c, sin_c, w_in[l], nsa_cmp_pos[l], nsa_cmp_w1[l],
                            nsa_cmp_b1[l], nsa_cmp_w2[l], ssm_conv_w[l], ssm_conv_b[l], ssm_dt_bias[l],
                            ssm_a_log[l], ssm_d[l], ssm_norm[l], swa_sinks[l], proj_nsa[l], proj_ssm[l],
                            proj_swa[l], w_out[l])
        h = rmsnorm(x, norm_ffn[l])
        x = x + hier_moe(h, moe_group_router[l], moe_group_bias[l], moe_expert_router[l],
                         moe_expert_bias[l], moe_w_gate[l], moe_w_up[l], moe_w_down[l])
    return rmsnorm(x, final_norm)
```

```cpp
#include <hip/hip_runtime.h>
#include <cstdio>
#include <cstdint>
#include <cstring>
namespace pg8 {
#define PG8_LAS __attribute__((address_space(3)))
typedef unsigned short bf16_t;
typedef short bf16x8 __attribute__((ext_vector_type(8)));
typedef float f32x4 __attribute__((ext_vector_type(4)));
typedef unsigned u32x4 __attribute__((ext_vector_type(4)));
typedef unsigned u32x2 __attribute__((ext_vector_type(2)));
constexpr int BM = 256, BK = 64, HALF = 128, HTB = HALF * BK * 2  , STAGE_BYTES = 8 * HTB, NXCD = 8, WGM = 4;

__host__ __device__ __forceinline__ int lds_byte(int r, int c) { const int st = (r >> 4) * 2 + (c >> 5), rr = r & 15, cc = c & 31, ob = rr * 64 + cc * 2; return st * 1024 + (ob ^ (((ob >> 9) & 1) << 5)); }
__host__ __device__ __forceinline__ void stage_rc(int b, int& R, int& C) { const int st = b / 1024, sb = b % 1024, swz = sb ^ (((sb >> 9) & 1) << 5); R = (st >> 1) * 16 + swz / 64; C = (st & 1) * 32 + (swz % 64) / 2; }
__host__ __device__ __forceinline__ int perm32(int rho) { const int n = rho >> 4, i = rho & 15; return 8 * (i >> 2) + 4 * n + (i & 3); }

struct Unit { int pm, pn; };
struct Gemm { const bf16_t* A; const bf16_t* Bt; int M, N, K, lda, ldb; };

struct StaticOrder {
    int nM, nN, nwg, G, c;
    __host__ __device__ void init(int M, int N, int G_, int c_) { nM = M / BM; nN = N / BM; nwg = nM * nN; G = G_; c = c_; }
    __host__ __device__ void tile(long L, Unit& u) const {
        int wgid = (int)L; { const int q = nwg / NXCD, r = nwg % NXCD, xcd = wgid % NXCD, off = wgid / NXCD; wgid = (xcd < r ? xcd * (q + 1) : r * (q + 1) + (xcd - r) * q) + off; }
        const int nig = WGM * nN, gid = wgid / nig, fm = gid * WGM, gsz = (nM - fm) < WGM ? (nM - fm) : WGM;
        u.pm = fm + ((wgid % nig) % gsz); u.pn = (wgid % nig) / gsz; }
    __host__ __device__ bool next(int i, Unit& u) const { const long L = (long)i * G + c; if (L >= nwg) return false; tile(L, u); return true; }
    __device__ __forceinline__ unsigned row_off(const Unit&, int) const { return 0u; }
    __device__ __forceinline__ void a_ready(const Unit&) const {}
    __device__ __forceinline__ void done(const Unit&) const {}
};
struct UnevenOrder : StaticOrder {
    int kHi, kLo;
    __device__ bool next(int i, Unit& u) const { const int hG = G >> 1; long L;
        if (c >= hG) { if (i >= kHi) return false; L = (long)i * hG + (c - hG); } else { if (i >= kLo) return false; L = (long)kHi * hG + (long)i * hG + c; }
        if (L >= nwg) return false; tile(L, u); return true; }
};
struct PlainOrder {
    int nM, nN, G, c;
    __device__ void init(int M, int N, int G_, int c_) { nM = M / BM; nN = N / BM; G = G_; c = c_; }
    __device__ bool next(int i, Unit& u) const { const long L = (long)i * G + c; if (c < 0 || L >= (long)nM * nN) return false; u.pm = (int)(L % nM); u.pn = (int)(L / nM); return true; }
    __device__ __forceinline__ unsigned row_off(const Unit&, int) const { return 0u; }
    __device__ __forceinline__ void a_ready(const Unit&) const {}
    __device__ __forceinline__ void done(const Unit&) const {}
};
template <int NT> struct GroupedOrder {
    const PG8_LAS int* tab; const int* list; int cap, ldab, G, c;
    __device__ bool next(int i, Unit& u) const { const long L = (long)i * G + c; const int npan = tab[128]; if (L >= (long)npan * NT) return false; const int p = (int)(L / NT), t = (int)(L % NT); u.pm = p; u.pn = __builtin_amdgcn_readfirstlane(tab[192 + p]) * NT + t; return true; }
    __device__ __forceinline__ unsigned row_off(const Unit& u, int r) const { const int e = u.pn / NT, pos = u.pm * BM + r - tab[e]; const int tk = pos < tab[64 + e] ? list[(size_t)e * cap + pos] : 0; return (unsigned)tk * (unsigned)ldab; }
    __device__ __forceinline__ void a_ready(const Unit&) const {}
    __device__ __forceinline__ void done(const Unit&) const {}
};

typedef float f32x2_cv __attribute__((ext_vector_type(2)));
typedef __bf16 bf16x2_cv __attribute__((ext_vector_type(2)));
__device__ __forceinline__ unsigned cvt_pk_bf16(float lo, float hi) { const f32x2_cv v = {lo, hi}; const bf16x2_cv b = __builtin_convertvector(v, bf16x2_cv); return __builtin_bit_cast(unsigned, b); }
__device__ __forceinline__ float bflo(unsigned w) { return __uint_as_float(w << 16); }
__device__ __forceinline__ float bfhi(unsigned w) { return __uint_as_float(w & 0xffff0000u); }
__device__ __forceinline__ float sigm(float x) { return __builtin_amdgcn_rcpf(1.0f + __builtin_amdgcn_exp2f(x * -1.4426950408889634f)); }

typedef float f32x2 __attribute__((ext_vector_type(2)));
typedef int v8i_t __attribute__((ext_vector_type(8)));
typedef int v4i_t __attribute__((ext_vector_type(4)));
__host__ __device__ __forceinline__ int sw16(int x) { return (x & ~12) | ((x & 4) << 1) | ((x & 8) >> 1); }
__device__ __forceinline__ u32x4 pack8(const f32x4 v0, const f32x4 v1) { u32x4 w; w.x = cvt_pk_bf16(v0[0], v0[1]); w.y = cvt_pk_bf16(v0[2], v0[3]); w.z = cvt_pk_bf16(v1[0], v1[1]); w.w = cvt_pk_bf16(v1[2], v1[3]); return w; }

struct EpiIn {
    static constexpr bool PERM = true, AFTER_DRAIN = false;
    bf16_t* U; int up; bf16_t* KVC; size_t kvc_cstride; float* SM; bf16_t* VTS; bf16_t* VTW; bf16_t* VTC;
    __device__ __forceinline__ void operator()(const f32x4 (&acc)[2][2][4][2], const Unit& u, int wr, int wc, int fr, int fq) const {
        const int row0 = u.pm * BM + wr * 64 + fr; const int pn = u.pn;
        if (pn == 25) {
            if (wc < 2) {
#pragma unroll
                for (int ai = 0; ai < 2; ++ai)
#pragma unroll
                    for (int m = 0; m < 4; ++m) { float* rp = SM + (size_t)(row0 + ai * HALF + m * 16) * 64 + wc * 32 + 8 * fq;
                        *(f32x4*)(rp) = acc[ai][0][m][0]; *(f32x4*)(rp + 4) = acc[ai][0][m][1]; }
            }
            return;
        }
        if (pn == 4 || pn == 5) {
            bf16_t* base = KVC + (size_t)(pn - 4) * kvc_cstride;
#pragma unroll
            for (int ai = 0; ai < 2; ++ai)
#pragma unroll
                for (int m = 0; m < 4; ++m) { const int row = row0 + ai * HALF + m * 16; const int b = row >> 12, s = row & 4095;
#pragma unroll
                    for (int bj = 0; bj < 2; ++bj) { bf16_t* p = base + ((size_t)((b * 2 + bj) * 4096 + s)) * 128 + wc * 32 + 8 * fq;
                        *(u32x4*)p = pack8(acc[ai][bj][m][0], acc[ai][bj][m][1]); } }
            return;
        }
        if (pn == 7 || pn == 9) {
            bf16_t* vt = pn == 7 ? VTS : VTW;
#pragma unroll
            for (int ai = 0; ai < 2; ++ai)
#pragma unroll
                for (int m = 0; m < 4; ++m) { const int row = row0 + ai * HALF + m * 16; const int b = row >> 12, s = row & 4095;
#pragma unroll
                    for (int bj = 0; bj < 2; ++bj) { bf16_t* p = vt + ((size_t)((b * 2 + bj) * 128 + wc * 32 + 8 * fq)) * 4096 + sw16(s); const u32x4 w = pack8(acc[ai][bj][m][0], acc[ai][bj][m][1]);
                        p[0] = (bf16_t)(w.x & 0xffffu); p[4096] = (bf16_t)(w.x >> 16); p[2 * 4096] = (bf16_t)(w.y & 0xffffu); p[3 * 4096] = (bf16_t)(w.y >> 16);
                        p[4 * 4096] = (bf16_t)(w.z & 0xffffu); p[5 * 4096] = (bf16_t)(w.z >> 16); p[6 * 4096] = (bf16_t)(w.w & 0xffffu); p[7 * 4096] = (bf16_t)(w.w >> 16); } }
            return;
        }
        if (pn == 24) {
#pragma unroll
            for (int ai = 0; ai < 2; ++ai)
#pragma unroll
                for (int m = 0; m < 4; ++m) { const int row = row0 + ai * HALF + m * 16; const int b = row >> 12, s = row & 4095;
                    bf16_t* p = VTC + ((size_t)((b * 2 + (wc >> 1)) * 64 + (wc & 1) * 32 + 8 * fq)) * 4096 + sw16(s); const u32x4 w = pack8(acc[ai][1][m][0], acc[ai][1][m][1]);
                    p[0] = (bf16_t)(w.x & 0xffffu); p[4096] = (bf16_t)(w.x >> 16); p[2 * 4096] = (bf16_t)(w.y & 0xffffu); p[3 * 4096] = (bf16_t)(w.y >> 16);
                    p[4 * 4096] = (bf16_t)(w.z & 0xffffu); p[5 * 4096] = (bf16_t)(w.z >> 16); p[6 * 4096] = (bf16_t)(w.w & 0xffffu); p[7 * 4096] = (bf16_t)(w.w >> 16); }
        }
#pragma unroll
        for (int ai = 0; ai < 2; ++ai)
#pragma unroll
            for (int m = 0; m < 4; ++m) { bf16_t* rowp = U + (size_t)(row0 + ai * HALF + m * 16) * up + pn * BM + wc * 32 + 8 * fq;
#pragma unroll
                for (int bj = 0; bj < 2; ++bj) *(u32x4*)(rowp + bj * HALF) = pack8(acc[ai][bj][m][0], acc[ai][bj][m][1]); }
    }
};
struct EpiGate {
    static constexpr bool PERM = true, AFTER_DRAIN = false;
    bf16_t* G; int ldg; float scale;
    __device__ __forceinline__ void operator()(const f32x4 (&acc)[2][2][4][2], const Unit& u, int wr, int wc, int fr, int fq) const {
        const int row0 = u.pm * BM + wr * 64 + fr;
#pragma unroll
        for (int ai = 0; ai < 2; ++ai)
#pragma unroll
            for (int m = 0; m < 4; ++m) { bf16_t* rowp = G + (size_t)(row0 + ai * HALF + m * 16) * ldg + u.pn * BM + wc * 32 + 8 * fq;
#pragma unroll
                for (int bj = 0; bj < 2; ++bj) { f32x4 v0 = acc[ai][bj][m][0] * scale, v1 = acc[ai][bj][m][1] * scale;
#pragma unroll
                    for (int j = 0; j < 4; ++j) { v0[j] = sigm(v0[j]); v1[j] = sigm(v1[j]); }
                    *(u32x4*)(rowp + bj * HALF) = pack8(v0, v1); } }
    }
};
struct EpiSilu {
    static constexpr bool PERM = true, AFTER_DRAIN = false;
    bf16_t* O; int ldc; const float* bias;
    __device__ __forceinline__ void operator()(const f32x4 (&acc)[2][2][4][2], const Unit& u, int wr, int wc, int fr, int fq) const {
        const int row0 = u.pm * BM + wr * 64 + fr; const int col0 = u.pn * BM + wc * 32 + 8 * fq;
        f32x4 bv[2][2];
#pragma unroll
        for (int bj = 0; bj < 2; ++bj)
#pragma unroll
            for (int n = 0; n < 2; ++n) bv[bj][n] = *(const f32x4*)(bias + col0 + bj * HALF + 4 * n);
#pragma unroll
        for (int ai = 0; ai < 2; ++ai)
#pragma unroll
            for (int m = 0; m < 4; ++m) { bf16_t* rowp = O + (size_t)(row0 + ai * HALF + m * 16) * ldc + col0;
#pragma unroll
                for (int bj = 0; bj < 2; ++bj) { f32x4 v0 = acc[ai][bj][m][0] + bv[bj][0], v1 = acc[ai][bj][m][1] + bv[bj][1];
#pragma unroll
                    for (int j = 0; j < 4; ++j) { v0[j] = v0[j] * sigm(v0[j]); v1[j] = v1[j] * sigm(v1[j]); }
                    *(u32x4*)(rowp + bj * HALF) = pack8(v0, v1); } }
    }
};
struct EpiPart {
    static constexpr bool PERM = false, AFTER_DRAIN = false;
    float* P; int ldc;
    __device__ __forceinline__ void operator()(const f32x4 (&acc)[2][2][4][2], const Unit& u, int wr, int wc, int fr, int fq) const {
        const int row0 = u.pm * BM + wr * 64 + fr, col0 = u.pn * BM + wc * 32 + 4 * fq;
#pragma unroll
        for (int ai = 0; ai < 2; ++ai)
#pragma unroll
            for (int m = 0; m < 4; ++m) { float* rp = P + (size_t)(row0 + ai * HALF + m * 16) * ldc + col0;
#pragma unroll
                for (int bj = 0; bj < 2; ++bj)
#pragma unroll
                    for (int n = 0; n < 2; ++n) *(f32x4*)(rp + bj * HALF + n * 16) = acc[ai][bj][m][n]; }
    }
};
struct EpiProj {
    static constexpr bool PERM = true, AFTER_DRAIN = false;
    bf16_t* Y; int ldy; const bf16_t* Gt; int ldg; int first;
    __device__ __forceinline__ void operator()(const f32x4 (&acc)[2][2][4][2], const Unit& u, int wr, int wc, int fr, int fq) const {
        const int row0 = u.pm * BM + wr * 64 + fr; const int col0 = u.pn * BM + wc * 32 + 8 * fq;
#pragma unroll
        for (int ai = 0; ai < 2; ++ai) { u32x4 g[4][2], y[4][2];
#pragma unroll
            for (int m = 0; m < 4; ++m) { const size_t row = (size_t)(row0 + ai * HALF + m * 16);
#pragma unroll
                for (int bj = 0; bj < 2; ++bj) { g[m][bj] = *(const u32x4*)(Gt + row * ldg + col0 + bj * HALF); y[m][bj] = (u32x4){0u, 0u, 0u, 0u}; if (!first) y[m][bj] = *(const u32x4*)(Y + row * ldy + col0 + bj * HALF); } }
#pragma unroll
            for (int m = 0; m < 4; ++m) { const size_t row = (size_t)(row0 + ai * HALF + m * 16);
#pragma unroll
                for (int bj = 0; bj < 2; ++bj) { const u32x4 gg = g[m][bj], yy = y[m][bj]; const f32x4 a0 = acc[ai][bj][m][0], a1 = acc[ai][bj][m][1]; f32x4 v0, v1;
                    v0[0] = bflo(yy.x) + bflo(gg.x) * a0[0]; v0[1] = bfhi(yy.x) + bfhi(gg.x) * a0[1]; v0[2] = bflo(yy.y) + bflo(gg.y) * a0[2]; v0[3] = bfhi(yy.y) + bfhi(gg.y) * a0[3];
                    v1[0] = bflo(yy.z) + bflo(gg.z) * a1[0]; v1[1] = bfhi(yy.z) + bfhi(gg.z) * a1[1]; v1[2] = bflo(yy.w) + bflo(gg.w) * a1[2]; v1[3] = bfhi(yy.w) + bfhi(gg.w) * a1[3];
                    *(u32x4*)(Y + row * ldy + col0 + bj * HALF) = pack8(v0, v1); } }
            asm volatile("" ::: "memory"); }
    }
};
struct EpiOut {
    static constexpr bool PERM = false, AFTER_DRAIN = false;
    const float* xin; float* out; int ldc;
    __device__ __forceinline__ void operator()(const f32x4 (&acc)[2][2][4][2], const Unit& u, int wr, int wc, int fr, int fq) const {
        const int row0 = u.pm * BM + wr * 64 + fr, col0 = u.pn * BM + wc * 32 + 4 * fq;
#pragma unroll
        for (int ai = 0; ai < 2; ++ai) { f32x4 b[4][2][2];
#pragma unroll
            for (int m = 0; m < 4; ++m) { const size_t off = (size_t)(row0 + ai * HALF + m * 16) * ldc + col0;
#pragma unroll
                for (int bj = 0; bj < 2; ++bj)
#pragma unroll
                    for (int n = 0; n < 2; ++n) b[m][bj][n] = *(const f32x4*)(xin + off + bj * HALF + n * 16); }
#pragma unroll
            for (int m = 0; m < 4; ++m) { const size_t off = (size_t)(row0 + ai * HALF + m * 16) * ldc + col0;
#pragma unroll
                for (int bj = 0; bj < 2; ++bj)
#pragma unroll
                    for (int n = 0; n < 2; ++n) *(f32x4*)(out + off + bj * HALF + n * 16) = b[m][bj][n] + acc[ai][bj][m][n]; }
            asm volatile("" ::: "memory"); }
    }
};
struct EpiGU {
    static constexpr bool PERM = true, AFTER_DRAIN = false;
    bf16_t* HG; const float* ewr; const PG8_LAS int* tab; int cap;
    __device__ __forceinline__ void operator()(const f32x4 (&acc)[2][2][4][2], const Unit& u, int wr, int wc, int fr, int fq) const {
        const int row0 = u.pm * BM + wr * 64 + fr; const int col0 = (u.pn & 3) * HALF + wc * 32 + 8 * fq; const int e = u.pn >> 2, off = tab[e], cn = tab[64 + e];
#pragma unroll
        for (int ai = 0; ai < 2; ++ai)
#pragma unroll
            for (int m = 0; m < 4; ++m) { const int row = row0 + ai * HALF + m * 16, pos = row - off; float w = 0.f, ri = 0.f; if (pos < cn) { const f32x2 t = *(const f32x2*)(ewr + ((size_t)e * cap + pos) * 2); w = t.x; ri = t.y; }
                f32x4 v0, v1;
#pragma unroll
                for (int j = 0; j < 4; ++j) { const float g0 = acc[ai][0][m][0][j] * ri, g1 = acc[ai][0][m][1][j] * ri; v0[j] = g0 * sigm(g0) * acc[ai][1][m][0][j] * (ri * w); v1[j] = g1 * sigm(g1) * acc[ai][1][m][1][j] * (ri * w); }
                *(u32x4*)(HG + (size_t)row * 512 + col0) = pack8(v0, v1); }
    }
};
struct EpiDown {
    static constexpr bool PERM = true, AFTER_DRAIN = false;
    bf16_t* YG;
    __device__ __forceinline__ void operator()(const f32x4 (&acc)[2][2][4][2], const Unit& u, int wr, int wc, int fr, int fq) const {
        const int row0 = u.pm * BM + wr * 64 + fr, col0 = (u.pn & 7) * BM + wc * 32 + 8 * fq;
#pragma unroll
        for (int ai = 0; ai < 2; ++ai)
#pragma unroll
            for (int m = 0; m < 4; ++m) { bf16_t* rowp = YG + (size_t)(row0 + ai * HALF + m * 16) * 2048 + col0;
#pragma unroll
                for (int bj = 0; bj < 2; ++bj) *(u32x4*)(rowp + bj * HALF) = pack8(acc[ai][bj][m][0], acc[ai][bj][m][1]); }
    }
};

template <class Epi, class Sched, bool ALIGN_EPI = false, bool F8 = false, bool GATHER = false>
__device__ __forceinline__ void gemm_phase(PG8_LAS unsigned char* lds, const Gemm g, const Sched& S, const Epi& E) {
    int tid_ = threadIdx.x; asm volatile("" : "+v"(tid_));
    const int tid = tid_, wid = __builtin_amdgcn_readfirstlane(tid >> 6), lane = tid & 63, wr = wid >> 2, wc = wid & 3, fr = lane & 15, fq = lane >> 4;
    const int K = g.K, nt = K / BK, lda = g.lda, ldb = g.ldb;
    unsigned voffA[2], voffB[2];
#pragma unroll
    for (int i = 0; i < 2; ++i) { int R, C; stage_rc(tid * 16 + i * 8192, R, C); const int Rb = Epi::PERM ? ((R & ~31) + perm32(R & 31)) : R;
        voffA[i] = (unsigned)(R * lda + C) * 2u; voffB[i] = (unsigned)(Rb * ldb + C) * 2u; }
    const size_t kstep = (size_t)(BK * 2);
    const size_t hstepA = (size_t)HALF * lda * 2, hstepB = (size_t)HALF * ldb * 2;
    const size_t tstepB = 2 * hstepB;
    const size_t hstepAg = GATHER ? 0 : hstepA, tstepA = GATHER ? 0 : 2 * hstepA;
    const unsigned ldsw = (unsigned)wid * 1024u;
    const int aoff = lds_byte(wr * 64 + fr, fq * 8), boff = lds_byte(wc * 32 + fr, fq * 8);
#define PG8_SA(b, h) (((b) * 2 + (h)) * HTB)
#define PG8_SB(b, h) ((4 + (b) * 2 + (h)) * HTB)
#define PG8_VA(nx, h) (GATHER ? ((nx) ? vnx[h] : vcu[h]) : voffA)
#define PG8_STAGE(bufoff, gbase, voff) do { _Pragma("unroll") for (int _i = 0; _i < 2; ++_i) \
        __builtin_amdgcn_global_load_lds((const unsigned*)((const char*)(gbase) + (voff)[_i]), (PG8_LAS unsigned*)(lds + (bufoff) + ldsw + _i * 8192), 16, 0, 0); } while (0)
#define PG8_LDA(dst, b, h) do { _Pragma("unroll") for (int m = 0; m < 4; ++m) { if constexpr (F8) { dst##8[m].lo = *(const PG8_LAS v4i_t*)(lds + PG8_SA(b, h) + aoff + m * 2048); dst##8[m].hi = *(const PG8_LAS v4i_t*)(lds + PG8_SA(b, h) + aoff + m * 2048 + 1024); } \
        else { _Pragma("unroll") for (int k = 0; k < 2; ++k) dst[m][k] = *(const PG8_LAS bf16x8*)(lds + PG8_SA(b, h) + aoff + m * 2048 + k * 1024); } } } while (0)
#define PG8_LDB(dst, b, h) do { _Pragma("unroll") for (int n = 0; n < 2; ++n) { if constexpr (F8) { dst##8[n].lo = *(const PG8_LAS v4i_t*)(lds + PG8_SB(b, h) + boff + n * 2048); dst##8[n].hi = *(const PG8_LAS v4i_t*)(lds + PG8_SB(b, h) + boff + n * 2048 + 1024); } \
        else { _Pragma("unroll") for (int k = 0; k < 2; ++k) dst[n][k] = *(const PG8_LAS bf16x8*)(lds + PG8_SB(b, h) + boff + n * 2048 + k * 1024); } } } while (0)
#define PG8_MMA(ai, bj, At, Bt) do { __builtin_amdgcn_s_setprio(1); _Pragma("unroll") for (int m = 0; m < 4; ++m) _Pragma("unroll") for (int n = 0; n < 2; ++n) { \
        if constexpr (F8) asm volatile("v_mfma_f32_16x16x128_f8f6f4 %0, %1, %2, %0" : "+v"(acc[ai][bj][m][n]) : "v"(Bt##8[n]), "v"(At##8[m])); \
        else { _Pragma("unroll") for (int k = 0; k < 2; ++k) acc[ai][bj][m][n] = __builtin_amdgcn_mfma_f32_16x16x32_bf16(Bt[n][k], At[m][k], acc[ai][bj][m][n], 0, 0, 0); } } __builtin_amdgcn_s_setprio(0); } while (0)
#define PG8_WAIT_V(n) asm volatile("s_waitcnt vmcnt(" #n ")" ::: "memory")
#define PG8_WAIT_L(n) asm volatile("s_waitcnt lgkmcnt(" #n ")" ::: "memory")
#define PG8_BAR __builtin_amdgcn_s_barrier()
#define PG8_SCHED __builtin_amdgcn_sched_barrier(0)
    Unit cur, nxt; int ui = 0;
    if (!S.next(0, cur)) return;
    f32x4 acc[2][2][4][2];
#pragma unroll
    for (int a = 0; a < 2; ++a)
#pragma unroll
        for (int b = 0; b < 2; ++b)
#pragma unroll
            for (int m = 0; m < 4; ++m)
#pragma unroll
                for (int n = 0; n < 2; ++n) acc[a][b][m][n] = (f32x4){0.f, 0.f, 0.f, 0.f};
    bf16x8 At[4][2], B0[2][2], B1[2][2]; v8i_t At8[4], B08[2], B18[2];
    const char* cA = (const char*)g.A + (size_t)cur.pm * tstepA; const char* cB = (const char*)g.Bt + (size_t)cur.pn * tstepB;
    unsigned vcu[2][2], vnx[2][2];
#define PG8_GOFF(u, v) do { _Pragma("unroll") for (int _h = 0; _h < 2; ++_h) _Pragma("unroll") for (int _i = 0; _i < 2; ++_i) { int R, C; stage_rc(tid * 16 + _i * 8192, R, C); v[_h][_i] = S.row_off(u, _h * HALF + R) + (unsigned)C * 2u; } } while (0)
    if constexpr (GATHER) PG8_GOFF(cur, vcu);
    S.a_ready(cur);
    PG8_STAGE(PG8_SB(0, 0), cB, voffB); PG8_STAGE(PG8_SB(0, 1), cB + hstepB, voffB); PG8_STAGE(PG8_SA(0, 0), cA, PG8_VA(false, 0)); PG8_STAGE(PG8_SA(0, 1), cA + hstepAg, PG8_VA(false, 1));
    if (wr == 1) PG8_BAR;
    PG8_WAIT_V(2); PG8_BAR;
    PG8_STAGE(PG8_SB(1, 0), cB + kstep, voffB); PG8_STAGE(PG8_SA(1, 0), cA + kstep, PG8_VA(false, 0)); PG8_STAGE(PG8_SB(1, 1), cB + hstepB + kstep, voffB);
    PG8_WAIT_V(6); PG8_BAR;
    for (;;) {
        const bool has_next = S.next(ui + 1, nxt);
        if constexpr (GATHER) { if (has_next) PG8_GOFF(nxt, vnx); else {
#pragma unroll
            for (int _h = 0; _h < 2; ++_h)
#pragma unroll
                for (int _i = 0; _i < 2; ++_i) vnx[_h][_i] = vcu[_h][_i]; } }
        const char* nA = has_next ? (const char*)g.A + (size_t)nxt.pm * tstepA : cA; const char* nB = has_next ? (const char*)g.Bt + (size_t)nxt.pn * tstepB : cB;
        for (int t = 0; t < nt; t += 2) {
            const bool last = (t == nt - 2);
            const char* a1 = cA + (size_t)(t + 1) * kstep;
            const char* a2 = last ? nA : cA + (size_t)(t + 2) * kstep; const char* b2 = last ? nB : cB + (size_t)(t + 2) * kstep;
            const char* a3 = a2 + kstep; const char* b3 = b2 + kstep;
            if (last && has_next) S.a_ready(nxt);
            PG8_LDB(B0, 0, 0); PG8_LDB(B1, 0, 1); PG8_SCHED; PG8_LDA(At, 0, 0); PG8_STAGE(PG8_SA(1, 1), a1 + hstepAg, PG8_VA(false, 1));
            PG8_WAIT_V(8); PG8_WAIT_L(0); PG8_BAR; PG8_MMA(0, 0, At, B0); PG8_MMA(0, 1, At, B1); PG8_BAR; PG8_SCHED;
            PG8_LDA(At, 0, 1); PG8_STAGE(PG8_SB(0, 0), b2, voffB); PG8_STAGE(PG8_SB(0, 1), b2 + hstepB, voffB); PG8_STAGE(PG8_SA(0, 0), a2, PG8_VA(last, 0));
            PG8_WAIT_V(8); PG8_WAIT_L(0); PG8_BAR; PG8_MMA(1, 0, At, B0); PG8_MMA(1, 1, At, B1); PG8_BAR; PG8_SCHED;
            PG8_LDB(B0, 1, 0); PG8_LDB(B1, 1, 1); PG8_SCHED; PG8_LDA(At, 1, 0); PG8_STAGE(PG8_SA(0, 1), a2 + hstepAg, PG8_VA(last, 1));
            PG8_WAIT_V(8); PG8_WAIT_L(0); PG8_BAR; PG8_MMA(0, 0, At, B0); PG8_MMA(0, 1, At, B1); PG8_BAR; PG8_SCHED;
            PG8_LDA(At, 1, 1); PG8_STAGE(PG8_SB(1, 0), b3, voffB); PG8_STAGE(PG8_SB(1, 1), b3 + hstepB, voffB); PG8_STAGE(PG8_SA(1, 0), a3, PG8_VA(last, 0));
            PG8_WAIT_V(8); PG8_WAIT_L(0); PG8_BAR; PG8_MMA(1, 0, At, B0); PG8_MMA(1, 1, At, B1); PG8_BAR; PG8_SCHED;
        }
        if constexpr (ALIGN_EPI) { if (wr == 0) PG8_BAR; }
        if constexpr (F8) {
            asm volatile("s_nop 15\n\ts_nop 15" : "+v"(acc[0][0][0][0]), "+v"(acc[0][0][0][1]), "+v"(acc[0][0][1][0]), "+v"(acc[0][0][1][1]), "+v"(acc[0][0][2][0]), "+v"(acc[0][0][2][1]), "+v"(acc[0][0][3][0]), "+v"(acc[0][0][3][1]),
                                                    "+v"(acc[0][1][0][0]), "+v"(acc[0][1][0][1]), "+v"(acc[0][1][1][0]), "+v"(acc[0][1][1][1]), "+v"(acc[0][1][2][0]), "+v"(acc[0][1][2][1]), "+v"(acc[0][1][3][0]), "+v"(acc[0][1][3][1]));
            asm volatile("" : "+v"(acc[1][0][0][0]), "+v"(acc[1][0][0][1]), "+v"(acc[1][0][1][0]), "+v"(acc[1][0][1][1]), "+v"(acc[1][0][2][0]), "+v"(acc[1][0][2][1]), "+v"(acc[1][0][3][0]), "+v"(acc[1][0][3][1]),
                                "+v"(acc[1][1][0][0]), "+v"(acc[1][1][0][1]), "+v"(acc[1][1][1][0]), "+v"(acc[1][1][1][1]), "+v"(acc[1][1][2][0]), "+v"(acc[1][1][2][1]), "+v"(acc[1][1][3][0]), "+v"(acc[1][1][3][1])); }
        E(acc, cur, wr, wc, fr, fq); S.done(cur);
        if (!has_next) break;
#pragma unroll
        for (int a = 0; a < 2; ++a)
#pragma unroll
            for (int b = 0; b < 2; ++b)
#pragma unroll
                for (int m = 0; m < 4; ++m)
#pragma unroll
                    for (int n = 0; n < 2; ++n) acc[a][b][m][n] = (f32x4){0.f, 0.f, 0.f, 0.f};
        cur = nxt; cA = nA; cB = nB; ++ui;
        if constexpr (GATHER) {
#pragma unroll
            for (int _h = 0; _h < 2; ++_h)
#pragma unroll
                for (int _i = 0; _i < 2; ++_i) vcu[_h][_i] = vnx[_h][_i]; }
        if constexpr (ALIGN_EPI) { if (wr == 1) PG8_BAR; }
    }
    PG8_WAIT_V(0);
    if constexpr (!ALIGN_EPI) { if (wr == 0) PG8_BAR; }
    PG8_BAR;
#undef PG8_SA
#undef PG8_VA
#undef PG8_GOFF
#undef PG8_SB
#undef PG8_STAGE
#undef PG8_LDA
#undef PG8_LDB
#undef PG8_MMA
#undef PG8_WAIT_V
#undef PG8_WAIT_L
#undef PG8_BAR
#undef PG8_SCHED
}
}
constexpr int NB = 8, S = 4096, D = 2048, T = NB * S;
constexpr int HBN = 4, TH = HBN * S;
constexpr int IN_DIM = 12584, NIN1 = 6656, NGATE = 6144, UP = 12544;
constexpr int UC_Q = 0, UC_KV = 1024, UC_Z = 2560, UC_XBC = 3584, UC_SQ = 5120, UC_SKV = 6144, UC_G = 6400;
constexpr int NSLOT = 73728;
constexpr float NORM_EPS = 1e-6f;

constexpr size_t MiB = 1u << 20;
constexpr size_t WS_CTL = 0, CTL_ZERO_BYTES = 1 * MiB;
constexpr size_t WS_TAB = 1 * MiB;
constexpr size_t WS_B1P = WS_TAB + 3 * MiB;
constexpr size_t WS_WR = WS_B1P + 64 * 1024;
constexpr size_t WS_W2T = WS_WR + 512 * 1024;
constexpr size_t WS_WIN = 5 * MiB;
constexpr size_t WS_WG8 = WS_WIN + 26 * MiB;
constexpr size_t WS_W1 = WS_WIN + 50 * MiB;
constexpr size_t WS_PT = WS_W1 + 4 * MiB;
constexpr size_t WS_WOUT = WS_PT + 12 * MiB;
constexpr size_t WS_GU = WS_WOUT + 8 * MiB;
constexpr size_t WS_DN = WS_GU + 128 * MiB;
constexpr size_t WS_ACT = WS_DN + 64 * MiB;
constexpr size_t WS_HN = WS_ACT;
constexpr size_t WS_U = WS_HN + 64 * MiB;
constexpr size_t WS_KVC = WS_U + 392 * MiB;
constexpr size_t KVC_CSTRIDE = (size_t)(HBN * 2 * 4096 + 16) * 128;
constexpr size_t WS_SM = WS_KVC + 17 * MiB;
constexpr size_t WS_QR = WS_SM + 4 * MiB;
constexpr size_t WS_XC = WS_QR + 32 * MiB;
constexpr size_t WS_DTV = WS_XC + 48 * MiB;
constexpr size_t WS_ACS = WS_DTV + 1 * MiB;
constexpr size_t WS_HID = WS_ACS + 1 * MiB;
constexpr size_t WS_KC = WS_HID + 2 * MiB;
constexpr size_t WS_SEL = WS_KC + 1 * MiB;
constexpr size_t WS_OA = WS_SEL + 1 * MiB;
constexpr size_t WS_OB = WS_OA + 32 * MiB, WS_OC = WS_OB + 32 * MiB;
constexpr size_t WS_CBG = WS_OA + 96 * MiB;
constexpr size_t WS_YD = WS_CBG + 16 * MiB;
constexpr size_t WS_ST = WS_YD + 64 * MiB;
constexpr size_t WS_VTS = WS_ST + 64 * MiB;
constexpr size_t WS_VTW = WS_VTS + 8 * MiB;
constexpr size_t WS_VTC = WS_VTW + 8 * MiB;
constexpr size_t WS_VCT = WS_VTC + 4 * MiB;
constexpr size_t WS_HN1 = WS_VCT + 1 * MiB;
constexpr size_t WS_HN8 = WS_HN1 + 64 * MiB;
constexpr size_t WS_MIX_END = WS_HN8 + 64 * MiB;
constexpr size_t WS_ROUTE = WS_U;
constexpr size_t WS_ELT = WS_ROUTE + 1 * MiB;
constexpr size_t WS_EWR = WS_ELT + 4 * MiB;
constexpr size_t WS_XB = WS_EWR + 8 * MiB;
constexpr size_t WS_HG = WS_XB + 128 * MiB;
constexpr size_t WS_XG = WS_HG + 72 * MiB;
constexpr size_t WS_MOE_END = WS_XG + 288 * MiB;
static_assert(WS_MOE_END <= WS_CBG, "MoE buffers must stay inside the dead mixer buffers");
constexpr size_t WS_END = WS_MIX_END > WS_MOE_END ? WS_MIX_END : WS_MOE_END;
constexpr int CW_BAR = 4096;
constexpr int CW_ECNT = 16384;

constexpr int RING_OFF = 0, RING_BYTES = 131072;
constexpr int LDS_BYTES = 147456;
constexpr int LDSCTL_OFF = LDS_BYTES - 512, MISC_OFF = LDSCTL_OFF + 320;
constexpr int MOETAB_OFF = RING_BYTES;
constexpr int NWAVES = 8;

#define GAS __attribute__((address_space(1)))
#define LAS __attribute__((address_space(3)))
typedef unsigned short bf16;
typedef unsigned v4u __attribute__((ext_vector_type(4)));
typedef unsigned v2u __attribute__((ext_vector_type(2)));
typedef float f32x4 __attribute__((ext_vector_type(4)));
typedef float v2f __attribute__((ext_vector_type(2)));
typedef GAS unsigned gu32;
#define RLX_AGENT __ATOMIC_RELAXED, __HIP_MEMORY_SCOPE_AGENT
#define LDS_WAIT() asm volatile("s_waitcnt lgkmcnt(0)" ::: "memory")
#define VM_WAIT() asm volatile("s_waitcnt vmcnt(0)" ::: "memory")
__device__ __forceinline__ unsigned f2bf(float f) { unsigned u = __builtin_bit_cast(unsigned, f); return (u + 0x7fffu + ((u >> 16) & 1u)) >> 16; }
__device__ __forceinline__ unsigned pk2(float lo, float hi) { return f2bf(lo) | (f2bf(hi) << 16); }
__device__ __forceinline__ float bf2f(bf16 v) { return __uint_as_float(((unsigned)v) << 16); }
__device__ __forceinline__ float blo(unsigned w) { return __uint_as_float(w << 16); }
__device__ __forceinline__ float bhi(unsigned w) { return __uint_as_float(w & 0xffff0000u); }
__device__ __forceinline__ float sigmf(float x) { return __builtin_amdgcn_rcpf(1.0f + __builtin_amdgcn_exp2f(x * -1.4426950408889634f)); }
__host__ __device__ __forceinline__ int sw16(int x) { return (x & ~12) | ((x & 4) << 1) | ((x & 8) >> 1); }
__device__ __forceinline__ float wave_sum(float v) {
#pragma unroll
    for (int o = 1; o < 64; o <<= 1) v += __shfl_xor(v, o);
    return v;
}
__device__ __forceinline__ float wave_max(float v) {
#pragma unroll
    for (int o = 1; o < 64; o <<= 1) v = fmaxf(v, __shfl_xor(v, o));
    return v;
}

#define XB_TMO      128
#define XB_XCNT(j)  (256  + 64 * (j))
#define XB_XSUB(j)  (1280 + 64 * (j))
#define XB_XGEN(j)  (2304 + 64 * (j))
#define XB_TOP      3328
#define XB_TOPGEN   3392
#define XCD_BAR_WORDS 3456
#define XB_SPIN_CAP (1u << 18)

__device__ __forceinline__ unsigned xb_ld(unsigned* p)              { return __hip_atomic_load(p, __ATOMIC_RELAXED, __HIP_MEMORY_SCOPE_AGENT); }
__device__ __forceinline__ unsigned xb_add(unsigned* p, unsigned v) { return __hip_atomic_fetch_add(p, v, __ATOMIC_RELAXED, __HIP_MEMORY_SCOPE_AGENT); }
__device__ __forceinline__ unsigned xb_xcc_id() { return (unsigned)__builtin_amdgcn_s_getreg((3 << 11) | 20) & 0xFu; }
#define XB_SPIN(cond, bar) do { unsigned _sp = 0; while (cond) { __builtin_amdgcn_s_sleep(1); \
    if ((++_sp & 255u) == 0u) { if (xb_ld(&(bar)[XB_TMO])) break; if (_sp > XB_SPIN_CAP) { atomicAdd(&(bar)[XB_TMO], 1u); break; } } } } while (0)

struct XcdBarrier {
    unsigned* bar; unsigned x;
    volatile LAS unsigned* st;
};

__device__ __forceinline__ XcdBarrier xcd_barrier_post(unsigned* bar, volatile LAS unsigned* st) {
    XcdBarrier b; b.bar = bar; b.x = xb_xcc_id(); b.st = st;
    if (threadIdx.x == 0) (void)xb_add(&bar[XB_XCNT(b.x)], 1u);
    return b;
}
__device__ __forceinline__ void xcd_barrier_complete(unsigned* bar, unsigned x, unsigned& nloc, unsigned& nx) {
    const unsigned G = gridDim.x * gridDim.y * gridDim.z;
    unsigned sum, cnt, mine, sp = 0u;
    for (;;) {
        sum = 0u; cnt = 0u; mine = 0u;
#pragma unroll
        for (unsigned j = 0; j < 16; ++j) { const unsigned c = xb_ld(&bar[XB_XCNT(j)]); sum += c; cnt += (c > 0u) ? 1u : 0u; mine = (j == x) ? c : mine; }
        if (sum == G) break;
        __builtin_amdgcn_s_sleep(1);
        if ((++sp & 255u) == 0u) { if (xb_ld(&bar[XB_TMO])) break; if (sp > XB_SPIN_CAP) { atomicAdd(&bar[XB_TMO], 1u); break; } }
    }
    nloc = mine > 0u ? mine : 1u; nx = cnt > 0u ? cnt : 1u;
}

__device__ __forceinline__ void xcd_barrier(const XcdBarrier& b) {
    asm volatile("s_waitcnt vmcnt(0)" ::: "memory");
    __syncthreads();
    if (threadIdx.x == 0) {
        unsigned* bar = b.bar;
        __builtin_amdgcn_s_waitcnt(0);
        unsigned nloc = b.st[0], nx = b.st[1];
        if (nloc == 0u) { xcd_barrier_complete(bar, b.x, nloc, nx); b.st[0] = nloc; b.st[1] = nx; }
        const unsigned old = xb_add(&bar[XB_XSUB(b.x)], 1u);
        const unsigned gen = old / nloc;
        if (old + 1u == (gen + 1u) * nloc) {
            __builtin_amdgcn_fence(__ATOMIC_RELEASE, "agent");
            asm volatile("s_waitcnt vmcnt(0)" ::: "memory");
            const unsigned og = xb_add(&bar[XB_TOP], 1u);
            const unsigned tg = og / nx;
            if (og + 1u == (tg + 1u) * nx) xb_add(&bar[XB_TOPGEN], 1u);
            else XB_SPIN(xb_ld(&bar[XB_TOPGEN]) == tg, bar);
            __builtin_amdgcn_fence(__ATOMIC_ACQUIRE, "agent");
            xb_add(&bar[XB_XGEN(b.x)], 1u);
            asm volatile("s_waitcnt vmcnt(0)" ::: "memory");
        } else {
            XB_SPIN(xb_ld(&bar[XB_XGEN(b.x)]) == gen, bar);
            __builtin_amdgcn_fence(__ATOMIC_ACQUIRE, "agent");
            asm volatile("s_waitcnt vmcnt(0)" ::: "memory");
        }
    }
    __syncthreads();
}

struct Args { const float* in[27]; float* out; unsigned char* ws; int lo, hi; };
struct Frame {
    LAS unsigned char* lds;
    volatile LAS unsigned* MISC;
    gu32* ctl;
    int tid, lane, wave, vcu, G;
    int gtid, GT, gw, NGW;
};
constexpr int NSTEPS = 37;
#define LAUNDER_S(x) asm volatile("" : "+s"(x))
#define LAUNDER_V(x) asm volatile("" : "+v"(x))
#define inp(a, K) inp_<(K)>(a)
template <int K> __device__ __forceinline__ const float* inp_(const Args& a) { unsigned long long v = (unsigned long long)a.in[K]; LAUNDER_S(v); return (const float*)(GAS const float*)v; }
__device__ __forceinline__ unsigned char* wsp(const Args& a) { unsigned long long v = (unsigned long long)a.ws; LAUNDER_S(v); return (unsigned char*)(GAS unsigned char*)v; }
__device__ __forceinline__ float* outp(const Args& a) { unsigned long long v = (unsigned long long)a.out; LAUNDER_S(v); return (float*)(GAS float*)v; }
__device__ __forceinline__ Frame refr(const Frame& F0) { Frame F = F0; int tid = F0.tid; LAUNDER_V(tid); int v = F0.vcu; LAUNDER_S(v); F.tid = tid; F.lane = tid & 63; F.wave = __builtin_amdgcn_readfirstlane(tid >> 6); F.vcu = v; int G = F0.G; LAUNDER_S(G); F.G = G; F.GT = G * NWAVES * 64; F.NGW = G * NWAVES;
    F.gtid = v * (NWAVES * 64) + tid; F.gw = v * NWAVES + F.wave; return F; }

__device__ __forceinline__ void tr_item(const float* W, int ldw, int K, int col0, bf16* WT, int row0, int nblk, LAS float* scr, int item, int lane, const float* kscale = nullptr) {
    const int kb = item / nblk, nb = item - kb * nblk, k0 = 64 * kb, n0 = 64 * nb; const int kq = lane >> 4, n4 = (lane & 15) * 4;
    f32x4 v[16];
#pragma unroll
    for (int i = 0; i < 16; ++i) v[i] = *(const f32x4*)(W + (size_t)(k0 + 4 * i + kq) * ldw + col0 + n0 + n4);
    if (kscale) {
#pragma unroll
        for (int i = 0; i < 16; ++i) v[i] = v[i] * kscale[k0 + 4 * i + kq]; }
#pragma unroll
    for (int i = 0; i < 16; ++i) { LAS float* d = scr + (4 * i + kq) * 65 + n4; d[0] = v[i].x; d[1] = v[i].y; d[2] = v[i].z; d[3] = v[i].w; }
    LDS_WAIT();
    const int c = lane & 7;
#pragma unroll
    for (int j = 0; j < 8; ++j) { const int n = (lane >> 3) + 8 * j; const LAS float* s = scr + (8 * c) * 65 + n;
        v4u o; o.x = pk2(s[0 * 65], s[1 * 65]); o.y = pk2(s[2 * 65], s[3 * 65]); o.z = pk2(s[4 * 65], s[5 * 65]); o.w = pk2(s[6 * 65], s[7 * 65]);
        *(v4u*)(WT + (size_t)(row0 + n0 + n) * K + k0 + 8 * c) = o; }
    LDS_WAIT();
}
__device__ __forceinline__ void tr_item8(const float* W, int ldw, int K, int col0, unsigned char* WT, int row0, int nblk, float sc, LAS float* scr, int item, int lane) {
    const int kb = item / nblk, nb = item - kb * nblk, k0 = 64 * kb, n0 = 64 * nb; const int kq = lane >> 4, n4 = (lane & 15) * 4;
    f32x4 v[16];
#pragma unroll
    for (int i = 0; i < 16; ++i) v[i] = *(const f32x4*)(W + (size_t)(k0 + 4 * i + kq) * ldw + col0 + n0 + n4);
#pragma unroll
    for (int i = 0; i < 16; ++i) { LAS float* d = scr + (4 * i + kq) * 65 + n4; const f32x4 c = __builtin_elementwise_min(__builtin_elementwise_max(v[i] * sc, (f32x4){-448.f, -448.f, -448.f, -448.f}), (f32x4){448.f, 448.f, 448.f, 448.f}); d[0] = c.x; d[1] = c.y; d[2] = c.z; d[3] = c.w; }
    LDS_WAIT();
    const int c = lane & 7;
#pragma unroll
    for (int j = 0; j < 8; ++j) { const int n = (lane >> 3) + 8 * j; const LAS float* s = scr + (8 * c) * 65 + n;
        unsigned w0 = __builtin_amdgcn_cvt_pk_fp8_f32(s[0 * 65], s[1 * 65], 0u, false); w0 = __builtin_amdgcn_cvt_pk_fp8_f32(s[2 * 65], s[3 * 65], w0, true);
        unsigned w1 = __builtin_amdgcn_cvt_pk_fp8_f32(s[4 * 65], s[5 * 65], 0u, false); w1 = __builtin_amdgcn_cvt_pk_fp8_f32(s[6 * 65], s[7 * 65], w1, true);
        v2u o; o.x = w0; o.y = w1; *(v2u*)(WT + (size_t)(row0 + n0 + n) * K + k0 + 8 * c) = o; }
    LDS_WAIT();
}
__device__ __forceinline__ float rms_row_load(const float* xrow, const float* w, int lane, f32x4 (&v)[8]) {
    const f32x4* xr = (const f32x4*)xrow + lane; float ss = 0.f;
#pragma unroll
    for (int j = 0; j < 8; ++j) { v[j] = xr[64 * j]; ss += (v[j].x * v[j].x + v[j].y * v[j].y) + (v[j].z * v[j].z + v[j].w * v[j].w); }
    const float rinv = 1.0f / sqrtf(wave_sum(ss) * (1.f / D) + NORM_EPS);
    const f32x4* wr = (const f32x4*)w + lane;
#pragma unroll
    for (int j = 0; j < 8; ++j) { const f32x4 ww = wr[64 * j]; v[j] = v[j] * rinv * ww; }
    return rinv;
}
__device__ __forceinline__ void store_row_bf16(bf16* orow, int lane, const f32x4 (&v)[8]) {
    v2u* o8 = (v2u*)orow + lane;
#pragma unroll
    for (int j = 0; j < 8; ++j) { v2u w; w.x = pk2(v[j].x, v[j].y); w.y = pk2(v[j].z, v[j].w); o8[64 * j] = w; }
}

__device__ __forceinline__ void phW(const Frame& F0, const Args& a, int l) {
    const Frame F = refr(F0);
    unsigned char* ws = wsp(a);
    LAS float* scr = (LAS float*)(F.lds + F.wave * 16640);
    if (F.gw < 512) { const int c = F.gw >> 8, j = ((F.gw >> 6) & 3) * 64 + F.lane, seg = F.gw & 63;
        const float* w1 = inp(a, 5) + (size_t)(l * 2 + c) * 4096 * 256 + (size_t)seg * 64 * 256; const float* pos = inp(a, 4) + (size_t)(l * 2 + c) * 4096 + seg * 64;
        float a0 = 0.f, a1 = 0.f, a2 = 0.f, a3 = 0.f;
#pragma unroll 4
        for (int i = 0; i < 64; i += 4) { a0 += pos[i] * w1[(size_t)i * 256 + j]; a1 += pos[i + 1] * w1[(size_t)(i + 1) * 256 + j]; a2 += pos[i + 2] * w1[(size_t)(i + 2) * 256 + j]; a3 += pos[i + 3] * w1[(size_t)(i + 3) * 256 + j]; }
        ((float*)(ws + WS_CBG))[(seg * 2 + c) * 256 + j] = (a0 + a1) + (a2 + a3); }
    if (l == 0) { float* cosA = (float*)(ws + WS_TAB); float* sinA = cosA + 4096 * 64; float* cosC = sinA + 4096 * 64; float* sinC = cosC + 4096 * 32;
        for (int idx = F.gtid; idx < 4096 * 96; idx += F.GT) { const int s = idx / 96, i = idx - s * 96;
            const bool isA = i < 64; const int ii = isA ? i : i - 64; const float dim = isA ? 128.f : 64.f;
            const float inv = 1.0f / powf(10000.0f, (float)(2 * ii) / dim); const float ang = (float)s * inv;
            double r = (double)ang * 0.15915494309189533577; r -= floor(r); const float a2 = (float)(r * 6.28318530717958647692);
            const float cv = __cosf(a2), sv = __sinf(a2);
            if (isA) { cosA[s * 64 + ii] = cv; sinA[s * 64 + ii] = sv; } else { cosC[s * 32 + ii] = cv; sinC[s * 32 + ii] = sv; } } }
    bf16* WIN = (bf16*)(ws + WS_WIN); bf16* W1T = (bf16*)(ws + WS_W1); bf16* PT = (bf16*)(ws + WS_PT); bf16* WOUT = (bf16*)(ws + WS_WOUT); bf16* GU = (bf16*)(ws + WS_GU); bf16* DN = (bf16*)(ws + WS_DN);
    const float* w_in = inp(a, 3) + (size_t)l * D * IN_DIM;
    constexpr int I_IN0 = 32 * 40, I_IN1 = 32 * 40, I_IN2 = 32 * 20, I_IN3 = 32 * 96, I_W1 = 64 * 4, I_P = 16 * 32, I_O = 32 * 32, I_GU = 32 * 512, I_DN = 32 * 256;
    constexpr int NITEMS = I_IN0 + I_IN1 + I_IN2 + I_IN3 + 2 * I_W1 + 3 * I_P + I_O + I_GU + I_DN;
    for (int it = F.gw; it < NITEMS; it += F.NGW) {
        int r = it;
        if (r < I_IN0) { tr_item(w_in, IN_DIM, D, 0, WIN, 0, 40, scr, r, F.lane); continue; } r -= I_IN0;
        if (r < I_IN1) { tr_item(w_in, IN_DIM, D, 2584, WIN, 2560, 40, scr, r, F.lane); continue; } r -= I_IN1;
        if (r < I_IN2) { tr_item(w_in, IN_DIM, D, 5160, WIN, 5120, 20, scr, r, F.lane); continue; } r -= I_IN2;
        if (r < I_IN3) { tr_item8(w_in, IN_DIM, D, 6440, (unsigned char*)(ws + WS_WG8), 0, 96, 64.0f, scr, r, F.lane); continue; } r -= I_IN3;
        if (r < 2 * I_W1) { const int c = r / I_W1; tr_item(inp(a, 5) + (size_t)(l * 2 + c) * 4096 * 256, 256, 4096, 0, W1T + (size_t)c * 256 * 4096, 0, 4, scr, r - c * I_W1, F.lane); continue; } r -= 2 * I_W1;
        if (r < 3 * I_P) { const int i = r / I_P; tr_item((i == 0 ? inp(a, 15) : (i == 1 ? inp(a, 16) : inp(a, 17))) + (size_t)l * 1024 * 2048, 2048, 1024, 0, PT + (size_t)i * 2048 * 1024, 0, 32, scr, r - i * I_P, F.lane); continue; } r -= 3 * I_P;
        if (r < I_O) { tr_item(inp(a, 18) + (size_t)l * 2048 * 2048, 2048, 2048, 0, WOUT, 0, 32, scr, r, F.lane); continue; } r -= I_O;
        if (r < I_GU) { const int e = r >> 9, rr = r & 511, which = rr >> 8, t = (rr >> 6) & 3, i2 = rr & 63;
            tr_item((which == 0 ? inp(a, 23) : inp(a, 24)) + (size_t)(l * 32 + e) * 2048 * 512, 512, 2048, t * 128, GU + (size_t)e * 1024 * 2048, t * 256 + which * 128, 2, scr, i2, F.lane, inp(a, 2) + (size_t)l * D); continue; } r -= I_GU;
        { const int e = r >> 8, i2 = r & 255; tr_item(inp(a, 25) + (size_t)(l * 32 + e) * 512 * 2048, 2048, 512, 0, DN + (size_t)e * 2048 * 512, 0, 32, scr, i2, F.lane); }
    }
    { bf16* WRh = (bf16*)(ws + WS_WR); bf16* WRl = WRh + 64 * 2048; const float* nwf = inp(a, 2) + (size_t)l * D; const float* gr = inp(a, 19) + (size_t)l * D * 4; const float* er = inp(a, 21) + (size_t)l * D * 32;
      for (int idx = F.gtid; idx < 64 * 2048; idx += F.GT) { const int c = idx >> 11, k = idx & 2047; float v = 0.f; if (c < 4) v = nwf[k] * gr[(size_t)k * 4 + c]; else if (c < 36) v = nwf[k] * er[(size_t)k * 32 + (c - 4)];
          const unsigned hi = f2bf(v); const float rem = v - __uint_as_float(hi << 16); WRh[idx] = (bf16)hi; WRl[idx] = (bf16)f2bf(rem); } }
    { bf16* W2T = (bf16*)(ws + WS_W2T); const float* w2 = inp(a, 7) + (size_t)l * 2 * 256 * 128;
      for (int idx = F.gtid; idx < 2 * 128 * 256; idx += F.GT) { const int i = idx & 255, d = (idx >> 8) & 127, c = idx >> 15; W2T[idx] = (bf16)f2bf(w2[(size_t)(c * 256 + i) * 128 + d]); } }
    for (int idx = F.gtid; idx < 256 * 256; idx += F.GT) { const int n = idx >> 8, k8 = idx & 255; const int src = n < 24 ? 2560 + n : (n < 40 ? 5144 + (n - 24) : -1);
        float f[8];
#pragma unroll
        for (int j = 0; j < 8; ++j) f[j] = src >= 0 ? w_in[(size_t)(k8 * 8 + j) * IN_DIM + src] : 0.f;
        v4u o; o.x = pk2(f[0], f[1]); o.y = pk2(f[2], f[3]); o.z = pk2(f[4], f[5]); o.w = pk2(f[6], f[7]);
        *(v4u*)(WIN + (size_t)(6400 + n) * D + k8 * 8) = o; }
}

__device__ __forceinline__ void moe_tables(const Frame& F0, int ly) {
    const Frame F = refr(F0);
    LAS int* tab = (LAS int*)(F.lds + MOETAB_OFF); gu32* cnt = F.ctl + CW_ECNT + ly * 32 * 64;
    __syncthreads();
    if (F.tid < 32) tab[64 + F.tid] = (int)__hip_atomic_load(cnt + F.tid * 64, RLX_AGENT);
    __syncthreads();
    if (F.tid == 0) { int o = 0; for (int e = 0; e < 32; ++e) { tab[e] = o; o += (tab[64 + e] + 255) & ~255; } tab[32] = o; tab[128] = o >> 8; }
    __syncthreads();
    for (int p = F.tid; p < (tab[32] >> 8); p += NWAVES * 64) { int e = 0; for (int q = 1; q < 32; ++q) if (p * 256 >= tab[q]) e = q; tab[192 + p] = e; }
    __syncthreads();
}
__device__ __forceinline__ void phA(const Frame& F0, const Args& a, int l) {
    const Frame F = refr(F0);
    unsigned char* ws = wsp(a); const float* xin = (l == 0 ? inp(a, 0) : outp(a)); float* xo = outp(a); const float* w = inp(a, 1) + l * D;
    const unsigned* ROUTE = (const unsigned*)(ws + WS_ROUTE); const bf16* YG = (const bf16*)(ws + WS_XG); const LAS int* tab = (const LAS int*)(F.lds + MOETAB_OFF);
    if (l > 0) moe_tables(F, l - 1);
    for (int m = F.gw; m < T; m += F.NGW) { f32x4 v[8]; const f32x4* xr = (const f32x4*)(xin + (size_t)m * D) + F.lane;
#pragma unroll
        for (int j = 0; j < 8; ++j) v[j] = xr[64 * j];
        if (l > 0) { const v4u rr = *(const v4u*)(ROUTE + (size_t)m * 8); const unsigned s0 = tab[rr.x] + rr.z, s1 = tab[rr.y] + rr.w; const v2u* y0 = (const v2u*)(YG + (size_t)s0 * D) + F.lane; const v2u* y1 = (const v2u*)(YG + (size_t)s1 * D) + F.lane;
            f32x4* xw = (f32x4*)(xo + (size_t)m * D) + F.lane;
#pragma unroll
            for (int j = 0; j < 8; ++j) { const v2u a0 = y0[64 * j], a1 = y1[64 * j]; v[j].x += blo(a0.x) + blo(a1.x); v[j].y += bhi(a0.x) + bhi(a1.x); v[j].z += blo(a0.y) + blo(a1.y); v[j].w += bhi(a0.y) + bhi(a1.y); xw[64 * j] = v[j]; } }
        float ss = 0.f;
#pragma unroll
        for (int j = 0; j < 8; ++j) ss += (v[j].x * v[j].x + v[j].y * v[j].y) + (v[j].z * v[j].z + v[j].w * v[j].w);
        const float rinv = 1.0f / sqrtf(wave_sum(ss) * (1.f / D) + NORM_EPS); const f32x4* wr = (const f32x4*)w + F.lane;
#pragma unroll
        for (int j = 0; j < 8; ++j) { const f32x4 ww = wr[64 * j]; v[j] = v[j] * rinv * ww; }
        bf16* HN = (bf16*)(ws + (m < TH ? WS_HN : WS_HN1)); store_row_bf16(HN + (size_t)(m < TH ? m : m - TH) * D, F.lane, v);
        unsigned* h8 = (unsigned*)(ws + WS_HN8 + (size_t)m * D) + F.lane;
#pragma unroll
        for (int j = 0; j < 8; ++j) { const f32x4 c = __builtin_elementwise_min(__builtin_elementwise_max(v[j] * 16.f, (f32x4){-448.f, -448.f, -448.f, -448.f}), (f32x4){448.f, 448.f, 448.f, 448.f});
            unsigned w = __builtin_amdgcn_cvt_pk_fp8_f32(c.x, c.y, 0u, false); w = __builtin_amdgcn_cvt_pk_fp8_f32(c.z, c.w, w, true); h8[64 * j] = w; } }
}
__device__ __forceinline__ void ph_bias(const Frame& F0, const Args& a, int l) {
    const Frame F = refr(F0);
    if (F.vcu == 0) { unsigned char* ws = wsp(a); const float* part = (const float*)(ws + WS_CBG); float acc = inp(a, 6)[l * 512 + F.tid];
#pragma unroll 8
        for (int seg = 0; seg < 64; ++seg) acc += part[seg * 512 + F.tid];
        ((float*)(ws + WS_B1P))[F.tid] = acc; }
}
__device__ __forceinline__ void phFinal(const Frame& F0, const Args& a) {
    const Frame F = refr(F0);
    unsigned char* ws = wsp(a); float* xo = outp(a); const float* w = inp(a, 26); const unsigned* ROUTE = (const unsigned*)(ws + WS_ROUTE); const bf16* YG = (const bf16*)(ws + WS_XG); const LAS int* tab = (const LAS int*)(F.lds + MOETAB_OFF);
    moe_tables(F, 1);
    for (int m = F.gw; m < T; m += F.NGW) { f32x4 v[8]; f32x4* xr = (f32x4*)(xo + (size_t)m * D) + F.lane;
        const v4u rr = *(const v4u*)(ROUTE + (size_t)m * 8); const unsigned s0 = tab[rr.x] + rr.z, s1 = tab[rr.y] + rr.w; const v2u* y0 = (const v2u*)(YG + (size_t)s0 * D) + F.lane; const v2u* y1 = (const v2u*)(YG + (size_t)s1 * D) + F.lane;
        float ss = 0.f;
#pragma unroll
        for (int j = 0; j < 8; ++j) { v[j] = xr[64 * j]; const v2u a0 = y0[64 * j], a1 = y1[64 * j]; v[j].x += blo(a0.x) + blo(a1.x); v[j].y += bhi(a0.x) + bhi(a1.x); v[j].z += blo(a0.y) + blo(a1.y); v[j].w += bhi(a0.y) + bhi(a1.y);
            ss += (v[j].x * v[j].x + v[j].y * v[j].y) + (v[j].z * v[j].z + v[j].w * v[j].w); }
        const float rinv = 1.0f / sqrtf(wave_sum(ss) * (1.f / D) + NORM_EPS); const f32x4* wr = (const f32x4*)w + F.lane;
#pragma unroll
        for (int j = 0; j < 8; ++j) { const f32x4 ww = wr[64 * j]; xr[64 * j] = v[j] * rinv * ww; } }
}
__device__ __forceinline__ void rope_pair(bf16* p1, bf16* p2, bf16* o1, bf16* o2, float c, float s) { const float x1 = bf2f(*p1), x2 = bf2f(*p2); *o1 = (bf16)f2bf(x1 * c - x2 * s); *o2 = (bf16)f2bf(x2 * c + x1 * s); }
__device__ __forceinline__ void phC_elem(const Frame& F0, const Args& a, int l, bool split) {
    const Frame F = refr(F0);
    const int vb = split ? F.vcu - 64 : F.vcu, nb = split ? F.G - 64 : F.G; const int gtid = vb * 512 + F.tid, GT = nb * 512, gw = vb * 8 + F.wave, NGW = nb * 8;
    unsigned char* ws = wsp(a); bf16* U = (bf16*)(ws + WS_U); bf16* XC = (bf16*)(ws + WS_XC); const float* SM = (const float*)(ws + WS_SM);
    const float* cosA = (const float*)(ws + WS_TAB); const float* sinA = cosA + 4096 * 64; const float* cosC = sinA + 4096 * 64; const float* sinC = cosC + 4096 * 32;
#pragma unroll 2
    for (int idx = gtid; idx < TH * 40; idx += GT) { const int tok = idx / 40, it = idx - tok * 40, s = tok & 4095; bf16* ur = U + (size_t)tok * UP;
        if (it < 32) { const int blk = it >> 3, i8 = (it & 7) * 8; bf16* p = ur + (blk < 2 ? 1536 + blk * 128 : 2048 + (blk - 2) * 128) + i8;
            const v4u x1 = *(const v4u*)p, x2 = *(const v4u*)(p + 64); const f32x4 c0 = *(const f32x4*)(cosA + s * 64 + i8), c1 = *(const f32x4*)(cosA + s * 64 + i8 + 4), s0 = *(const f32x4*)(sinA + s * 64 + i8), s1 = *(const f32x4*)(sinA + s * 64 + i8 + 4);
            v4u o1, o2;
            o1.x = pk2(blo(x1.x) * c0.x - blo(x2.x) * s0.x, bhi(x1.x) * c0.y - bhi(x2.x) * s0.y); o2.x = pk2(blo(x2.x) * c0.x + blo(x1.x) * s0.x, bhi(x2.x) * c0.y + bhi(x1.x) * s0.y);
            o1.y = pk2(blo(x1.y) * c0.z - blo(x2.y) * s0.z, bhi(x1.y) * c0.w - bhi(x2.y) * s0.w); o2.y = pk2(blo(x2.y) * c0.z + blo(x1.y) * s0.z, bhi(x2.y) * c0.w + bhi(x1.y) * s0.w);
            o1.z = pk2(blo(x1.z) * c1.x - blo(x2.z) * s1.x, bhi(x1.z) * c1.y - bhi(x2.z) * s1.y); o2.z = pk2(blo(x2.z) * c1.x + blo(x1.z) * s1.x, bhi(x2.z) * c1.y + bhi(x1.z) * s1.y);
            o1.w = pk2(blo(x1.w) * c1.z - blo(x2.w) * s1.z, bhi(x1.w) * c1.w - bhi(x2.w) * s1.w); o2.w = pk2(blo(x2.w) * c1.z + blo(x1.w) * s1.z, bhi(x2.w) * c1.w + bhi(x1.w) * s1.w);
            *(v4u*)p = o1; *(v4u*)(p + 64) = o2; }
        else { const int q = it - 32, g = q >> 2, i8 = (q & 3) * 8; bf16* p = ur + UC_SKV + g * 64 + i8;
            const v4u x1 = *(const v4u*)p, x2 = *(const v4u*)(p + 32); const f32x4 c0 = *(const f32x4*)(cosC + s * 32 + i8), c1 = *(const f32x4*)(cosC + s * 32 + i8 + 4), s0 = *(const f32x4*)(sinC + s * 32 + i8), s1 = *(const f32x4*)(sinC + s * 32 + i8 + 4);
            v4u o1, o2;
            o1.x = pk2(blo(x1.x) * c0.x - blo(x2.x) * s0.x, bhi(x1.x) * c0.y - bhi(x2.x) * s0.y); o2.x = pk2(blo(x2.x) * c0.x + blo(x1.x) * s0.x, bhi(x2.x) * c0.y + bhi(x1.x) * s0.y);
            o1.y = pk2(blo(x1.y) * c0.z - blo(x2.y) * s0.z, bhi(x1.y) * c0.w - bhi(x2.y) * s0.w); o2.y = pk2(blo(x2.y) * c0.z + blo(x1.y) * s0.z, bhi(x2.y) * c0.w + bhi(x1.y) * s0.w);
            o1.z = pk2(blo(x1.z) * c1.x - blo(x2.z) * s1.x, bhi(x1.z) * c1.y - bhi(x2.z) * s1.y); o2.z = pk2(blo(x2.z) * c1.x + blo(x1.z) * s1.x, bhi(x2.z) * c1.y + bhi(x1.z) * s1.y);
            o1.w = pk2(blo(x1.w) * c1.z - blo(x2.w) * s1.z, bhi(x1.w) * c1.w - bhi(x2.w) * s1.w); o2.w = pk2(blo(x2.w) * c1.z + blo(x1.w) * s1.z, bhi(x2.w) * c1.w + bhi(x1.w) * s1.w);
            *(v4u*)p = o1; *(v4u*)(p + 32) = o2; } }
    const float* cw = inp(a, 8) + (size_t)l * 4 * 1536; const float* cb = inp(a, 9) + (size_t)l * 1536;
#pragma unroll 2
    for (int idx = gtid; idx < (TH / 4) * 192; idx += GT) { const int t4 = idx / 192, c8 = (idx - t4 * 192) * 8, tok = t4 * 4, s = tok & 4095;
        float w[4][8], bias[8];
#pragma unroll
        for (int k = 0; k < 4; ++k) { const f32x4 a0 = *(const f32x4*)(cw + k * 1536 + c8), a1 = *(const f32x4*)(cw + k * 1536 + c8 + 4); w[k][0] = a0.x; w[k][1] = a0.y; w[k][2] = a0.z; w[k][3] = a0.w; w[k][4] = a1.x; w[k][5] = a1.y; w[k][6] = a1.z; w[k][7] = a1.w; }
        { const f32x4 a0 = *(const f32x4*)(cb + c8), a1 = *(const f32x4*)(cb + c8 + 4); bias[0] = a0.x; bias[1] = a0.y; bias[2] = a0.z; bias[3] = a0.w; bias[4] = a1.x; bias[5] = a1.y; bias[6] = a1.z; bias[7] = a1.w; }
        float acc[4][8];
#pragma unroll
        for (int t = 0; t < 4; ++t)
#pragma unroll
            for (int e = 0; e < 8; ++e) acc[t][e] = bias[e];
#pragma unroll
        for (int r = 0; r < 7; ++r) { const int sp = s - 3 + r; v4u x = (v4u){0u, 0u, 0u, 0u}; if (sp >= 0) x = *(const v4u*)(U + (size_t)(tok - 3 + r) * UP + UC_XBC + c8);
            const float xf[8] = {blo(x.x), bhi(x.x), blo(x.y), bhi(x.y), blo(x.z), bhi(x.z), blo(x.w), bhi(x.w)};
#pragma unroll
            for (int t = 0; t < 4; ++t) { const int k = r - t; if (k >= 0 && k < 4) {
#pragma unroll
                for (int e = 0; e < 8; ++e) acc[t][e] += w[k][e] * xf[e]; } } }
#pragma unroll
        for (int t = 0; t < 4; ++t) { v4u o; o.x = pk2(acc[t][0] * sigmf(acc[t][0]), acc[t][1] * sigmf(acc[t][1])); o.y = pk2(acc[t][2] * sigmf(acc[t][2]), acc[t][3] * sigmf(acc[t][3]));
            o.z = pk2(acc[t][4] * sigmf(acc[t][4]), acc[t][5] * sigmf(acc[t][5])); o.w = pk2(acc[t][6] * sigmf(acc[t][6]), acc[t][7] * sigmf(acc[t][7])); *(v4u*)(XC + (size_t)(tok + t) * 1536 + c8) = o; } }
    float* DTV = (float*)(ws + WS_DTV); float* ACS = (float*)(ws + WS_ACS);
    for (int it = gw; it < HBN * 32 * 16; it += NGW) { const int b = it >> 9, c = (it >> 4) & 31, h = it & 15; const int tok0 = b * 4096 + c * 128 + 2 * F.lane;
        const float bias = inp(a, 10)[l * 16 + h], A = -__expf(inp(a, 11)[l * 16 + h]);
        const float r0 = SM[(size_t)tok0 * 64 + 24 + h] + bias, r1 = SM[(size_t)(tok0 + 1) * 64 + 24 + h] + bias;
        const float d0 = fmaxf(r0, 0.f) + log1pf(__expf(-fabsf(r0))), d1 = fmaxf(r1, 0.f) + log1pf(__expf(-fabsf(r1)));
        const float a0 = d0 * A, a1 = d1 * A; float x = a0 + a1;
#pragma unroll
        for (int o = 1; o < 64; o <<= 1) { const float t = __shfl_up(x, o); if (F.lane >= o) x += t; }
        DTV[(size_t)tok0 * 16 + h] = d0; DTV[(size_t)(tok0 + 1) * 16 + h] = d1; ACS[(size_t)tok0 * 16 + h] = x - a1; ACS[(size_t)(tok0 + 1) * 16 + h] = x; }
}


namespace fa {
typedef float f32x16 __attribute__((ext_vector_type(16)));
typedef short bf16x8 __attribute__((ext_vector_type(8)));
typedef short s16x4 __attribute__((ext_vector_type(4)));
typedef float f32x2_t __attribute__((ext_vector_type(2)));
typedef __bf16 bf16x2_t __attribute__((ext_vector_type(2)));
#define FA_MFMA(a, b, c) __builtin_amdgcn_mfma_f32_32x32x16_bf16((a), (b), (c), 0, 0, 0)
__device__ __forceinline__ unsigned cvtpk(float lo, float hi) { f32x2_t v = {lo, hi}; bf16x2_t b = __builtin_convertvector(v, bf16x2_t); return __builtin_bit_cast(unsigned, b); }
__device__ __forceinline__ float xhalf_max(float x) { const auto r = __builtin_amdgcn_permlane32_swap(__float_as_uint(x), __float_as_uint(x), false, false); return fmaxf(__uint_as_float(r[0]), __uint_as_float(r[1])); }
__device__ __forceinline__ float xhalf_sum(float x) { const auto r = __builtin_amdgcn_permlane32_swap(__float_as_uint(x), __float_as_uint(x), false, false); return __uint_as_float(r[0]) + __uint_as_float(r[1]); }
__device__ __forceinline__ float quad_sum(float x) { x += __builtin_bit_cast(float, __builtin_amdgcn_mov_dpp(__builtin_bit_cast(int, x), 0xB1, 0xF, 0xF, true)); x += __builtin_bit_cast(float, __builtin_amdgcn_mov_dpp(__builtin_bit_cast(int, x), 0x4E, 0xF, 0xF, true)); return x; }
__device__ __forceinline__ int crow(int reg, int h) { return (reg & 3) + 8 * (reg >> 2) + 4 * h; }
constexpr int VP = 144;
template <int DH> struct Geo { static constexpr int KP = DH * 2 + 16, KBYTES = 64 * KP, VBYTES = DH * VP, BUF = KBYTES + VBYTES, NCH = DH / 64  ; };

template <int DH> struct Stage { v4u k[Geo<DH>::NCH], v[Geo<DH>::NCH]; };
template <int DH>
__device__ __forceinline__ void tile_load(Stage<DH>& st, const bf16* Kb, int kpitch, const bf16* VTb, int vtpitch, int key0, int tid) {
#pragma unroll
    for (int i = 0; i < Geo<DH>::NCH; ++i) { const int c = tid + i * 512; const int row = c / (DH / 8), col8 = c % (DH / 8); st.k[i] = *(const v4u*)(Kb + (size_t)(key0 + row) * kpitch + col8 * 8);
        const int d = c >> 3, k8 = c & 7; st.v[i] = *(const v4u*)(VTb + (size_t)d * vtpitch + key0 + k8 * 8); }
}
template <int DH>
__device__ __forceinline__ void tile_store(const Stage<DH>& st, LAS unsigned char* buf, int tid) {
#pragma unroll
    for (int i = 0; i < Geo<DH>::NCH; ++i) { const int c = tid + i * 512; const int row = c / (DH / 8), col8 = c % (DH / 8); *(LAS v4u*)(buf + row * Geo<DH>::KP + col8 * 16) = st.k[i];
        const int d = c >> 3, k8 = c & 7; *(LAS v4u*)(buf + Geo<DH>::KBYTES + d * VP + k8 * 16) = st.v[i]; }
}
template <int DH>
__device__ __forceinline__ void qk_tile(const LAS unsigned char* buf, const bf16x8 (&qf)[DH / 16], int r32, int h, f32x16& s0, f32x16& s1) {
#pragma unroll
    for (int i = 0; i < 16; ++i) { s0[i] = 0.f; s1[i] = 0.f; }
    const LAS unsigned char* p0 = buf + r32 * Geo<DH>::KP + 16 * h; const LAS unsigned char* p1 = p0 + 32 * Geo<DH>::KP;
    constexpr int NG = DH / 32;
    bf16x8 a[2][2], b[2][2];
#pragma unroll
    for (int q = 0; q < 2; ++q) { a[0][q] = *(const LAS bf16x8*)(p0 + 32 * q); b[0][q] = *(const LAS bf16x8*)(p1 + 32 * q); }
    __builtin_amdgcn_sched_barrier(0);
#pragma unroll
    for (int g = 0; g < NG; ++g) {
        if (g + 1 < NG) {
#pragma unroll
            for (int q = 0; q < 2; ++q) { a[(g + 1) & 1][q] = *(const LAS bf16x8*)(p0 + 32 * (2 * (g + 1) + q)); b[(g + 1) & 1][q] = *(const LAS bf16x8*)(p1 + 32 * (2 * (g + 1) + q)); } }
        __builtin_amdgcn_sched_barrier(0);
#pragma unroll
        for (int q = 0; q < 2; ++q) { s0 = FA_MFMA(a[g & 1][q], qf[2 * g + q], s0); s1 = FA_MFMA(b[g & 1][q], qf[2 * g + q], s1); }
        __builtin_amdgcn_sched_barrier(0); }
}
template <int DH>
__device__ __forceinline__ void pv_tile(const LAS unsigned char* buf, const bf16x8 (&pf)[2][2], int r32, int h, f32x16 (&ot)[DH / 32]) {
    constexpr int NB = DH / 32; const LAS unsigned char* vb = buf + Geo<DH>::KBYTES + r32 * VP + 16 * h;
    bf16x8 a[2][NB];
#pragma unroll
    for (int db = 0; db < NB; ++db) a[0][db] = *(const LAS bf16x8*)(vb + 32 * db * VP);
    __builtin_amdgcn_sched_barrier(0);
#pragma unroll
    for (int t = 0; t < 4; ++t) {
        if (t < 3) {
#pragma unroll
            for (int db = 0; db < NB; ++db) a[(t + 1) & 1][db] = *(const LAS bf16x8*)(vb + 32 * db * VP + 32 * (t + 1)); }
        __builtin_amdgcn_sched_barrier(0);
#pragma unroll
        for (int db = 0; db < NB; ++db) ot[db] = FA_MFMA(a[t & 1][db], pf[t >> 1][t & 1], ot[db]);
        __builtin_amdgcn_sched_barrier(0); }
}
__device__ __forceinline__ void pack_p(const f32x16& p, bf16x8 (&pf)[2]) {
#pragma unroll
    for (int s = 0; s < 2; ++s) { v4u w; w.x = cvtpk(p[8 * s], p[8 * s + 1]); w.y = cvtpk(p[8 * s + 2], p[8 * s + 3]); w.z = cvtpk(p[8 * s + 4], p[8 * s + 5]); w.w = cvtpk(p[8 * s + 6], p[8 * s + 7]); pf[s] = __builtin_bit_cast(bf16x8, w); }
}
template <int DH>
__device__ __forceinline__ void load_qf(const bf16* qrow, int h, float sc, bf16x8 (&qf)[DH / 16]) {
#pragma unroll
    for (int ks = 0; ks < DH / 16; ++ks) { const v4u w = *(const v4u*)(qrow + 16 * ks + 8 * h); v4u o;
        o.x = cvtpk(blo(w.x) * sc, bhi(w.x) * sc); o.y = cvtpk(blo(w.y) * sc, bhi(w.y) * sc); o.z = cvtpk(blo(w.z) * sc, bhi(w.z) * sc); o.w = cvtpk(blo(w.w) * sc, bhi(w.w) * sc); qf[ks] = __builtin_bit_cast(bf16x8, o); }
}
template <int DH>
__device__ __forceinline__ void load_qf_rope(const bf16* qrow, int h, float sc, const float* cs, const float* sn, bf16x8 (&qf)[DH / 16]) {
#pragma unroll
    for (int ks = 0; ks < DH / 32; ++ks) { const int i0 = 16 * ks + 8 * h; const v4u a = *(const v4u*)(qrow + i0), b = *(const v4u*)(qrow + DH / 2 + i0);
        const f32x4 c0 = *(const f32x4*)(cs + i0), c1 = *(const f32x4*)(cs + i0 + 4), s0 = *(const f32x4*)(sn + i0), s1 = *(const f32x4*)(sn + i0 + 4);
        const float x1[8] = {blo(a.x), bhi(a.x), blo(a.y), bhi(a.y), blo(a.z), bhi(a.z), blo(a.w), bhi(a.w)}, x2[8] = {blo(b.x), bhi(b.x), blo(b.y), bhi(b.y), blo(b.z), bhi(b.z), blo(b.w), bhi(b.w)};
        const float c[8] = {c0.x, c0.y, c0.z, c0.w, c1.x, c1.y, c1.z, c1.w}, s[8] = {s0.x, s0.y, s0.z, s0.w, s1.x, s1.y, s1.z, s1.w};
        float y1[8], y2[8];
#pragma unroll
        for (int e = 0; e < 8; ++e) { y1[e] = (x1[e] * c[e] - x2[e] * s[e]) * sc; y2[e] = (x2[e] * c[e] + x1[e] * s[e]) * sc; }
        v4u o1, o2; o1.x = cvtpk(y1[0], y1[1]); o1.y = cvtpk(y1[2], y1[3]); o1.z = cvtpk(y1[4], y1[5]); o1.w = cvtpk(y1[6], y1[7]); o2.x = cvtpk(y2[0], y2[1]); o2.y = cvtpk(y2[2], y2[3]); o2.z = cvtpk(y2[4], y2[5]); o2.w = cvtpk(y2[6], y2[7]);
        qf[ks] = __builtin_bit_cast(bf16x8, o1); qf[ks + DH / 32] = __builtin_bit_cast(bf16x8, o2); }
}
template <int DH, class V>
__device__ __forceinline__ void softmax_step(f32x16& s0, f32x16& s1, int h, bool laneoff, bool domask, const V& valid, float& m, float& l, f32x16 (&ot)[DH / 32], bf16x8 (&pf)[2][2]) {
    if (domask) {
#pragma unroll
        for (int i = 0; i < 16; ++i) { if (!valid(crow(i, h))) s0[i] = -1e30f; if (!valid(32 + crow(i, h))) s1[i] = -1e30f; } }
    float mx = fmaxf(s0[0], s1[0]);
#pragma unroll
    for (int i = 1; i < 16; ++i) mx = fmaxf(mx, fmaxf(s0[i], s1[i]));
    mx = xhalf_max(mx);
    const float mn = laneoff ? m : fmaxf(m, mx); const float al = __builtin_amdgcn_exp2f(m - mn); m = mn;
    const float mb = laneoff ? 3e38f : mn;
    float sum = 0.f;
#pragma unroll
    for (int i = 0; i < 16; ++i) { float p0 = __builtin_amdgcn_exp2f(s0[i] - mb), p1 = __builtin_amdgcn_exp2f(s1[i] - mb);
        if (domask) { if (s0[i] <= -1e30f) p0 = 0.f; if (s1[i] <= -1e30f) p1 = 0.f; }
        s0[i] = p0; s1[i] = p1; sum += p0 + p1; }
    l = l * al + sum;
    if (__any(al != 1.0f)) {
#pragma unroll
        for (int db = 0; db < DH / 32; ++db)
#pragma unroll
            for (int i = 0; i < 16; ++i) ot[db][i] *= al; }
    pack_p(s0, pf[0]); pack_p(s1, pf[1]);
}
}

template <int DH, class MaskF>
__device__ __forceinline__ void fa_unit(LAS unsigned char* lds, int tid, const bf16* Kb, int kpitch, const bf16* VTb, int vtpitch, int jt0, int jt1,
                                        const bf16* qrow, float qscale, const float* rcs, const float* rsn, const MaskF& mf, float& m, float& l, fa::f32x16 (&ot)[DH / 32]) {
    const int lane = tid & 63, r32 = lane & 31, h = lane >> 5;
    fa::bf16x8 qf[DH / 16]; fa::load_qf_rope<DH>(qrow, h, qscale, rcs, rsn, qf);
    fa::Stage<DH> st; fa::tile_load<DH>(st, Kb, kpitch, VTb, vtpitch, jt0 * 64, tid);
    for (int j = jt0; j <= jt1; ++j) {
        LAS unsigned char* buf = lds + ((j - jt0) & 1) * fa::Geo<DH>::BUF;
        fa::tile_store<DH>(st, buf, tid);
        __syncthreads();
        if (j < jt1) fa::tile_load<DH>(st, Kb, kpitch, VTb, vtpitch, (j + 1) * 64, tid);
        if (!mf.skip(j)) {
            fa::f32x16 s0, s1; fa::qk_tile<DH>(buf, qf, r32, h, s0, s1);
            fa::bf16x8 pf[2][2];
            fa::softmax_step<DH>(s0, s1, h, mf.laneoff(j), mf.domask(j), [&](int kl) { return mf.valid(j, kl); }, m, l, ot, pf);
            fa::pv_tile<DH>(buf, pf, r32, h, ot);
        }
    }
    __syncthreads();
}
struct BandMask {
    int sq, sq0, W;
    __device__ __forceinline__ bool skip(int j) const { return 64 * j > sq0 + 31 || 64 * j + 63 + W <= sq0; }
    __device__ __forceinline__ bool laneoff(int) const { return false; }
    __device__ __forceinline__ bool domask(int j) const { return !(64 * j + 63 <= sq0 && 64 * j + W > sq0 + 31); }
    __device__ __forceinline__ bool valid(int j, int kl) const { const int key = 64 * j + kl; return key <= sq && key + W > sq; }
};
struct SlcMask {
    int sq, sq0; unsigned mlo, mhi;
    __device__ __forceinline__ bool sel(int j) const { return ((j < 32 ? (mlo >> j) : (mhi >> (j - 32))) & 1u) != 0u; }
    __device__ __forceinline__ bool skip(int j) const { return __ballot(sel(j)) == 0ull; }
    __device__ __forceinline__ bool laneoff(int j) const { return !sel(j); }
    __device__ __forceinline__ bool domask(int j) const { return 64 * j + 63 > sq0; }
    __device__ __forceinline__ bool valid(int j, int kl) const { return 64 * j + kl <= sq; }
};
constexpr float LOG2E = 1.4426950408889634f;
__device__ __forceinline__ bool unit_map(const Frame& F, int i, int nqt, bool zig, int& bg, int& qt) {
    if (F.G == 256) { if (32 * i >= nqt) return false; bg = F.vcu >> 5; const int q = F.vcu & 31; qt = 32 * i + ((zig && (i & 1)) ? 31 - q : q); return true; }
    const int u = i * F.G + F.vcu; if (u >= 8 * nqt) return false; bg = u & 7; qt = u >> 3; return true;
}

__device__ __forceinline__ void ph_win_mfma(const Frame& F0, const Args& a) {
    const Frame F = refr(F0);
    unsigned char* ws = wsp(a); const bf16* U = (const bf16*)(ws + WS_U); bf16* OA = (bf16*)(ws + WS_OA); const float* SM = (const float*)(ws + WS_SM); const bf16* VT = (const bf16*)(ws + WS_VTW); const float* cosA = (const float*)(ws + WS_TAB); const float* sinA = cosA + 4096 * 64;
    const int r32 = F.lane & 31, h = F.lane >> 5, r = F.wave >> 1, toff = (F.wave & 1) * 32 + r32;
    for (int ui = 0;; ++ui) { int bg, qt; if (!unit_map(F, ui, 64, false, bg, qt)) break; const int b = bg >> 1, g = bg & 1; const int sq = qt * 64 + toff, tok = b * 4096 + sq;
        float m = -1e30f, l = 0.f; fa::f32x16 ot[4];
#pragma unroll
        for (int db = 0; db < 4; ++db)
#pragma unroll
            for (int i = 0; i < 16; ++i) ot[db][i] = 0.f;
        const BandMask mf{sq, qt * 64 + (F.wave & 1) * 32, 512};
        fa_unit<128, BandMask>(F.lds, F.tid, U + (size_t)(b * 4096) * UP + 2048 + g * 128, UP, VT + (size_t)((b * 2 + g) * 128) * 4096, 4096, qt > 8 ? qt - 8 : 0, qt,
                               U + (size_t)tok * UP + UC_Q + (g * 4 + r) * 128, 0.08838834764831845f * LOG2E, cosA + sq * 64, sinA + sq * 64, mf, m, l, ot);
        l = fa::xhalf_sum(l); const float sc = sigmf(SM[(size_t)tok * 64 + (g * 4 + r) * 3 + 2]) / l; bf16* op = OA + (size_t)tok * 1024 + (g * 4 + r) * 128;
#pragma unroll
        for (int db = 0; db < 4; ++db)
#pragma unroll
            for (int q = 0; q < 4; ++q) { v2u w; w.x = fa::cvtpk(ot[db][4 * q] * sc, ot[db][4 * q + 1] * sc); w.y = fa::cvtpk(ot[db][4 * q + 2] * sc, ot[db][4 * q + 3] * sc); *(v2u*)(op + 32 * db + 8 * q + 4 * h) = w; } }
}
__device__ __forceinline__ void ph_slc_mfma(const Frame& F0, const Args& a, bf16* OA) {
    const Frame F = refr(F0);
    unsigned char* ws = wsp(a); const bf16* U = (const bf16*)(ws + WS_U); const float* SM = (const float*)(ws + WS_SM); const bf16* VT = (const bf16*)(ws + WS_VTS); const float* cosA = (const float*)(ws + WS_TAB); const float* sinA = cosA + 4096 * 64;
    const unsigned long long* SEL = (const unsigned long long*)(ws + WS_SEL);
    const int r32 = F.lane & 31, h = F.lane >> 5, r = F.wave >> 1, toff = (F.wave & 1) * 32 + r32; constexpr int NU = HBN * 2 * 64;
    for (int i = 0;; ++i) { int bg, qt; if (!unit_map(F, i, 64, true, bg, qt)) break; const int b = bg >> 1, g = bg & 1; const int sq = qt * 64 + toff, tok = b * 4096 + sq;
        const unsigned long long mk = SEL[(size_t)(b * 2 + g) * 4096 + sq];
        float m = -1e30f, l = 0.f; fa::f32x16 ot[4];
#pragma unroll
        for (int db = 0; db < 4; ++db)
#pragma unroll
            for (int i2 = 0; i2 < 16; ++i2) ot[db][i2] = 0.f;
        const SlcMask mf{sq, qt * 64 + (F.wave & 1) * 32, (unsigned)mk, (unsigned)(mk >> 32)};
        fa_unit<128, SlcMask>(F.lds, F.tid, U + (size_t)(b * 4096) * UP + 1536 + g * 128, UP, VT + (size_t)((b * 2 + g) * 128) * 4096, 4096, 0, qt,
                              U + (size_t)tok * UP + UC_Q + (g * 4 + r) * 128, 0.08838834764831845f * LOG2E, cosA + sq * 64, sinA + sq * 64, mf, m, l, ot);
        l = fa::xhalf_sum(l); const float sc = sigmf(SM[(size_t)tok * 64 + (g * 4 + r) * 3 + 1]) / l; bf16* op = OA + (size_t)tok * 1024 + (g * 4 + r) * 128;
#pragma unroll
        for (int db = 0; db < 4; ++db)
#pragma unroll
            for (int q = 0; q < 4; ++q) { v2u* p = (v2u*)(op + 32 * db + 8 * q + 4 * h); const v2u o = *p; v2u w;
                w.x = fa::cvtpk(blo(o.x) + ot[db][4 * q] * sc, bhi(o.x) + ot[db][4 * q + 1] * sc); w.y = fa::cvtpk(blo(o.y) + ot[db][4 * q + 2] * sc, bhi(o.y) + ot[db][4 * q + 3] * sc); *p = w; } }
}
__device__ __forceinline__ void ph_swa_mfma(const Frame& F0, const Args& a, int ly) {
    const Frame F = refr(F0);
    unsigned char* ws = wsp(a); const bf16* U = (const bf16*)(ws + WS_U); bf16* OC = (bf16*)(ws + WS_OC); const bf16* VT = (const bf16*)(ws + WS_VTC); const float* cosC = (const float*)(ws + WS_TAB) + 2 * 4096 * 64; const float* sinC = cosC + 4096 * 32;
    const int r32 = F.lane & 31, h = F.lane >> 5, r = F.wave;
    for (int ui = 0;; ++ui) { int bg, qt; if (!unit_map(F, ui, 128, false, bg, qt)) break; const int b = bg >> 1, g = bg & 1; const int sq = qt * 32 + r32, tok = b * 4096 + sq;
        float m = inp(a, 14)[ly * 16 + g * 8 + r] * LOG2E, l = h == 0 ? 1.f : 0.f; fa::f32x16 ot[2];
#pragma unroll
        for (int db = 0; db < 2; ++db)
#pragma unroll
            for (int i = 0; i < 16; ++i) ot[db][i] = 0.f;
        const BandMask mf{sq, qt * 32, 128}; const int jt1 = qt >> 1;
        fa_unit<64, BandMask>(F.lds, F.tid, U + (size_t)(b * 4096) * UP + UC_SKV + g * 64, UP, VT + (size_t)((b * 2 + g) * 64) * 4096, 4096, jt1 > 2 ? jt1 - 2 : 0, jt1,
                              U + (size_t)tok * UP + UC_SQ + (g * 8 + r) * 64, 0.125f * LOG2E, cosC + sq * 32, sinC + sq * 32, mf, m, l, ot);
        l = fa::xhalf_sum(l); const float sc = 1.0f / l; bf16* op = OC + (size_t)tok * 1024 + (g * 8 + r) * 64;
#pragma unroll
        for (int db = 0; db < 2; ++db)
#pragma unroll
            for (int q = 0; q < 4; ++q) { v2u w; w.x = fa::cvtpk(ot[db][4 * q] * sc, ot[db][4 * q + 1] * sc); w.y = fa::cvtpk(ot[db][4 * q + 2] * sc, ot[db][4 * q + 3] * sc); *(v2u*)(op + 32 * db + 8 * q + 4 * h) = w; } }
}
__device__ __forceinline__ void ph_cmp_mfma(const Frame& F0, const Args& a) {
    const Frame F = refr(F0);
    unsigned char* ws = wsp(a); const bf16* U = (const bf16*)(ws + WS_U); bf16* OA = (bf16*)(ws + WS_OA); const float* SM = (const float*)(ws + WS_SM);
    const bf16* KC = (const bf16*)(ws + WS_KC); const bf16* VCT = (const bf16*)(ws + WS_VCT); unsigned long long* SEL = (unsigned long long*)(ws + WS_SEL);
    const int lane = F.lane, r32 = lane & 31, h = lane >> 5, r = r32 & 3, tl = F.wave * 8 + (r32 >> 2);
    constexpr int BUF = fa::Geo<128>::BUF; constexpr int PP = 257;
    LAS float* psum = (LAS float*)(F.lds + 40960) + F.wave * 8 * PP;
    for (int ui = 0;; ++ui) { int bg, qt; if (!unit_map(F, ui, 64, false, bg, qt)) break; const int b = bg >> 1, g = bg & 1; const int sq = qt * 64 + tl, tok = b * 4096 + sq;
        const int nvis = sq >= 31 ? ((sq - 31) >> 4) + 1 : 0; const int nvmax = ((qt * 64 + 63 - 31) >> 4) + 1, jt1 = (nvmax - 1) >> 6;
        const int nvw = (qt * 64 + F.wave * 8 + 7 >= 31) ? ((qt * 64 + F.wave * 8 + 7 - 31) >> 4) + 1 : 0;
        const bf16* Kb = KC + (size_t)((b * 2 + g) * 256) * 128; const bf16* VTb = VCT + (size_t)((b * 2 + g) * 128) * 256;
        fa::bf16x8 qf[8]; fa::load_qf<128>(U + (size_t)tok * UP + UC_Q + (g * 4 + r) * 128, h, 0.08838834764831845f * LOG2E, qf);
        for (int i = lane; i < 8 * PP; i += 64) psum[i] = 0.f;
        float m = -1e30f, l = 0.f;
        fa::Stage<128> st; fa::tile_load<128>(st, Kb, 128, VTb, 256, 0, F.tid);
        for (int j = 0; j <= jt1; ++j) {
            __syncthreads(); fa::tile_store<128>(st, F.lds, F.tid); __syncthreads();
            fa::tile_load<128>(st, Kb, 128, VTb, 256, (j < jt1 ? j + 1 : 0) * 64, F.tid);
            if (64 * j < nvw) { fa::f32x16 s0, s1; fa::qk_tile<128>(F.lds, qf, r32, h, s0, s1); float mx = -1e30f;
#pragma unroll
                for (int i = 0; i < 16; ++i) { if (64 * j + fa::crow(i, h) >= nvis) s0[i] = -1e30f; if (64 * j + 32 + fa::crow(i, h) >= nvis) s1[i] = -1e30f; mx = fmaxf(mx, fmaxf(s0[i], s1[i])); }
                mx = fa::xhalf_max(mx); const float mn = fmaxf(m, mx); float sum = 0.f;
#pragma unroll
                for (int i = 0; i < 16; ++i) { sum += (s0[i] <= -1e30f ? 0.f : __builtin_amdgcn_exp2f(s0[i] - mn)) + (s1[i] <= -1e30f ? 0.f : __builtin_amdgcn_exp2f(s1[i] - mn)); }
                l = l * __builtin_amdgcn_exp2f(m - mn) + sum; m = mn; } }
        l = fa::xhalf_sum(l); const float linv = l > 0.f ? 1.0f / l : 0.f;
        fa::f32x16 ot[4];
#pragma unroll
        for (int db = 0; db < 4; ++db)
#pragma unroll
            for (int i = 0; i < 16; ++i) ot[db][i] = 0.f;
        for (int j = 0; j <= jt1; ++j) {
            __syncthreads(); fa::tile_store<128>(st, F.lds, F.tid); __syncthreads();
            if (j < jt1) fa::tile_load<128>(st, Kb, 128, VTb, 256, (j + 1) * 64, F.tid);
            if (64 * j < nvw) { fa::f32x16 s0, s1; fa::qk_tile<128>(F.lds, qf, r32, h, s0, s1);
#pragma unroll
                for (int i = 0; i < 16; ++i) { const int n0 = 64 * j + fa::crow(i, h), n1 = n0 + 32;
                    const float p0 = n0 < nvis ? __builtin_amdgcn_exp2f(s0[i] - m) * linv : 0.f, p1 = n1 < nvis ? __builtin_amdgcn_exp2f(s1[i] - m) * linv : 0.f; s0[i] = p0; s1[i] = p1;
                    const float t0 = fa::quad_sum(p0), t1 = fa::quad_sum(p1);
                    if (r == 0) { psum[(r32 >> 2) * PP + n0] = t0; psum[(r32 >> 2) * PP + n1] = t1; } }
                fa::bf16x8 pf[2][2]; fa::pack_p(s0, pf[0]); fa::pack_p(s1, pf[1]);
                fa::pv_tile<128>(F.lds, pf, r32, h, ot); } }
        { const float sc = sigmf(SM[(size_t)tok * 64 + (g * 4 + r) * 3 + 0]); bf16* op = OA + (size_t)tok * 1024 + (g * 4 + r) * 128;
#pragma unroll
          for (int db = 0; db < 4; ++db)
#pragma unroll
            for (int q = 0; q < 4; ++q) { v2u* p = (v2u*)(op + 32 * db + 8 * q + 4 * h); const v2u o = *p; v2u w;
                w.x = fa::cvtpk(blo(o.x) + ot[db][4 * q] * sc, bhi(o.x) + ot[db][4 * q + 1] * sc); w.y = fa::cvtpk(blo(o.y) + ot[db][4 * q + 2] * sc, bhi(o.y) + ot[db][4 * q + 3] * sc); *p = w; } }
        LDS_WAIT();
        for (int t = 0; t < 8; ++t) { const int s = qt * 64 + F.wave * 8 + t, qb = s >> 6; float imp = 0.f; const int n0 = 4 * lane - 1;
#pragma unroll
            for (int k = 0; k < 5; ++k) { const int n = n0 + k; if (n >= 0 && n <= 254) imp += psum[t * PP + n]; }
            unsigned long long mask;
            if (qb <= 15) mask = (2ull << qb) - 1ull;
            else { const bool cand = lane >= 1 && lane <= qb - 2; const float v = cand ? imp : -1.f; int rank = 0;
                for (int jj = 0; jj < 64; ++jj) { const float vj = __shfl(v, jj); rank += (vj > v || (vj == v && jj < lane)) ? 1 : 0; }
                mask = __ballot(cand && rank < 13) | 1ull | (1ull << qb) | (1ull << (qb - 1)); }
            if (lane == 0) SEL[(size_t)(b * 2 + g) * 4096 + s] = mask; }
        LDS_WAIT();
        __syncthreads();
    }
}


namespace ssd {
constexpr int TP = 136;
constexpr int TILE128 = 128 * TP * 2;
constexpr int XT_BYTES = 64 * TP * 2;
__device__ __forceinline__ void stage_rows(LAS unsigned char* dst, const bf16* src  , int tid) {
#pragma unroll
    for (int i = 0; i < 4; ++i) { const int c = tid + i * 512, row = c >> 4, c8 = c & 15; *(LAS v4u*)(dst + (row * TP + c8 * 8) * 2) = *(const v4u*)(src + (size_t)row * 1536 + c8 * 8); }
}
__device__ __forceinline__ void stage_rows_T(LAS unsigned char* dst, const bf16* src, int tid) {
#pragma unroll
    for (int i = 0; i < 4; ++i) { const int c = tid + i * 512, row = c & 127, c8 = c >> 7; const v4u w = *(const v4u*)(src + (size_t)row * 1536 + c8 * 8); LAS bf16* d = (LAS bf16*)dst + (c8 * 8) * TP + sw16(row);
        d[0] = (bf16)(w.x & 0xffffu); d[TP] = (bf16)(w.x >> 16); d[2 * TP] = (bf16)(w.y & 0xffffu); d[3 * TP] = (bf16)(w.y >> 16); d[4 * TP] = (bf16)(w.z & 0xffffu); d[5 * TP] = (bf16)(w.z >> 16); d[6 * TP] = (bf16)(w.w & 0xffffu); d[7 * TP] = (bf16)(w.w >> 16); }
}
__device__ __forceinline__ void xT_load(v4u (&r)[8], const bf16* src  , int t) {
#pragma unroll
    for (int i = 0; i < 8; ++i) r[i] = *(const v4u*)(src + (size_t)t * 1536 + i * 8);
}
__device__ __forceinline__ void xT_store(LAS unsigned char* dst, const v4u (&r)[8], int t) {
    LAS bf16* d = (LAS bf16*)dst + sw16(t);
#pragma unroll
    for (int i = 0; i < 8; ++i) { const v4u w = r[i]; LAS bf16* dd = d + (i * 8) * TP;
        dd[0] = (bf16)(w.x & 0xffffu); dd[TP] = (bf16)(w.x >> 16); dd[2 * TP] = (bf16)(w.y & 0xffffu); dd[3 * TP] = (bf16)(w.y >> 16); dd[4 * TP] = (bf16)(w.z & 0xffffu); dd[5 * TP] = (bf16)(w.z >> 16); dd[6 * TP] = (bf16)(w.w & 0xffffu); dd[7 * TP] = (bf16)(w.w >> 16); }
}
}

__device__ __forceinline__ void ph_states_mfma(const Frame& F0, const Args& a) {
    const Frame F = refr(F0);
    unsigned char* ws = wsp(a); const bf16* XC = (const bf16*)(ws + WS_XC); const float* DTV = (const float*)(ws + WS_DTV); const float* ACS = (const float*)(ws + WS_ACS); float* ST = (float*)(ws + WS_ST);
    const int lane = F.lane, r32 = lane & 31, h2 = lane >> 5, hq = F.wave >> 1, nh = F.wave & 1;
    LAS unsigned char* BT = F.lds; LAS unsigned char* XT = F.lds + ssd::TILE128; LAS float* WL = (LAS float*)(F.lds + ssd::TILE128 + 4 * ssd::XT_BYTES);
    for (int it = F.vcu; it < HBN * 32 * 2; it += F.G) { const int g = it & 1, bc = it >> 1; const size_t tok0 = (size_t)bc * 128;
        __syncthreads();
        v4u xr[8]; ssd::xT_load(xr, XC + tok0 * 1536 + (g * 8 + hq) * 64, nh * 64 + lane);
        ssd::stage_rows_T(BT, XC + tok0 * 1536 + 1024 + g * 128, F.tid);
#pragma unroll
        for (int i2 = 0; i2 < 2; ++i2) { const int i = F.tid + i2 * 512; const int hh = i >> 7, l = i & 127, h = g * 8 + hh; WL[hh * 128 + sw16(l)] = __expf(ACS[(tok0 + 127) * 16 + h] - ACS[(tok0 + l) * 16 + h]) * DTV[(tok0 + l) * 16 + h]; }
#pragma unroll 1
        for (int sub = 0; sub < 2; ++sub) { const int hh = sub * 4 + hq, h = g * 8 + hh;
            if (sub) __syncthreads();
            ssd::xT_store(XT + hq * ssd::XT_BYTES, xr, nh * 64 + lane);
            if (sub == 0) ssd::xT_load(xr, XC + tok0 * 1536 + (g * 8 + 4 + hq) * 64, nh * 64 + lane);
            __syncthreads();
            fa::f32x16 acc[2][2];
#pragma unroll
            for (int nb = 0; nb < 2; ++nb)
#pragma unroll
                for (int pb = 0; pb < 2; ++pb)
#pragma unroll
                    for (int i = 0; i < 16; ++i) acc[nb][pb][i] = 0.f;
            const LAS unsigned char* xt = XT + hq * ssd::XT_BYTES;
#pragma unroll 2
            for (int ks = 0; ks < 8; ++ks) { const int l0 = 16 * ks + 8 * h2; const f32x4 w0 = *(const LAS f32x4*)(WL + hh * 128 + l0), w1 = *(const LAS f32x4*)(WL + hh * 128 + l0 + 4);
                fa::bf16x8 A[2], B[2];
#pragma unroll
                for (int pb = 0; pb < 2; ++pb) { const v4u x = *(const LAS v4u*)(xt + ((32 * pb + r32) * ssd::TP + l0) * 2); v4u o;
                    o.x = fa::cvtpk(blo(x.x) * w0.x, bhi(x.x) * w0.y); o.y = fa::cvtpk(blo(x.y) * w0.z, bhi(x.y) * w0.w); o.z = fa::cvtpk(blo(x.z) * w1.x, bhi(x.z) * w1.y); o.w = fa::cvtpk(blo(x.w) * w1.z, bhi(x.w) * w1.w); A[pb] = __builtin_bit_cast(fa::bf16x8, o); }
#pragma unroll
                for (int nb = 0; nb < 2; ++nb) B[nb] = *(const LAS fa::bf16x8*)(BT + ((32 * (2 * nh + nb) + r32) * ssd::TP + l0) * 2);
#pragma unroll
                for (int nb = 0; nb < 2; ++nb)
#pragma unroll
                    for (int pb = 0; pb < 2; ++pb) acc[nb][pb] = FA_MFMA(A[pb], B[nb], acc[nb][pb]); }
            float* o = ST + ((size_t)bc * 16 + h) * 8192;
#pragma unroll
            for (int nb = 0; nb < 2; ++nb)
#pragma unroll
                for (int pb = 0; pb < 2; ++pb)
#pragma unroll
                    for (int i = 0; i < 16; ++i) o[(32 * pb + fa::crow(i, h2)) * 128 + 32 * (2 * nh + nb) + r32] = acc[nb][pb][i];
        }
    }
    __syncthreads();
}
__device__ __forceinline__ void ph_scan2(const Frame& F0, const Args& a) {
    const Frame F = refr(F0);
    const float* ACS = (const float*)(wsp(a) + WS_ACS); float* ST = (float*)(wsp(a) + WS_ST);
    for (int idx = F.gtid; idx < HBN * 16 * 8192; idx += F.GT) { const int np = idx & 8191, h = (idx >> 13) & 15, b = idx >> 17; float st[32], dec[32];
#pragma unroll
        for (int c = 0; c < 32; ++c) { st[c] = ST[((size_t)(b * 32 + c) * 16 + h) * 8192 + np]; dec[c] = ACS[((size_t)b * 4096 + c * 128 + 127) * 16 + h]; }
        float hc = 0.f;
#pragma unroll
        for (int c = 0; c < 32; ++c) { ST[((size_t)(b * 32 + c) * 16 + h) * 8192 + np] = hc; hc = hc * __expf(dec[c]) + st[c]; } }
}
__device__ __forceinline__ void ph_ssdy_mfma(const Frame& F0, const Args& a, int ly) {
    const Frame F = refr(F0);
    unsigned char* ws = wsp(a); const bf16* XC = (const bf16*)(ws + WS_XC); const float* DTV = (const float*)(ws + WS_DTV); const float* ACS = (const float*)(ws + WS_ACS); const float* ST = (const float*)(ws + WS_ST);
    const bf16* U = (const bf16*)(ws + WS_U); float* YD = (float*)(ws + WS_YD); bf16* OB = (bf16*)(ws + WS_OB);
    const int lane = F.lane, r32 = lane & 31, h2 = lane >> 5, hq = F.wave >> 1, wl = F.wave & 1;
    LAS unsigned char* BM = F.lds; LAS unsigned char* XT = F.lds + ssd::TILE128; LAS float* AC = (LAS float*)(F.lds + ssd::TILE128 + 4 * ssd::XT_BYTES); LAS float* DT = AC + 1024; LAS float* SSQ = DT + 1024; LAS float* RINV = SSQ + 1024;
    for (int it = F.vcu; it < HBN * 32 * 2; it += F.G) { const int g = it & 1, bc = it >> 1; const size_t tok0 = (size_t)bc * 128;
        __syncthreads();
        v4u xr[8]; ssd::xT_load(xr, XC + tok0 * 1536 + (g * 8 + hq) * 64, wl * 64 + lane);
        ssd::stage_rows(BM, XC + tok0 * 1536 + 1024 + g * 128, F.tid);
#pragma unroll
        for (int i2 = 0; i2 < 2; ++i2) { const int i = F.tid + i2 * 512; const int hh = i >> 7, l = i & 127, h = g * 8 + hh; AC[i] = ACS[(tok0 + l) * 16 + h]; DT[i] = DTV[(tok0 + l) * 16 + h]; }
#pragma unroll 1
        for (int sub = 0; sub < 2; ++sub) { const int hh = sub * 4 + hq, h = g * 8 + hh;
            if (sub) __syncthreads();
            ssd::xT_store(XT + hq * ssd::XT_BYTES, xr, wl * 64 + lane);
            if (sub == 0) ssd::xT_load(xr, XC + tok0 * 1536 + (g * 8 + 4 + hq) * 64, wl * 64 + lane);
            __syncthreads();
            const LAS unsigned char* xt = XT + hq * ssd::XT_BYTES; const float dsk = inp(a, 12)[ly * 16 + h];
            fa::bf16x8 hf[2][8]; { const float* hin = ST + ((size_t)bc * 16 + h) * 8192;
#pragma unroll
                for (int pb = 0; pb < 2; ++pb)
#pragma unroll
                    for (int ks = 0; ks < 8; ++ks) { const f32x4 v0 = *(const f32x4*)(hin + (32 * pb + r32) * 128 + 16 * ks + 8 * h2), v1 = *(const f32x4*)(hin + (32 * pb + r32) * 128 + 16 * ks + 8 * h2 + 4);
                        v4u o; o.x = fa::cvtpk(v0.x, v0.y); o.y = fa::cvtpk(v0.z, v0.w); o.z = fa::cvtpk(v1.x, v1.y); o.w = fa::cvtpk(v1.z, v1.w); hf[pb][ks] = __builtin_bit_cast(fa::bf16x8, o); } }
#pragma unroll 1
            for (int lbi = 0; lbi < 2; ++lbi) { const int lb = wl ? (lbi ? 2 : 1) : (lbi ? 3 : 0); const int l = 32 * lb + r32; const size_t tokl = tok0 + l;
                fa::bf16x8 qf[8];
#pragma unroll
                for (int ks = 0; ks < 8; ++ks) qf[ks] = *(const fa::bf16x8*)(XC + tokl * 1536 + 1280 + g * 128 + 16 * ks + 8 * h2);
                const float acsl = AC[hh * 128 + l];
                fa::f32x16 yT[2];
#pragma unroll
                for (int pb = 0; pb < 2; ++pb) {
#pragma unroll
                    for (int i = 0; i < 16; ++i) yT[pb][i] = 0.f;
#pragma unroll
                    for (int ks = 0; ks < 8; ++ks) yT[pb] = FA_MFMA(hf[pb][ks], qf[ks], yT[pb]);
                    const float e = __expf(acsl);
#pragma unroll
                    for (int i = 0; i < 16; ++i) yT[pb][i] *= e; }
                for (int sb = 0; sb <= lb; ++sb) { fa::f32x16 sT;
#pragma unroll
                    for (int i = 0; i < 16; ++i) sT[i] = 0.f;
#pragma unroll
                    for (int ks = 0; ks < 8; ++ks) { const fa::bf16x8 af = *(const LAS fa::bf16x8*)(BM + ((32 * sb + r32) * ssd::TP + 16 * ks + 8 * h2) * 2); sT = FA_MFMA(af, qf[ks], sT); }
#pragma unroll
                    for (int i = 0; i < 16; ++i) { const int sl = fa::crow(i, h2), s = 32 * sb + sl; const bool ok = sb < lb || sl <= r32; const float f = ok ? __expf(acsl - AC[hh * 128 + s]) * DT[hh * 128 + s] : 0.f; sT[i] = ok ? sT[i] * f : 0.f; }
                    fa::bf16x8 pf[2]; fa::pack_p(sT, pf);
#pragma unroll
                    for (int pb = 0; pb < 2; ++pb)
#pragma unroll
                        for (int st = 0; st < 2; ++st) { const fa::bf16x8 af = *(const LAS fa::bf16x8*)(xt + ((32 * pb + r32) * ssd::TP + 32 * sb + 16 * st + 8 * h2) * 2); yT[pb] = FA_MFMA(af, pf[st], yT[pb]); } }
                float ss = 0.f;
#pragma unroll
                for (int pb = 0; pb < 2; ++pb)
#pragma unroll
                    for (int q = 0; q < 4; ++q) { const int p = 32 * pb + 8 * q + 4 * h2; const v2u xv = *(const v2u*)(XC + tokl * 1536 + h * 64 + p), zv = *(const v2u*)(U + tokl * UP + UC_Z + h * 64 + p);
                        const float xs[4] = {blo(xv.x), bhi(xv.x), blo(xv.y), bhi(xv.y)}, zs[4] = {blo(zv.x), bhi(zv.x), blo(zv.y), bhi(zv.y)}; f32x4 y;
#pragma unroll
                        for (int e = 0; e < 4; ++e) { float v = yT[pb][4 * q + e] + xs[e] * dsk; v *= zs[e] * sigmf(zs[e]); y[e] = v; ss += v * v; }
                        *(f32x4*)(YD + tokl * 1024 + h * 64 + p) = y; }
                ss += __shfl_xor(ss, 32);
                if (h2 == 0) SSQ[hh * 128 + l] = ss;
            }
        }
        __syncthreads();
        if (F.tid < 128) { float s = 0.f;
#pragma unroll
            for (int hh = 0; hh < 8; ++hh) s += SSQ[hh * 128 + F.tid];
            RINV[F.tid] = 1.0f / sqrtf(s * (1.f / 512.f) + NORM_EPS); }
        __syncthreads();
        const float* nw = inp(a, 13) + (size_t)ly * 1024 + g * 512;
#pragma unroll 8
        for (int gi = F.tid; gi < 8192; gi += 512) { const int tl = gi >> 6, c8 = (gi & 63) * 8; const float ri = RINV[tl]; const float* yp = YD + (tok0 + tl) * 1024 + g * 512 + c8;
            const f32x4 y0 = *(const f32x4*)yp, y1 = *(const f32x4*)(yp + 4), n0 = *(const f32x4*)(nw + c8), n1 = *(const f32x4*)(nw + c8 + 4);
            v4u o; o.x = fa::cvtpk(y0.x * ri * n0.x, y0.y * ri * n0.y); o.y = fa::cvtpk(y0.z * ri * n0.z, y0.w * ri * n0.w); o.z = fa::cvtpk(y1.x * ri * n1.x, y1.y * ri * n1.y); o.w = fa::cvtpk(y1.z * ri * n1.z, y1.w * ri * n1.w);
            *(v4u*)(OB + (tok0 + tl) * 1024 + g * 512 + c8) = o; }
    }
    __syncthreads();
}

__device__ __forceinline__ void ph_route_mfma(const Frame& F0, const Args& a, int ly) {
    const Frame F = refr(F0);
    unsigned char* ws = wsp(a); unsigned* ROUTE = (unsigned*)(ws + WS_ROUTE); const float* x = outp(a); const bf16* WRh = (const bf16*)(ws + WS_WR); const bf16* WRl = WRh + 64 * 2048;
    int* ELT = (int*)(ws + WS_ELT); float* EWR = (float*)(ws + WS_EWR); bf16* XB = (bf16*)(ws + WS_XB);
    const float* gbias = inp(a, 20) + ly * 4; const float* ebias = inp(a, 22) + ly * 32; gu32* cnt = F.ctl + CW_ECNT + ly * 32 * 64;
    const int lane = F.lane, r32 = lane & 31, h = lane >> 5, kh = F.wave & 1, tq = F.wave >> 1; LAS float* LG = (LAS float*)(F.lds + tq * 8704);
    for (int it = F.vcu; it < T / 128; it += F.G) { const int tk = it * 128 + tq * 32 + r32; const float* xr = x + (size_t)tk * D + kh * 1024 + 8 * h;
        fa::f32x16 acc[2];
#pragma unroll
        for (int cb = 0; cb < 2; ++cb)
#pragma unroll
            for (int i = 0; i < 16; ++i) acc[cb][i] = 0.f;
        float ss = 0.f;
#pragma unroll 4
        for (int ks = 0; ks < 64; ++ks) { const f32x4 x0 = *(const f32x4*)(xr + 16 * ks), x1 = *(const f32x4*)(xr + 16 * ks + 4);
            ss += (x0.x * x0.x + x0.y * x0.y) + (x0.z * x0.z + x0.w * x0.w) + (x1.x * x1.x + x1.y * x1.y) + (x1.z * x1.z + x1.w * x1.w);
            v4u hi, lo; hi.x = fa::cvtpk(x0.x, x0.y); hi.y = fa::cvtpk(x0.z, x0.w); hi.z = fa::cvtpk(x1.x, x1.y); hi.w = fa::cvtpk(x1.z, x1.w);
            lo.x = fa::cvtpk(x0.x - blo(hi.x), x0.y - bhi(hi.x)); lo.y = fa::cvtpk(x0.z - blo(hi.y), x0.w - bhi(hi.y)); lo.z = fa::cvtpk(x1.x - blo(hi.z), x1.y - bhi(hi.z)); lo.w = fa::cvtpk(x1.z - blo(hi.w), x1.w - bhi(hi.w));
            const fa::bf16x8 xh = __builtin_bit_cast(fa::bf16x8, hi), xl = __builtin_bit_cast(fa::bf16x8, lo);
            *(v4u*)(XB + (size_t)tk * D + kh * 1024 + 16 * ks + 8 * h) = hi;
#pragma unroll
            for (int cb = 0; cb < 2; ++cb) { const size_t wo = (size_t)(32 * cb + r32) * 2048 + kh * 1024 + 16 * ks + 8 * h; const fa::bf16x8 wh = *(const fa::bf16x8*)(WRh + wo), wl = *(const fa::bf16x8*)(WRl + wo);
                acc[cb] = FA_MFMA(wh, xh, acc[cb]); acc[cb] = FA_MFMA(wl, xh, acc[cb]); acc[cb] = FA_MFMA(wh, xl, acc[cb]); } }
        ss += __shfl_xor(ss, 32);
        __syncthreads();
        if (kh == 1) {
#pragma unroll
            for (int cb = 0; cb < 2; ++cb)
#pragma unroll
                for (int i = 0; i < 16; ++i) LG[r32 * 68 + 32 * cb + fa::crow(i, h)] = acc[cb][i];
            if (h == 0) LG[r32 * 68 + 64] = ss; }
        __syncthreads();
        if (kh == 0) { ss += LG[r32 * 68 + 64]; const float rinv = 1.0f / sqrtf(ss * (1.f / D) + NORM_EPS);
#pragma unroll
            for (int cb = 0; cb < 2; ++cb)
#pragma unroll
                for (int i = 0; i < 16; ++i) { const int o = r32 * 68 + 32 * cb + fa::crow(i, h); LG[o] = (LG[o] + acc[cb][i]) * rinv; }
            LDS_WAIT();
            if (h == 0) { const LAS float* lg = LG + r32 * 68;
                float gl[4];
#pragma unroll
                for (int i = 0; i < 4; ++i) gl[i] = lg[i] + gbias[i];
                int gi = 0; float gm = gl[0];
#pragma unroll
                for (int i = 1; i < 4; ++i) if (gl[i] > gm) { gm = gl[i]; gi = i; }
                float gs = 0.f;
#pragma unroll
                for (int i = 0; i < 4; ++i) gs += __expf(gl[i] - gm);
                const float gwt = 1.0f / gs;
                float el[8];
#pragma unroll
                for (int e = 0; e < 8; ++e) el[e] = lg[4 + gi * 8 + e] + ebias[gi * 8 + e];
                int i1 = 0; float v1 = el[0];
#pragma unroll
                for (int e = 1; e < 8; ++e) if (el[e] > v1) { v1 = el[e]; i1 = e; }
                int i2 = -1; float v2 = -3.0e38f;
#pragma unroll
                for (int e = 0; e < 8; ++e) if (e != i1 && el[e] > v2) { v2 = el[e]; i2 = e; }
                const float ex = __expf(v2 - v1); const float w1 = 1.0f / (1.0f + ex), w2 = ex * w1;
                const int e0 = gi * 8 + i1, e1 = gi * 8 + i2;
                const unsigned p0 = __hip_atomic_fetch_add(cnt + e0 * 64, 1u, RLX_AGENT), p1 = __hip_atomic_fetch_add(cnt + e1 * 64, 1u, RLX_AGENT);
                v4u r0, r1; r0.x = (unsigned)e0; r0.y = (unsigned)e1; r0.z = p0; r0.w = p1; r1.x = __float_as_uint(gwt * w1); r1.y = __float_as_uint(gwt * w2); r1.z = __float_as_uint(rinv); r1.w = 0u;
                *(v4u*)(ROUTE + (size_t)tk * 8) = r0; *(v4u*)(ROUTE + (size_t)tk * 8 + 4) = r1;
                ELT[(size_t)e0 * T + p0] = tk; ELT[(size_t)e1 * T + p1] = tk; *(v2f*)(EWR + ((size_t)e0 * T + p0) * 2) = (v2f){gwt * w1, rinv}; *(v2f*)(EWR + ((size_t)e1 * T + p1) * 2) = (v2f){gwt * w2, rinv}; } }
    }
    __syncthreads();
}

__device__ __forceinline__ void ph_cmp2_mfma(const Frame& F0, const Args& a) {
    const Frame F = refr(F0);
    unsigned char* ws = wsp(a); const float* HP = (const float*)(ws + WS_CBG); const float* B1 = (const float*)(ws + WS_B1P); const bf16* W2T = (const bf16*)(ws + WS_W2T); bf16* KC = (bf16*)(ws + WS_KC); bf16* VCT = (bf16*)(ws + WS_VCT);
    const int lane = F.lane, r32 = lane & 31, h = lane >> 5;
    for (int it = F.gw; it < 128; it += F.NGW) { const int c = it >> 6, row = (it & 63) * 32 + r32;
        fa::f32x16 acc[4];
#pragma unroll
        for (int db = 0; db < 4; ++db)
#pragma unroll
            for (int i = 0; i < 16; ++i) acc[db][i] = 0.f;
#pragma unroll 8
        for (int ks = 0; ks < 16; ++ks) { const int i0 = 16 * ks + 8 * h; f32x4 v0 = *(const f32x4*)(B1 + c * 256 + i0), v1 = *(const f32x4*)(B1 + c * 256 + i0 + 4);
#pragma unroll
            for (int kq = 0; kq < 4; ++kq) { const float* p = HP + ((size_t)(c * 4 + kq) * 2048 + row) * 256 + i0; v0 = v0 + *(const f32x4*)p; v1 = v1 + *(const f32x4*)(p + 4); }
            v4u o; o.x = fa::cvtpk(v0.x * sigmf(v0.x), v0.y * sigmf(v0.y)); o.y = fa::cvtpk(v0.z * sigmf(v0.z), v0.w * sigmf(v0.w)); o.z = fa::cvtpk(v1.x * sigmf(v1.x), v1.y * sigmf(v1.y)); o.w = fa::cvtpk(v1.z * sigmf(v1.z), v1.w * sigmf(v1.w));
            const fa::bf16x8 bfr = __builtin_bit_cast(fa::bf16x8, o);
#pragma unroll
            for (int db = 0; db < 4; ++db) { const fa::bf16x8 af = *(const fa::bf16x8*)(W2T + ((size_t)(c * 128 + 32 * db + r32)) * 256 + i0); acc[db] = FA_MFMA(af, bfr, acc[db]); } }
#pragma unroll
        for (int db = 0; db < 4; ++db)
#pragma unroll
            for (int q = 0; q < 4; ++q) { const int d = 32 * db + 8 * q + 4 * h; v2u w; w.x = fa::cvtpk(acc[db][4 * q], acc[db][4 * q + 1]); w.y = fa::cvtpk(acc[db][4 * q + 2], acc[db][4 * q + 3]);
                *(v2u*)(KC + (size_t)(c * 2048 + row) * 128 + d) = w;
                if (c == 1) { bf16* vp = VCT + ((size_t)(row >> 8) * 128 + d) * 256 + sw16(row & 255); vp[0] = (bf16)(w.x & 0xffffu); vp[256] = (bf16)(w.x >> 16); vp[512] = (bf16)(w.y & 0xffffu); vp[768] = (bf16)(w.y >> 16); } }
    }
}

#ifndef EN_W
#define EN_W 1
#endif
#ifndef EN_A
#define EN_A 1
#endif
#ifndef EN_B
#define EN_B 1
#endif
#ifndef EN_C
#define EN_C 1
#endif
#ifndef EN_D
#define EN_D 1
#endif
#ifndef EN_E
#define EN_E 1
#endif
#ifndef EN_F
#define EN_F 1
#endif
#ifndef EN_G
#define EN_G 1
#endif
#ifndef EN_H
#define EN_H 1
#endif
#ifndef EN_I
#define EN_I 1
#endif
#ifndef EN_J
#define EN_J 1
#endif
#ifndef EN_K
#define EN_K 1
#endif
#ifndef EN_L
#define EN_L 1
#endif
#ifndef EN_M
#define EN_M 1
#endif
__global__ void __launch_bounds__(NWAVES * 64, 2) mk_fwd(Args a) {
    extern __shared__ __attribute__((aligned(16))) unsigned char lds_raw[];
    Frame F;
    F.lds = (LAS unsigned char*)lds_raw;
    F.MISC = (volatile LAS unsigned*)(F.lds + MISC_OFF);
    F.tid = threadIdx.x; F.lane = F.tid & 63; F.wave = __builtin_amdgcn_readfirstlane(F.tid >> 6);
    F.G = gridDim.x; { const int bx = blockIdx.x; F.vcu = (F.G % 8 == 0) ? (bx % 8) * (F.G / 8) + bx / 8 : bx; }
    F.gtid = F.vcu * (NWAVES * 64) + F.tid; F.GT = F.G * NWAVES * 64; F.gw = F.vcu * NWAVES + F.wave; F.NGW = F.G * NWAVES;
    F.ctl = (gu32*)(a.ws + WS_CTL);
    for (int u = F.tid; u < (LDS_BYTES - LDSCTL_OFF) / 4; u += NWAVES * 64) ((LAS unsigned*)(F.lds + LDSCTL_OFF))[u] = 0u;
    __syncthreads();
    const int lo = a.lo, hi = a.hi;
    XcdBarrier bar; bar.bar = (unsigned*)(F.ctl + CW_BAR); bar.x = 0; bar.st = nullptr;
    if (hi - lo > 1) bar = xcd_barrier_post((unsigned*)(F.ctl + CW_BAR), F.MISC + 8);
#define RUN(s) (lo <= (s) && (s) < hi)
#define SEAM(s) do { if (RUN(s) && RUN((s) + 1)) xcd_barrier(bar); else __syncthreads(); } while (0)
    int step = 0;
#pragma unroll 1
    for (int ly = 0; ly < 2; ++ly) {
        if (EN_W && RUN(step)) { phW(F, a, ly); phA(F, a, ly); }
        SEAM(step); ++step;
#pragma unroll 1
        for (int hb = 0; hb < 2; ++hb) {
            if (EN_B && RUN(step)) { unsigned char* ws = wsp(a); if (hb == 0) ph_bias(F, a, ly);
              {
                {
                  pg8::Gemm g{(const bf16*)(ws + WS_HN8 + (size_t)hb * TH * D), (const bf16*)(ws + WS_WG8), TH, NGATE, D / 2, D / 2, D / 2}; pg8::UnevenOrder S; S.init(TH, NGATE, F.G, (int)blockIdx.x);
                  if (F.G == 256) { S.kHi = 7; S.kLo = 5; } else { S.kHi = S.kLo = (1536 + F.G - 1) / F.G + 1; }
                  pg8::EpiGate E{(bf16*)(ws + WS_U) + UC_G, UP, 1.0f / 1024.0f};
                  pg8::gemm_phase<pg8::EpiGate, pg8::UnevenOrder, true, true>(F.lds + RING_OFF, g, S, E); }
                { pg8::Gemm g{(const bf16*)(ws + (hb ? WS_HN1 : WS_HN)), (const bf16*)(ws + WS_WIN), TH, NIN1, D, D, D}; pg8::StaticOrder S; S.init(TH, NIN1, F.G, (int)blockIdx.x);
                  pg8::EpiIn E{(bf16*)(ws + WS_U), UP, (bf16*)(ws + WS_KVC), KVC_CSTRIDE, (float*)(ws + WS_SM), (bf16*)(ws + WS_VTS), (bf16*)(ws + WS_VTW), (bf16*)(ws + WS_VTC)};
                  pg8::gemm_phase<pg8::EpiIn, pg8::StaticOrder, true>(F.lds + RING_OFF, g, S, E); }
              }
            }
            SEAM(step); ++step;
            if (EN_C && RUN(step)) { unsigned char* ws = wsp(a);
                const bool split = F.G > 128;
                if (!split || F.vcu >= 64) phC_elem(F, a, ly, split);
                if (!split || F.vcu < 64) {
#pragma unroll 1
                    for (int cq = 0; cq < 8; ++cq) { const int c = cq >> 2, kq = cq & 3;
                        pg8::Gemm g{(const bf16*)(ws + WS_KVC) + (size_t)c * KVC_CSTRIDE + kq * 1024, (const bf16*)(ws + WS_W1) + (size_t)c * 256 * 4096 + kq * 1024, 2048, 256, 1024, 2048, 4096};
                        pg8::PlainOrder S; S.init(2048, 256, F.G, split ? F.vcu - 8 * cq : F.vcu);
                        pg8::EpiPart E{(float*)(ws + WS_CBG) + (size_t)cq * 2048 * 256, 256};
                        pg8::gemm_phase<pg8::EpiPart, pg8::PlainOrder, false>(F.lds + RING_OFF, g, S, E);
                    }
                }
            }
            SEAM(step); ++step;
            if (EN_D && RUN(step)) {
                ph_cmp2_mfma(F, a); ph_states_mfma(F, a); ph_swa_mfma(F, a, ly); ph_win_mfma(F, a); }
            SEAM(step); ++step;
            if (EN_E && RUN(step)) { ph_scan2(F, a); ph_cmp_mfma(F, a); }
            SEAM(step); ++step;
            if (EN_F && RUN(step)) {
                ph_ssdy_mfma(F, a, ly); ph_slc_mfma(F, a, (bf16*)(wsp(a) + WS_OA)); }
            SEAM(step); ++step;
            if (EN_G && RUN(step)) { unsigned char* ws = wsp(a);
#pragma unroll 1
                for (int i = 0; i < 3; ++i) {
                    pg8::Gemm g{(const bf16*)(ws + WS_OA) + (size_t)(i % 3) * TH * 1024, (const bf16*)(ws + WS_PT) + (size_t)(i % 3) * 2048 * 1024, TH, D, 1024, 1024, 1024}; pg8::StaticOrder S; S.init(TH, D, F.G, (int)blockIdx.x);
                    pg8::EpiProj E{(bf16*)(ws + (hb ? WS_HN1 : WS_HN)), D, (const bf16*)(ws + WS_U) + UC_G + (i % 3) * D, UP, (i % 3) == 0 ? 1 : 0};
                    pg8::gemm_phase<pg8::EpiProj, pg8::StaticOrder, true>(F.lds + RING_OFF, g, S, E);
                }
            }
            SEAM(step); ++step;
            if (EN_H && RUN(step)) { unsigned char* ws = wsp(a);
                pg8::Gemm g{(const bf16*)(ws + (hb ? WS_HN1 : WS_HN)), (const bf16*)(ws + WS_WOUT), TH, D, D, D, D}; pg8::StaticOrder S; S.init(TH, D, F.G, (int)blockIdx.x);
                pg8::EpiOut E{(ly == 0 ? inp(a, 0) : outp(a)) + (size_t)hb * TH * D, outp(a) + (size_t)hb * TH * D, D};
                pg8::gemm_phase<pg8::EpiOut, pg8::StaticOrder, true>(F.lds + RING_OFF, g, S, E);
            }
            SEAM(step); ++step;
        }
        if (EN_I && RUN(step)) ph_route_mfma(F, a, ly);
        SEAM(step); ++step;
        if (EN_K && RUN(step)) { unsigned char* ws = wsp(a); moe_tables(F, ly); const LAS int* tab = (const LAS int*)(F.lds + MOETAB_OFF);
            pg8::Gemm g{(const bf16*)(ws + WS_XB), (const bf16*)(ws + WS_GU), NSLOT, 32 * 1024, D, D, D}; pg8::GroupedOrder<4> S{tab, (const int*)(ws + WS_ELT), T, D * 2, F.G, F.vcu};
            pg8::EpiGU E{(bf16*)(ws + WS_HG), (const float*)(ws + WS_EWR), tab, T};
            pg8::gemm_phase<pg8::EpiGU, pg8::GroupedOrder<4>, true, false, true>(F.lds + RING_OFF, g, S, E);
        }
        SEAM(step); ++step;
        if (EN_L && RUN(step)) { unsigned char* ws = wsp(a); moe_tables(F, ly); const LAS int* tab = (const LAS int*)(F.lds + MOETAB_OFF);
            pg8::Gemm g{(const bf16*)(ws + WS_HG), (const bf16*)(ws + WS_DN), NSLOT, 32 * 2048, 512, 512, 512}; pg8::GroupedOrder<8> S{tab, nullptr, 0, 0, F.G, F.vcu};
            pg8::EpiDown E{(bf16*)(ws + WS_XG)};
            pg8::gemm_phase<pg8::EpiDown, pg8::GroupedOrder<8>, true>(F.lds + RING_OFF, g, S, E);
        }
        SEAM(step); ++step;
    }
    if (RUN(step)) phFinal(F, a);
#undef RUN
#undef SEAM
}

#ifndef MK_SINGLE
#define MK_SINGLE 1
#endif
extern "C" void kernel_launch(void* const* d_in, const int* in_sizes, int n_in, void* d_out, int out_size, void* d_ws, size_t ws_size, hipStream_t stream) {
    static int grid = 0;
    if (grid == 0) {
        if (n_in != 27 || out_size != T * D || ws_size < WS_END) { fprintf(stderr, "kernel_launch: unexpected sizes (n_in %d out %d ws %zu need %zu)\n", n_in, out_size, ws_size, (size_t)WS_END); grid = -1; return; }
        int dev = 0, cus = 0, per_cu = 0;
        if (hipGetDevice(&dev) != hipSuccess || hipDeviceGetAttribute(&cus, hipDeviceAttributeMultiprocessorCount, dev) != hipSuccess) { grid = -1; return; }
        if (hipFuncSetAttribute((const void*)mk_fwd, hipFuncAttributeMaxDynamicSharedMemorySize, LDS_BYTES) != hipSuccess) { grid = -1; return; }
        if (hipOccupancyMaxActiveBlocksPerMultiprocessor(&per_cu, (const void*)mk_fwd, NWAVES * 64, LDS_BYTES) != hipSuccess || per_cu < 1) { fprintf(stderr, "kernel_launch: occupancy query says %d\n", per_cu); }
        (void)hipGetLastError();
        grid = cus;
    }
    if (grid < 0) return;
    if (hipMemsetAsync((char*)d_ws + WS_CTL, 0, CTL_ZERO_BYTES, stream) != hipSuccess) return;
    Args a; memset(&a, 0, sizeof(a));
    for (int i = 0; i < 27; ++i) a.in[i] = (const float*)d_in[i];
    a.out = (float*)d_out; a.ws = (unsigned char*)d_ws;
#ifdef PROBE_K
    a.lo = 0; a.hi = PROBE_K;
    hipLaunchKernelGGL(mk_fwd, dim3(grid), dim3(NWAVES * 64), LDS_BYTES, stream, a);
    if (hipMemsetAsync((char*)d_ws + WS_CTL, 0, CTL_ZERO_BYTES, stream) != hipSuccess) return;
#endif
#if MK_SINGLE
    a.lo = 0; a.hi = NSTEPS;
    hipLaunchKernelGGL(mk_fwd, dim3(grid), dim3(NWAVES * 64), LDS_BYTES, stream, a);
#else
    for (int s = 0; s < NSTEPS; ++s) { a.lo = s; a.hi = s + 1; hipLaunchKernelGGL(mk_fwd, dim3(grid), dim3(NWAVES * 64), LDS_BYTES, stream, a); }
#endif
}
```

```cpp
#include <hip/hip_runtime.h>
#include <cstdio>
#include <cstdint>
#include <cstring>
namespace pg8 {
#define PG8_LAS __attribute__((address_space(3)))
typedef unsigned short bf16_t;
typedef short bf16x8 __attribute__((ext_vector_type(8)));
typedef float f32x4 __attribute__((ext_vector_type(4)));
typedef unsigned u32x4 __attribute__((ext_vector_type(4)));
typedef unsigned u32x2 __attribute__((ext_vector_type(2)));
constexpr int BM = 256, BK = 64, HALF = 128, HTB = HALF * BK * 2  , STAGE_BYTES = 8 * HTB, NXCD = 8, WGM = 4;

__host__ __device__ __forceinline__ int lds_byte(int r, int c) { const int st = (r >> 4) * 2 + (c >> 5), rr = r & 15, cc = c & 31, ob = rr * 64 + cc * 2; return st * 1024 + (ob ^ (((ob >> 9) & 1) << 5)); }
__host__ __device__ __forceinline__ void stage_rc(int b, int& R, int& C) { const int st = b / 1024, sb = b % 1024, swz = sb ^ (((sb >> 9) & 1) << 5); R = (st >> 1) * 16 + swz / 64; C = (st & 1) * 32 + (swz % 64) / 2; }
__host__ __device__ __forceinline__ int perm32(int rho) { const int n = rho >> 4, i = rho & 15; return 8 * (i >> 2) + 4 * n + (i & 3); }

struct Unit { int pm, pn; };
struct Gemm { const bf16_t* A; const bf16_t* Bt; int M, N, K, lda, ldb; };

struct StaticOrder {
    int nM, nN, nwg, G, c;
    __host__ __device__ void init(int M, int N, int G_, int c_) { nM = M / BM; nN = N / BM; nwg = nM * nN; G = G_; c = c_; }
    __host__ __device__ void tile(long L, Unit& u) const {
        int wgid = (int)L; { const int q = nwg / NXCD, r = nwg % NXCD, xcd = wgid % NXCD, off = wgid / NXCD; wgid = (xcd < r ? xcd * (q + 1) : r * (q + 1) + (xcd - r) * q) + off; }
        const int nig = WGM * nN, gid = wgid / nig, fm = gid * WGM, gsz = (nM - fm) < WGM ? (nM - fm) : WGM;
        u.pm = fm + ((wgid % nig) % gsz); u.pn = (wgid % nig) / gsz; }
    __host__ __device__ bool next(int i, Unit& u) const { const long L = (long)i * G + c; if (L >= nwg) return false; tile(L, u); return true; }
    __device__ __forceinline__ unsigned row_off(const Unit&, int) const { return 0u; }
    __device__ __forceinline__ void a_ready(const Unit&) const {}
    __device__ __forceinline__ void done(const Unit&) const {}
};
struct UnevenOrder : StaticOrder {
    int kHi, kLo;
    __device__ bool next(int i, Unit& u) const { const int hG = G >> 1; long L;
        if (c >= hG) { if (i >= kHi) return false; L = (long)i * hG + (c - hG); } else { if (i >= kLo) return false; L = (long)kHi * hG + (long)i * hG + c; }
        if (L >= nwg) return false; tile(L, u); return true; }
};
struct ProjOrder : StaticOrder {
    __device__ bool next(int i, Unit& u) const { const int ti = i / 3, br = i - 3 * ti; const long L = (long)ti * G + c; if (L >= nwg) return false; tile(L, u); u.pm += br * nM; u.pn += br * nN; return true; }
};
struct PlainOrder {
    int nM, nN, G, c;
    __device__ void init(int M, int N, int G_, int c_) { nM = M / BM; nN = N / BM; G = G_; c = c_; }
    __device__ bool next(int i, Unit& u) const { const long L = (long)i * G + c; if (c < 0 || L >= (long)nM * nN) return false; u.pm = (int)(L % nM); u.pn = (int)(L / nM); return true; }
    __device__ __forceinline__ unsigned row_off(const Unit&, int) const { return 0u; }
    __device__ __forceinline__ void a_ready(const Unit&) const {}
    __device__ __forceinline__ void done(const Unit&) const {}
};
template <int NT> struct GroupedOrder {
    const PG8_LAS int* tab; const int* list; int cap, ldab, G, c;
    __device__ bool next(int i, Unit& u) const { const long L = (long)i * G + c; const int npan = tab[128]; if (L >= (long)npan * NT) return false; const int p = (int)(L / NT), t = (int)(L % NT); u.pm = p; u.pn = __builtin_amdgcn_readfirstlane(tab[192 + p]) * NT + t; return true; }
    __device__ __forceinline__ unsigned row_off(const Unit& u, int r) const { const int e = u.pn / NT, pos = u.pm * BM + r - tab[e]; const int tk = pos < tab[64 + e] ? list[(size_t)e * cap + pos] : 0; return (unsigned)tk * (unsigned)ldab; }
    __device__ __forceinline__ void a_ready(const Unit&) const {}
    __device__ __forceinline__ void done(const Unit&) const {}
};

typedef float f32x2_cv __attribute__((ext_vector_type(2)));
typedef __bf16 bf16x2_cv __attribute__((ext_vector_type(2)));
__device__ __forceinline__ unsigned cvt_pk_bf16(float lo, float hi) { const f32x2_cv v = {lo, hi}; const bf16x2_cv b = __builtin_convertvector(v, bf16x2_cv); return __builtin_bit_cast(unsigned, b); }
__device__ __forceinline__ float bflo(unsigned w) { return __uint_as_float(w << 16); }
__device__ __forceinline__ float bfhi(unsigned w) { return __uint_as_float(w & 0xffff0000u); }
__device__ __forceinline__ float sigm(float x) { return __builtin_amdgcn_rcpf(1.0f + __builtin_amdgcn_exp2f(x * -1.4426950408889634f)); }

typedef float f32x2 __attribute__((ext_vector_type(2)));
typedef int v8i_t __attribute__((ext_vector_type(8)));
typedef int v4i_t __attribute__((ext_vector_type(4)));
__host__ __device__ __forceinline__ int sw16(int x) { return (x & ~12) | ((x & 4) << 1) | ((x & 8) >> 1); }
__device__ __forceinline__ u32x4 pack8(const f32x4 v0, const f32x4 v1) { u32x4 w; w.x = cvt_pk_bf16(v0[0], v0[1]); w.y = cvt_pk_bf16(v0[2], v0[3]); w.z = cvt_pk_bf16(v1[0], v1[1]); w.w = cvt_pk_bf16(v1[2], v1[3]); return w; }

struct EpiIn {
    static constexpr bool PERM = true, AFTER_DRAIN = false;
    bf16_t* U; int up; bf16_t* KVC; size_t kvc_cstride; float* SM; bf16_t* VTS; bf16_t* VTW; bf16_t* VTC;
    __device__ __forceinline__ void operator()(const f32x4 (&acc)[2][2][4][2], const Unit& u, int wr, int wc, int fr, int fq) const {
        const int row0 = u.pm * BM + wr * 64 + fr; const int pn = u.pn;
        if (pn == 25) {
            if (wc < 2) {
#pragma unroll
                for (int ai = 0; ai < 2; ++ai)
#pragma unroll
                    for (int m = 0; m < 4; ++m) { float* rp = SM + (size_t)(row0 + ai * HALF + m * 16) * 64 + wc * 32 + 8 * fq;
                        *(f32x4*)(rp) = acc[ai][0][m][0]; *(f32x4*)(rp + 4) = acc[ai][0][m][1]; }
            }
            return;
        }
        if (pn == 4 || pn == 5) {
            bf16_t* base = KVC + (size_t)(pn - 4) * kvc_cstride;
#pragma unroll
            for (int ai = 0; ai < 2; ++ai)
#pragma unroll
                for (int m = 0; m < 4; ++m) { const int row = row0 + ai * HALF + m * 16; const int b = row >> 12, s = row & 4095;
#pragma unroll
                    for (int bj = 0; bj < 2; ++bj) { bf16_t* p = base + ((size_t)((b * 2 + bj) * 4096 + s)) * 128 + wc * 32 + 8 * fq;
                        *(u32x4*)p = pack8(acc[ai][bj][m][0], acc[ai][bj][m][1]); } }
            return;
        }
        if (pn == 7 || pn == 9) {
            bf16_t* vt = pn == 7 ? VTS : VTW;
#pragma unroll
            for (int ai = 0; ai < 2; ++ai)
#pragma unroll
                for (int m = 0; m < 4; ++m) { const int row = row0 + ai * HALF + m * 16; const int b = row >> 12, s = row & 4095;
#pragma unroll
                    for (int bj = 0; bj < 2; ++bj) { bf16_t* p = vt + ((size_t)((b * 2 + bj) * 128 + wc * 32 + 8 * fq)) * 4096 + sw16(s); const u32x4 w = pack8(acc[ai][bj][m][0], acc[ai][bj][m][1]);
                        p[0] = (bf16_t)(w.x & 0xffffu); p[4096] = (bf16_t)(w.x >> 16); p[2 * 4096] = (bf16_t)(w.y & 0xffffu); p[3 * 4096] = (bf16_t)(w.y >> 16);
                        p[4 * 4096] = (bf16_t)(w.z & 0xffffu); p[5 * 4096] = (bf16_t)(w.z >> 16); p[6 * 4096] = (bf16_t)(w.w & 0xffffu); p[7 * 4096] = (bf16_t)(w.w >> 16); } }
            return;
        }
        if (pn == 24) {
#pragma unroll
            for (int ai = 0; ai < 2; ++ai)
#pragma unroll
                for (int m = 0; m < 4; ++m) { const int row = row0 + ai * HALF + m * 16; const int b = row >> 12, s = row & 4095;
                    bf16_t* p = VTC + ((size_t)((b * 2 + (wc >> 1)) * 64 + (wc & 1) * 32 + 8 * fq)) * 4096 + sw16(s); const u32x4 w = pack8(acc[ai][1][m][0], acc[ai][1][m][1]);
                    p[0] = (bf16_t)(w.x & 0xffffu); p[4096] = (bf16_t)(w.x >> 16); p[2 * 4096] = (bf16_t)(w.y & 0xffffu); p[3 * 4096] = (bf16_t)(w.y >> 16);
                    p[4 * 4096] = (bf16_t)(w.z & 0xffffu); p[5 * 4096] = (bf16_t)(w.z >> 16); p[6 * 4096] = (bf16_t)(w.w & 0xffffu); p[7 * 4096] = (bf16_t)(w.w >> 16); }
        }
#pragma unroll
        for (int ai = 0; ai < 2; ++ai)
#pragma unroll
            for (int m = 0; m < 4; ++m) { bf16_t* rowp = U + (size_t)(row0 + ai * HALF + m * 16) * up + pn * BM + wc * 32 + 8 * fq;
#pragma unroll
                for (int bj = 0; bj < 2; ++bj) *(u32x4*)(rowp + bj * HALF) = pack8(acc[ai][bj][m][0], acc[ai][bj][m][1]); }
    }
};
struct EpiGate {
    static constexpr bool PERM = true, AFTER_DRAIN = false;
    bf16_t* G; int ldg; float scale;
    __device__ __forceinline__ void operator()(const f32x4 (&acc)[2][2][4][2], const Unit& u, int wr, int wc, int fr, int fq) const {
        const int row0 = u.pm * BM + wr * 64 + fr;
#pragma unroll
        for (int ai = 0; ai < 2; ++ai)
#pragma unroll
            for (int m = 0; m < 4; ++m) { bf16_t* rowp = G + (size_t)(row0 + ai * HALF + m * 16) * ldg + u.pn * BM + wc * 32 + 8 * fq;
#pragma unroll
                for (int bj = 0; bj < 2; ++bj) { f32x4 v0 = acc[ai][bj][m][0] * scale, v1 = acc[ai][bj][m][1] * scale;
#pragma unroll
                    for (int j = 0; j < 4; ++j) { v0[j] = sigm(v0[j]); v1[j] = sigm(v1[j]); }
                    *(u32x4*)(rowp + bj * HALF) = pack8(v0, v1); } }
    }
};
struct EpiSilu {
    static constexpr bool PERM = true, AFTER_DRAIN = false;
    bf16_t* O; int ldc; const float* bias;
    __device__ __forceinline__ void operator()(const f32x4 (&acc)[2][2][4][2], const Unit& u, int wr, int wc, int fr, int fq) const {
        const int row0 = u.pm * BM + wr * 64 + fr; const int col0 = u.pn * BM + wc * 32 + 8 * fq;
        f32x4 bv[2][2];
#pragma unroll
        for (int bj = 0; bj < 2; ++bj)
#pragma unroll
            for (int n = 0; n < 2; ++n) bv[bj][n] = *(const f32x4*)(bias + col0 + bj * HALF + 4 * n);
#pragma unroll
        for (int ai = 0; ai < 2; ++ai)
#pragma unroll
            for (int m = 0; m < 4; ++m) { bf16_t* rowp = O + (size_t)(row0 + ai * HALF + m * 16) * ldc + col0;
#pragma unroll
                for (int bj = 0; bj < 2; ++bj) { f32x4 v0 = acc[ai][bj][m][0] + bv[bj][0], v1 = acc[ai][bj][m][1] + bv[bj][1];
#pragma unroll
                    for (int j = 0; j < 4; ++j) { v0[j] = v0[j] * sigm(v0[j]); v1[j] = v1[j] * sigm(v1[j]); }
                    *(u32x4*)(rowp + bj * HALF) = pack8(v0, v1); } }
    }
};
struct EpiPart {
    static constexpr bool PERM = false, AFTER_DRAIN = false;
    float* P; int ldc;
    __device__ __forceinline__ void operator()(const f32x4 (&acc)[2][2][4][2], const Unit& u, int wr, int wc, int fr, int fq) const {
        const int row0 = u.pm * BM + wr * 64 + fr, col0 = u.pn * BM + wc * 32 + 4 * fq;
#pragma unroll
        for (int ai = 0; ai < 2; ++ai)
#pragma unroll
            for (int m = 0; m < 4; ++m) { float* rp = P + (size_t)(row0 + ai * HALF + m * 16) * ldc + col0;
#pragma unroll
                for (int bj = 0; bj < 2; ++bj)
#pragma unroll
                    for (int n = 0; n < 2; ++n) *(f32x4*)(rp + bj * HALF + n * 16) = acc[ai][bj][m][n]; }
    }
};
struct EpiProj {
    static constexpr bool PERM = true, AFTER_DRAIN = false;
    bf16_t* Y; int ldy; const bf16_t* Gt; int ldg; int npm, npn, gstride;
    __device__ __forceinline__ void operator()(const f32x4 (&acc)[2][2][4][2], const Unit& u, int wr, int wc, int fr, int fq) const {
        const int br = u.pm / npm, pm = u.pm - br * npm, pn = u.pn - br * npn; const bool first = br == 0; const bf16_t* G = Gt + (size_t)br * gstride;
        const int row0 = pm * BM + wr * 64 + fr; const int col0 = pn * BM + wc * 32 + 8 * fq;
#pragma unroll
        for (int ai = 0; ai < 2; ++ai) { u32x4 g[4][2], y[4][2];
#pragma unroll
            for (int m = 0; m < 4; ++m) { const size_t row = (size_t)(row0 + ai * HALF + m * 16);
#pragma unroll
                for (int bj = 0; bj < 2; ++bj) { g[m][bj] = *(const u32x4*)(G + row * ldg + col0 + bj * HALF); y[m][bj] = (u32x4){0u, 0u, 0u, 0u}; if (!first) y[m][bj] = *(const u32x4*)(Y + row * ldy + col0 + bj * HALF); } }
#pragma unroll
            for (int m = 0; m < 4; ++m) { const size_t row = (size_t)(row0 + ai * HALF + m * 16);
#pragma unroll
                for (int bj = 0; bj < 2; ++bj) { const u32x4 gg = g[m][bj], yy = y[m][bj]; const f32x4 a0 = acc[ai][bj][m][0], a1 = acc[ai][bj][m][1]; f32x4 v0, v1;
                    v0[0] = bflo(yy.x) + bflo(gg.x) * a0[0]; v0[1] = bfhi(yy.x) + bfhi(gg.x) * a0[1]; v0[2] = bflo(yy.y) + bflo(gg.y) * a0[2]; v0[3] = bfhi(yy.y) + bfhi(gg.y) * a0[3];
                    v1[0] = bflo(yy.z) + bflo(gg.z) * a1[0]; v1[1] = bfhi(yy.z) + bfhi(gg.z) * a1[1]; v1[2] = bflo(yy.w) + bflo(gg.w) * a1[2]; v1[3] = bfhi(yy.w) + bfhi(gg.w) * a1[3];
                    *(u32x4*)(Y + row * ldy + col0 + bj * HALF) = pack8(v0, v1); } }
            asm volatile("" ::: "memory"); }
    }
};
struct EpiOut {
    static constexpr bool PERM = false, AFTER_DRAIN = false;
    const float* xin; float* out; int ldc;
    __device__ __forceinline__ void operator()(const f32x4 (&acc)[2][2][4][2], const Unit& u, int wr, int wc, int fr, int fq) const {
        const int row0 = u.pm * BM + wr * 64 + fr, col0 = u.pn * BM + wc * 32 + 4 * fq;
#pragma unroll
        for (int ai = 0; ai < 2; ++ai) { f32x4 b[4][2][2];
#pragma unroll
            for (int m = 0; m < 4; ++m) { const size_t off = (size_t)(row0 + ai * HALF + m * 16) * ldc + col0;
#pragma unroll
                for (int bj = 0; bj < 2; ++bj)
#pragma unroll
                    for (int n = 0; n < 2; ++n) b[m][bj][n] = *(const f32x4*)(xin + off + bj * HALF + n * 16); }
#pragma unroll
            for (int m = 0; m < 4; ++m) { const size_t off = (size_t)(row0 + ai * HALF + m * 16) * ldc + col0;
#pragma unroll
                for (int bj = 0; bj < 2; ++bj)
#pragma unroll
                    for (int n = 0; n < 2; ++n) *(f32x4*)(out + off + bj * HALF + n * 16) = b[m][bj][n] + acc[ai][bj][m][n]; }
            asm volatile("" ::: "memory"); }
    }
};
struct EpiGU {
    static constexpr bool PERM = true, AFTER_DRAIN = false;
    bf16_t* HG; const float* ewr; const PG8_LAS int* tab; int cap;
    __device__ __forceinline__ void operator()(const f32x4 (&acc)[2][2][4][2], const Unit& u, int wr, int wc, int fr, int fq) const {
        const int row0 = u.pm * BM + wr * 64 + fr; const int col0 = (u.pn & 3) * HALF + wc * 32 + 8 * fq; const int e = u.pn >> 2, off = tab[e], cn = tab[64 + e];
#pragma unroll
        for (int ai = 0; ai < 2; ++ai)
#pragma unroll
            for (int m = 0; m < 4; ++m) { const int row = row0 + ai * HALF + m * 16, pos = row - off; float w = 0.f, ri = 0.f; if (pos < cn) { const f32x2 t = *(const f32x2*)(ewr + ((size_t)e * cap + pos) * 2); w = t.x; ri = t.y; }
                f32x4 v0, v1;
#pragma unroll
                for (int j = 0; j < 4; ++j) { const float g0 = acc[ai][0][m][0][j] * ri, g1 = acc[ai][0][m][1][j] * ri; v0[j] = g0 * sigm(g0) * acc[ai][1][m][0][j] * (ri * w); v1[j] = g1 * sigm(g1) * acc[ai][1][m][1][j] * (ri * w); }
                *(u32x4*)(HG + (size_t)row * 512 + col0) = pack8(v0, v1); }
    }
};
struct EpiDown {
    static constexpr bool PERM = true, AFTER_DRAIN = false;
    bf16_t* YG;
    __device__ __forceinline__ void operator()(const f32x4 (&acc)[2][2][4][2], const Unit& u, int wr, int wc, int fr, int fq) const {
        const int row0 = u.pm * BM + wr * 64 + fr, col0 = (u.pn & 7) * BM + wc * 32 + 8 * fq;
#pragma unroll
        for (int ai = 0; ai < 2; ++ai)
#pragma unroll
            for (int m = 0; m < 4; ++m) { bf16_t* rowp = YG + (size_t)(row0 + ai * HALF + m * 16) * 2048 + col0;
#pragma unroll
                for (int bj = 0; bj < 2; ++bj) *(u32x4*)(rowp + bj * HALF) = pack8(acc[ai][bj][m][0], acc[ai][bj][m][1]); }
    }
};

template <class Epi, class Sched, bool ALIGN_EPI = false, bool F8 = false, bool GATHER = false>
__device__ __forceinline__ void gemm_phase(PG8_LAS unsigned char* lds, const Gemm g, const Sched& S, const Epi& E) {
    int tid_ = threadIdx.x; asm volatile("" : "+v"(tid_));
    const int tid = tid_, wid = __builtin_amdgcn_readfirstlane(tid >> 6), lane = tid & 63, wr = wid >> 2, wc = wid & 3, fr = lane & 15, fq = lane >> 4;
    const int K = g.K, nt = K / BK, lda = g.lda, ldb = g.ldb;
    unsigned voffA[2], voffB[2];
#pragma unroll
    for (int i = 0; i < 2; ++i) { int R, C; stage_rc(tid * 16 + i * 8192, R, C); const int Rb = Epi::PERM ? ((R & ~31) + perm32(R & 31)) : R;
        voffA[i] = (unsigned)(R * lda + C) * 2u; voffB[i] = (unsigned)(Rb * ldb + C) * 2u; }
    const size_t kstep = (size_t)(BK * 2);
    const size_t hstepA = (size_t)HALF * lda * 2, hstepB = (size_t)HALF * ldb * 2;
    const size_t tstepB = 2 * hstepB;
    const size_t hstepAg = GATHER ? 0 : hstepA, tstepA = GATHER ? 0 : 2 * hstepA;
    const unsigned ldsw = (unsigned)wid * 1024u;
    const int aoff = lds_byte(wr * 64 + fr, fq * 8), boff = lds_byte(wc * 32 + fr, fq * 8);
#define PG8_SA(b, h) (((b) * 2 + (h)) * HTB)
#define PG8_SB(b, h) ((4 + (b) * 2 + (h)) * HTB)
#define PG8_VA(nx, h) (GATHER ? ((nx) ? vnx[h] : vcu[h]) : voffA)
#define PG8_STAGE(bufoff, gbase, voff) do { _Pragma("unroll") for (int _i = 0; _i < 2; ++_i) \
        __builtin_amdgcn_global_load_lds((const unsigned*)((const char*)(gbase) + (voff)[_i]), (PG8_LAS unsigned*)(lds + (bufoff) + ldsw + _i * 8192), 16, 0, 0); } while (0)
#define PG8_LDA(dst, b, h) do { _Pragma("unroll") for (int m = 0; m < 4; ++m) { if constexpr (F8) { dst##8[m].lo = *(const PG8_LAS v4i_t*)(lds + PG8_SA(b, h) + aoff + m * 2048); dst##8[m].hi = *(const PG8_LAS v4i_t*)(lds + PG8_SA(b, h) + aoff + m * 2048 + 1024); } \
        else { _Pragma("unroll") for (int k = 0; k < 2; ++k) dst[m][k] = *(const PG8_LAS bf16x8*)(lds + PG8_SA(b, h) + aoff + m * 2048 + k * 1024); } } } while (0)
#define PG8_LDB(dst, b, h) do { _Pragma("unroll") for (int n = 0; n < 2; ++n) { if constexpr (F8) { dst##8[n].lo = *(const PG8_LAS v4i_t*)(lds + PG8_SB(b, h) + boff + n * 2048); dst##8[n].hi = *(const PG8_LAS v4i_t*)(lds + PG8_SB(b, h) + boff + n * 2048 + 1024); } \
        else { _Pragma("unroll") for (int k = 0; k < 2; ++k) dst[n][k] = *(const PG8_LAS bf16x8*)(lds + PG8_SB(b, h) + boff + n * 2048 + k * 1024); } } } while (0)
#define PG8_MMA(ai, bj, At, Bt) do { __builtin_amdgcn_s_setprio(1); _Pragma("unroll") for (int m = 0; m < 4; ++m) _Pragma("unroll") for (int n = 0; n < 2; ++n) { \
        if constexpr (F8) asm volatile("v_mfma_f32_16x16x128_f8f6f4 %0, %1, %2, %0" : "+v"(acc[ai][bj][m][n]) : "v"(Bt##8[n]), "v"(At##8[m])); \
        else { _Pragma("unroll") for (int k = 0; k < 2; ++k) acc[ai][bj][m][n] = __builtin_amdgcn_mfma_f32_16x16x32_bf16(Bt[n][k], At[m][k], acc[ai][bj][m][n], 0, 0, 0); } } __builtin_amdgcn_s_setprio(0); } while (0)
#define PG8_WAIT_V(n) asm volatile("s_waitcnt vmcnt(" #n ")" ::: "memory")
#define PG8_WAIT_L(n) asm volatile("s_waitcnt lgkmcnt(" #n ")" ::: "memory")
#define PG8_BAR __builtin_amdgcn_s_barrier()
#define PG8_SCHED __builtin_amdgcn_sched_barrier(0)
    Unit cur, nxt; int ui = 0;
    if (!S.next(0, cur)) return;
    f32x4 acc[2][2][4][2];
#pragma unroll
    for (int a = 0; a < 2; ++a)
#pragma unroll
        for (int b = 0; b < 2; ++b)
#pragma unroll
            for (int m = 0; m < 4; ++m)
#pragma unroll
                for (int n = 0; n < 2; ++n) acc[a][b][m][n] = (f32x4){0.f, 0.f, 0.f, 0.f};
    bf16x8 At[4][2], B0[2][2], B1[2][2]; v8i_t At8[4], B08[2], B18[2];
    const char* cA = (const char*)g.A + (size_t)cur.pm * tstepA; const char* cB = (const char*)g.Bt + (size_t)cur.pn * tstepB;
    unsigned vcu[2][2], vnx[2][2];
#define PG8_GOFF(u, v) do { _Pragma("unroll") for (int _h = 0; _h < 2; ++_h) _Pragma("unroll") for (int _i = 0; _i < 2; ++_i) { int R, C; stage_rc(tid * 16 + _i * 8192, R, C); v[_h][_i] = S.row_off(u, _h * HALF + R) + (unsigned)C * 2u; } } while (0)
    if constexpr (GATHER) PG8_GOFF(cur, vcu);
    S.a_ready(cur);
    PG8_STAGE(PG8_SB(0, 0), cB, voffB); PG8_STAGE(PG8_SB(0, 1), cB + hstepB, voffB); PG8_STAGE(PG8_SA(0, 0), cA, PG8_VA(false, 0)); PG8_STAGE(PG8_SA(0, 1), cA + hstepAg, PG8_VA(false, 1));
    if (wr == 1) PG8_BAR;
    PG8_WAIT_V(2); PG8_BAR;
    PG8_STAGE(PG8_SB(1, 0), cB + kstep, voffB); PG8_STAGE(PG8_SA(1, 0), cA + kstep, PG8_VA(false, 0)); PG8_STAGE(PG8_SB(1, 1), cB + hstepB + kstep, voffB);
    PG8_WAIT_V(6); PG8_BAR;
    for (;;) {
        const bool has_next = S.next(ui + 1, nxt);
        if constexpr (GATHER) { if (has_next) PG8_GOFF(nxt, vnx); else {
#pragma unroll
            for (int _h = 0; _h < 2; ++_h)
#pragma unroll
                for (int _i = 0; _i < 2; ++_i) vnx[_h][_i] = vcu[_h][_i]; } }
        const char* nA = has_next ? (const char*)g.A + (size_t)nxt.pm * tstepA : cA; const char* nB = has_next ? (const char*)g.Bt + (size_t)nxt.pn * tstepB : cB;
        for (int t = 0; t < nt; t += 2) {
            const bool last = (t == nt - 2);
            const char* a1 = cA + (size_t)(t + 1) * kstep;
            const char* a2 = last ? nA : cA + (size_t)(t + 2) * kstep; const char* b2 = last ? nB : cB + (size_t)(t + 2) * kstep;
            const char* a3 = a2 + kstep; const char* b3 = b2 + kstep;
            if (last && has_next) S.a_ready(nxt);
            PG8_LDB(B0, 0, 0); PG8_LDB(B1, 0, 1); PG8_SCHED; PG8_LDA(At, 0, 0); PG8_STAGE(PG8_SA(1, 1), a1 + hstepAg, PG8_VA(false, 1));
            PG8_WAIT_V(8); PG8_WAIT_L(0); PG8_BAR; PG8_MMA(0, 0, At, B0); PG8_MMA(0, 1, At, B1); PG8_BAR; PG8_SCHED;
            PG8_LDA(At, 0, 1); PG8_STAGE(PG8_SB(0, 0), b2, voffB); PG8_STAGE(PG8_SB(0, 1), b2 + hstepB, voffB); PG8_STAGE(PG8_SA(0, 0), a2, PG8_VA(last, 0));
            PG8_WAIT_V(8); PG8_WAIT_L(0); PG8_BAR; PG8_MMA(1, 0, At, B0); PG8_MMA(1, 1, At, B1); PG8_BAR; PG8_SCHED;
            PG8_LDB(B0, 1, 0); PG8_LDB(B1, 1, 1); PG8_SCHED; PG8_LDA(At, 1, 0); PG8_STAGE(PG8_SA(0, 1), a2 + hstepAg, PG8_VA(last, 1));
            PG8_WAIT_V(8); PG8_WAIT_L(0); PG8_BAR; PG8_MMA(0, 0, At, B0); PG8_MMA(0, 1, At, B1); PG8_BAR; PG8_SCHED;
            PG8_LDA(At, 1, 1); PG8_STAGE(PG8_SB(1, 0), b3, voffB); PG8_STAGE(PG8_SB(1, 1), b3 + hstepB, voffB); PG8_STAGE(PG8_SA(1, 0), a3, PG8_VA(last, 0));
            PG8_WAIT_V(8); PG8_WAIT_L(0); PG8_BAR; PG8_MMA(1, 0, At, B0); PG8_MMA(1, 1, At, B1); PG8_BAR; PG8_SCHED;
        }
        if constexpr (ALIGN_EPI) { if (wr == 0) PG8_BAR; }
        if constexpr (F8) {
            asm volatile("s_nop 15\n\ts_nop 15" : "+v"(acc[0][0][0][0]), "+v"(acc[0][0][0][1]), "+v"(acc[0][0][1][0]), "+v"(acc[0][0][1][1]), "+v"(acc[0][0][2][0]), "+v"(acc[0][0][2][1]), "+v"(acc[0][0][3][0]), "+v"(acc[0][0][3][1]),
                                                    "+v"(acc[0][1][0][0]), "+v"(acc[0][1][0][1]), "+v"(acc[0][1][1][0]), "+v"(acc[0][1][1][1]), "+v"(acc[0][1][2][0]), "+v"(acc[0][1][2][1]), "+v"(acc[0][1][3][0]), "+v"(acc[0][1][3][1]));
            asm volatile("" : "+v"(acc[1][0][0][0]), "+v"(acc[1][0][0][1]), "+v"(acc[1][0][1][0]), "+v"(acc[1][0][1][1]), "+v"(acc[1][0][2][0]), "+v"(acc[1][0][2][1]), "+v"(acc[1][0][3][0]), "+v"(acc[1][0][3][1]),
                                "+v"(acc[1][1][0][0]), "+v"(acc[1][1][0][1]), "+v"(acc[1][1][1][0]), "+v"(acc[1][1][1][1]), "+v"(acc[1][1][2][0]), "+v"(acc[1][1][2][1]), "+v"(acc[1][1][3][0]), "+v"(acc[1][1][3][1])); }
        E(acc, cur, wr, wc, fr, fq); S.done(cur);
        if (!has_next) break;
#pragma unroll
        for (int a = 0; a < 2; ++a)
#pragma unroll
            for (int b = 0; b < 2; ++b)
#pragma unroll
                for (int m = 0; m < 4; ++m)
#pragma unroll
                    for (int n = 0; n < 2; ++n) acc[a][b][m][n] = (f32x4){0.f, 0.f, 0.f, 0.f};
        cur = nxt; cA = nA; cB = nB; ++ui;
        if constexpr (GATHER) {
#pragma unroll
            for (int _h = 0; _h < 2; ++_h)
#pragma unroll
                for (int _i = 0; _i < 2; ++_i) vcu[_h][_i] = vnx[_h][_i]; }
        if constexpr (ALIGN_EPI) { if (wr == 1) PG8_BAR; }
    }
    PG8_WAIT_V(0);
    if constexpr (!ALIGN_EPI) { if (wr == 0) PG8_BAR; }
    PG8_BAR;
#undef PG8_SA
#undef PG8_VA
#undef PG8_GOFF
#undef PG8_SB
#undef PG8_STAGE
#undef PG8_LDA
#undef PG8_LDB
#undef PG8_MMA
#undef PG8_WAIT_V
#undef PG8_WAIT_L
#undef PG8_BAR
#undef PG8_SCHED
}
}
constexpr int NB = 8, S = 4096, D = 2048, T = NB * S;
constexpr int HBN = 4, TH = HBN * S;
constexpr int IN_DIM = 12584, NIN1 = 6656, NGATE = 6144, UP = 12544;
constexpr int UC_Q = 0, UC_KV = 1024, UC_Z = 2560, UC_XBC = 3584, UC_SQ = 5120, UC_SKV = 6144, UC_G = 6400;
constexpr int NSLOT = 73728;
constexpr float NORM_EPS = 1e-6f;

constexpr size_t MiB = 1u << 20;
constexpr size_t WS_CTL = 0, CTL_ZERO_BYTES = 1 * MiB;
constexpr size_t WS_TAB = 1 * MiB;
constexpr size_t WS_B1P = WS_TAB + 3 * MiB;
constexpr size_t WS_WR = WS_B1P + 64 * 1024;
constexpr size_t WS_W2T = WS_WR + 512 * 1024;
constexpr size_t WS_WIN = 5 * MiB;
constexpr size_t WS_WG8 = WS_WIN + 26 * MiB;
constexpr size_t WS_W1 = WS_WIN + 50 * MiB;
constexpr size_t WS_PT = WS_W1 + 4 * MiB;
constexpr size_t WS_WOUT = WS_PT + 12 * MiB;
constexpr size_t WS_GU = WS_WOUT + 8 * MiB;
constexpr size_t WS_DN = WS_GU + 128 * MiB;
constexpr size_t WS_ACT = WS_DN + 64 * MiB;
constexpr size_t WS_HN = WS_ACT;
constexpr size_t WS_U = WS_HN + 64 * MiB;
constexpr size_t WS_KVC = WS_U + 392 * MiB;
constexpr size_t KVC_CSTRIDE = (size_t)(HBN * 2 * 4096 + 16) * 128;
constexpr size_t WS_SM = WS_KVC + 17 * MiB;
constexpr size_t WS_QR = WS_SM + 4 * MiB;
constexpr size_t WS_XC = WS_QR + 32 * MiB;
constexpr size_t WS_DTV = WS_XC + 48 * MiB;
constexpr size_t WS_ACS = WS_DTV + 1 * MiB;
constexpr size_t WS_HID = WS_ACS + 1 * MiB;
constexpr size_t WS_KC = WS_HID + 2 * MiB;
constexpr size_t WS_SEL = WS_KC + 1 * MiB;
constexpr size_t WS_OA = WS_SEL + 1 * MiB;
constexpr size_t WS_OB = WS_OA + 32 * MiB, WS_OC = WS_OB + 32 * MiB;
constexpr size_t WS_CBG = WS_OA + 96 * MiB;
constexpr size_t WS_YD = WS_CBG + 16 * MiB;
constexpr size_t WS_ST = WS_YD + 64 * MiB;
constexpr size_t WS_VTS = WS_ST + 64 * MiB;
constexpr size_t WS_VTW = WS_VTS + 8 * MiB;
constexpr size_t WS_VTC = WS_VTW + 8 * MiB;
constexpr size_t WS_VCT = WS_VTC + 4 * MiB;
constexpr size_t WS_HN1 = WS_VCT + 1 * MiB;
constexpr size_t WS_HN8 = WS_HN1 + 64 * MiB;
constexpr size_t WS_MIX_END = WS_HN8 + 64 * MiB;
constexpr size_t WS_ROUTE = WS_U;
constexpr size_t WS_ELT = WS_ROUTE + 1 * MiB;
constexpr size_t WS_EWR = WS_ELT + 4 * MiB;
constexpr size_t WS_XB = WS_EWR + 8 * MiB;
constexpr size_t WS_HG = WS_XB + 128 * MiB;
constexpr size_t WS_XG = WS_HG + 72 * MiB;
constexpr size_t WS_MOE_END = WS_XG + 288 * MiB;
static_assert(WS_MOE_END <= WS_CBG, "MoE buffers must stay inside the dead mixer buffers");
constexpr size_t WS_END = WS_MIX_END > WS_MOE_END ? WS_MIX_END : WS_MOE_END;
constexpr int CW_BAR = 4096;
constexpr int CW_ECNT = 16384;

constexpr int RING_OFF = 0, RING_BYTES = 131072;
constexpr int LDS_BYTES = 147456;
constexpr int LDSCTL_OFF = LDS_BYTES - 512, MISC_OFF = LDSCTL_OFF + 320;
constexpr int MOETAB_OFF = RING_BYTES;
constexpr int NWAVES = 8;

#define GAS __attribute__((address_space(1)))
#define LAS __attribute__((address_space(3)))
typedef unsigned short bf16;
typedef unsigned v4u __attribute__((ext_vector_type(4)));
typedef unsigned v2u __attribute__((ext_vector_type(2)));
typedef float f32x4 __attribute__((ext_vector_type(4)));
typedef float v2f __attribute__((ext_vector_type(2)));
typedef GAS unsigned gu32;
#define RLX_AGENT __ATOMIC_RELAXED, __HIP_MEMORY_SCOPE_AGENT
#define LDS_WAIT() asm volatile("s_waitcnt lgkmcnt(0)" ::: "memory")
#define VM_WAIT() asm volatile("s_waitcnt vmcnt(0)" ::: "memory")
__device__ __forceinline__ unsigned f2bf(float f) { unsigned u = __builtin_bit_cast(unsigned, f); return (u + 0x7fffu + ((u >> 16) & 1u)) >> 16; }
__device__ __forceinline__ unsigned pk2(float lo, float hi) { return f2bf(lo) | (f2bf(hi) << 16); }
__device__ __forceinline__ float bf2f(bf16 v) { return __uint_as_float(((unsigned)v) << 16); }
__device__ __forceinline__ float blo(unsigned w) { return __uint_as_float(w << 16); }
__device__ __forceinline__ float bhi(unsigned w) { return __uint_as_float(w & 0xffff0000u); }
__device__ __forceinline__ float sigmf(float x) { return __builtin_amdgcn_rcpf(1.0f + __builtin_amdgcn_exp2f(x * -1.4426950408889634f)); }
__host__ __device__ __forceinline__ int sw16(int x) { return (x & ~12) | ((x & 4) << 1) | ((x & 8) >> 1); }
__device__ __forceinline__ float wave_sum(float v) {
#pragma unroll
    for (int o = 1; o < 64; o <<= 1) v += __shfl_xor(v, o);
    return v;
}
__device__ __forceinline__ float wave_max(float v) {
#pragma unroll
    for (int o = 1; o < 64; o <<= 1) v = fmaxf(v, __shfl_xor(v, o));
    return v;
}

#define XB_TMO      128
#define XB_XCNT(j)  (256  + 64 * (j))
#define XB_XSUB(j)  (1280 + 64 * (j))
#define XB_XGEN(j)  (2304 + 64 * (j))
#define XB_TOP      3328
#define XB_TOPGEN   3392
#define XCD_BAR_WORDS 3456
#define XB_SPIN_CAP (1u << 18)

__device__ __forceinline__ unsigned xb_ld(unsigned* p)              { return __hip_atomic_load(p, __ATOMIC_RELAXED, __HIP_MEMORY_SCOPE_AGENT); }
__device__ __forceinline__ unsigned xb_add(unsigned* p, unsigned v) { return __hip_atomic_fetch_add(p, v, __ATOMIC_RELAXED, __HIP_MEMORY_SCOPE_AGENT); }
__device__ __forceinline__ unsigned xb_xcc_id() { return (unsigned)__builtin_amdgcn_s_getreg((3 << 11) | 20) & 0xFu; }
#define XB_SPIN(cond, bar) do { unsigned _sp = 0; while (cond) { __builtin_amdgcn_s_sleep(1); \
    if ((++_sp & 255u) == 0u) { if (xb_ld(&(bar)[XB_TMO])) break; if (_sp > XB_SPIN_CAP) { atomicAdd(&(bar)[XB_TMO], 1u); break; } } } } while (0)

struct XcdBarrier {
    unsigned* bar; unsigned x;
    volatile LAS unsigned* st;
};

__device__ __forceinline__ XcdBarrier xcd_barrier_post(unsigned* bar, volatile LAS unsigned* st) {
    XcdBarrier b; b.bar = bar; b.x = xb_xcc_id(); b.st = st;
    if (threadIdx.x == 0) (void)xb_add(&bar[XB_XCNT(b.x)], 1u);
    return b;
}
__device__ __forceinline__ void xcd_barrier_complete(unsigned* bar, unsigned x, unsigned& nloc, unsigned& nx) {
    const unsigned G = gridDim.x * gridDim.y * gridDim.z;
    unsigned sum, cnt, mine, sp = 0u;
    for (;;) {
        sum = 0u; cnt = 0u; mine = 0u;
#pragma unroll
        for (unsigned j = 0; j < 16; ++j) { const unsigned c = xb_ld(&bar[XB_XCNT(j)]); sum += c; cnt += (c > 0u) ? 1u : 0u; mine = (j == x) ? c : mine; }
        if (sum == G) break;
        __builtin_amdgcn_s_sleep(1);
        if ((++sp & 255u) == 0u) { if (xb_ld(&bar[XB_TMO])) break; if (sp > XB_SPIN_CAP) { atomicAdd(&bar[XB_TMO], 1u); break; } }
    }
    nloc = mine > 0u ? mine : 1u; nx = cnt > 0u ? cnt : 1u;
}

__device__ __forceinline__ void xcd_barrier(const XcdBarrier& b) {
    asm volatile("s_waitcnt vmcnt(0)" ::: "memory");
    __syncthreads();
    if (threadIdx.x == 0) {
        unsigned* bar = b.bar;
        __builtin_amdgcn_s_waitcnt(0);
        unsigned nloc = b.st[0], nx = b.st[1];
        if (nloc == 0u) { xcd_barrier_complete(bar, b.x, nloc, nx); b.st[0] = nloc; b.st[1] = nx; }
        const unsigned old = xb_add(&bar[XB_XSUB(b.x)], 1u);
        const unsigned gen = old / nloc;
        if (old + 1u == (gen + 1u) * nloc) {
            __builtin_amdgcn_fence(__ATOMIC_RELEASE, "agent");
            asm volatile("s_waitcnt vmcnt(0)" ::: "memory");
            const unsigned og = xb_add(&bar[XB_TOP], 1u);
            const unsigned tg = og / nx;
            if (og + 1u == (tg + 1u) * nx) xb_add(&bar[XB_TOPGEN], 1u);
            else XB_SPIN(xb_ld(&bar[XB_TOPGEN]) == tg, bar);
            __builtin_amdgcn_fence(__ATOMIC_ACQUIRE, "agent");
            xb_add(&bar[XB_XGEN(b.x)], 1u);
            asm volatile("s_waitcnt vmcnt(0)" ::: "memory");
        } else {
            XB_SPIN(xb_ld(&bar[XB_XGEN(b.x)]) == gen, bar);
            __builtin_amdgcn_fence(__ATOMIC_ACQUIRE, "agent");
            asm volatile("s_waitcnt vmcnt(0)" ::: "memory");
        }
    }
    __syncthreads();
}

struct Args { const float* in[27]; float* out; unsigned char* ws; int lo, hi; };
struct Frame {
    LAS unsigned char* lds;
    volatile LAS unsigned* MISC;
    gu32* ctl;
    int tid, lane, wave, vcu, G;
    int gtid, GT, gw, NGW;
};
constexpr int NSTEPS = 37;
#define LAUNDER_S(x) asm volatile("" : "+s"(x))
#define LAUNDER_V(x) asm volatile("" : "+v"(x))
#define inp(a, K) inp_<(K)>(a)
template <int K> __device__ __forceinline__ const float* inp_(const Args& a) { unsigned long long v = (unsigned long long)a.in[K]; LAUNDER_S(v); return (const float*)(GAS const float*)v; }
__device__ __forceinline__ unsigned char* wsp(const Args& a) { unsigned long long v = (unsigned long long)a.ws; LAUNDER_S(v); return (unsigned char*)(GAS unsigned char*)v; }
__device__ __forceinline__ float* outp(const Args& a) { unsigned long long v = (unsigned long long)a.out; LAUNDER_S(v); return (float*)(GAS float*)v; }
__device__ __forceinline__ Frame refr(const Frame& F0) { Frame F = F0; int tid = F0.tid; LAUNDER_V(tid); int v = F0.vcu; LAUNDER_S(v); F.tid = tid; F.lane = tid & 63; F.wave = __builtin_amdgcn_readfirstlane(tid >> 6); F.vcu = v; int G = F0.G; LAUNDER_S(G); F.G = G; F.GT = G * NWAVES * 64; F.NGW = G * NWAVES;
    F.gtid = v * (NWAVES * 64) + tid; F.gw = v * NWAVES + F.wave; return F; }

__device__ __forceinline__ void tr_item(const float* W, int ldw, int K, int col0, bf16* WT, int row0, int nblk, LAS float* scr, int item, int lane, const float* kscale = nullptr) {
    const int kb = item / nblk, nb = item - kb * nblk, k0 = 64 * kb, n0 = 64 * nb; const int kq = lane >> 4, n4 = (lane & 15) * 4;
    f32x4 v[16];
#pragma unroll
    for (int i = 0; i < 16; ++i) v[i] = *(const f32x4*)(W + (size_t)(k0 + 4 * i + kq) * ldw + col0 + n0 + n4);
    if (kscale) {
#pragma unroll
        for (int i = 0; i < 16; ++i) v[i] = v[i] * kscale[k0 + 4 * i + kq]; }
#pragma unroll
    for (int i = 0; i < 16; ++i) { LAS float* d = scr + (4 * i + kq) * 65 + n4; d[0] = v[i].x; d[1] = v[i].y; d[2] = v[i].z; d[3] = v[i].w; }
    LDS_WAIT();
    const int c = lane & 7;
#pragma unroll
    for (int j = 0; j < 8; ++j) { const int n = (lane >> 3) + 8 * j; const LAS float* s = scr + (8 * c) * 65 + n;
        v4u o; o.x = pk2(s[0 * 65], s[1 * 65]); o.y = pk2(s[2 * 65], s[3 * 65]); o.z = pk2(s[4 * 65], s[5 * 65]); o.w = pk2(s[6 * 65], s[7 * 65]);
        *(v4u*)(WT + (size_t)(row0 + n0 + n) * K + k0 + 8 * c) = o; }
    LDS_WAIT();
}
__device__ __forceinline__ void tr_item8(const float* W, int ldw, int K, int col0, unsigned char* WT, int row0, int nblk, float sc, LAS float* scr, int item, int lane) {
    const int kb = item / nblk, nb = item - kb * nblk, k0 = 64 * kb, n0 = 64 * nb; const int kq = lane >> 4, n4 = (lane & 15) * 4;
    f32x4 v[16];
#pragma unroll
    for (int i = 0; i < 16; ++i) v[i] = *(const f32x4*)(W + (size_t)(k0 + 4 * i + kq) * ldw + col0 + n0 + n4);
#pragma unroll
    for (int i = 0; i < 16; ++i) { LAS float* d = scr + (4 * i + kq) * 65 + n4; const f32x4 c = __builtin_elementwise_min(__builtin_elementwise_max(v[i] * sc, (f32x4){-448.f, -448.f, -448.f, -448.f}), (f32x4){448.f, 448.f, 448.f, 448.f}); d[0] = c.x; d[1] = c.y; d[2] = c.z; d[3] = c.w; }
    LDS_WAIT();
    const int c = lane & 7;
#pragma unroll
    for (int j = 0; j < 8; ++j) { const int n = (lane >> 3) + 8 * j; const LAS float* s = scr + (8 * c) * 65 + n;
        unsigned w0 = __builtin_amdgcn_cvt_pk_fp8_f32(s[0 * 65], s[1 * 65], 0u, false); w0 = __builtin_amdgcn_cvt_pk_fp8_f32(s[2 * 65], s[3 * 65], w0, true);
        unsigned w1 = __builtin_amdgcn_cvt_pk_fp8_f32(s[4 * 65], s[5 * 65], 0u, false); w1 = __builtin_amdgcn_cvt_pk_fp8_f32(s[6 * 65], s[7 * 65], w1, true);
        v2u o; o.x = w0; o.y = w1; *(v2u*)(WT + (size_t)(row0 + n0 + n) * K + k0 + 8 * c) = o; }
    LDS_WAIT();
}
__device__ __forceinline__ float rms_row_load(const float* xrow, const float* w, int lane, f32x4 (&v)[8]) {
    const f32x4* xr = (const f32x4*)xrow + lane; float ss = 0.f;
#pragma unroll
    for (int j = 0; j < 8; ++j) { v[j] = xr[64 * j]; ss += (v[j].x * v[j].x + v[j].y * v[j].y) + (v[j].z * v[j].z + v[j].w * v[j].w); }
    const float rinv = 1.0f / sqrtf(wave_sum(ss) * (1.f / D) + NORM_EPS);
    const f32x4* wr = (const f32x4*)w + lane;
#pragma unroll
    for (int j = 0; j < 8; ++j) { const f32x4 ww = wr[64 * j]; v[j] = v[j] * rinv * ww; }
    return rinv;
}
__device__ __forceinline__ void store_row_bf16(bf16* orow, int lane, const f32x4 (&v)[8]) {
    v2u* o8 = (v2u*)orow + lane;
#pragma unroll
    for (int j = 0; j < 8; ++j) { v2u w; w.x = pk2(v[j].x, v[j].y); w.y = pk2(v[j].z, v[j].w); o8[64 * j] = w; }
}

__device__ __forceinline__ void phW(const Frame& F0, const Args& a, int l) {
    const Frame F = refr(F0);
    unsigned char* ws = wsp(a);
    LAS float* scr = (LAS float*)(F.lds + F.wave * 16640);
    if (F.gw < 512) { const int c = F.gw >> 8, j = ((F.gw >> 6) & 3) * 64 + F.lane, seg = F.gw & 63;
        const float* w1 = inp(a, 5) + (size_t)(l * 2 + c) * 4096 * 256 + (size_t)seg * 64 * 256; const float* pos = inp(a, 4) + (size_t)(l * 2 + c) * 4096 + seg * 64;
        float a0 = 0.f, a1 = 0.f, a2 = 0.f, a3 = 0.f;
#pragma unroll 4
        for (int i = 0; i < 64; i += 4) { a0 += pos[i] * w1[(size_t)i * 256 + j]; a1 += pos[i + 1] * w1[(size_t)(i + 1) * 256 + j]; a2 += pos[i + 2] * w1[(size_t)(i + 2) * 256 + j]; a3 += pos[i + 3] * w1[(size_t)(i + 3) * 256 + j]; }
        ((float*)(ws + WS_CBG))[(seg * 2 + c) * 256 + j] = (a0 + a1) + (a2 + a3); }
    if (l == 0) { float* cosA = (float*)(ws + WS_TAB); float* sinA = cosA + 4096 * 64; float* cosC = sinA + 4096 * 64; float* sinC = cosC + 4096 * 32;
        for (int idx = F.gtid; idx < 4096 * 96; idx += F.GT) { const int s = idx / 96, i = idx - s * 96;
            const bool isA = i < 64; const int ii = isA ? i : i - 64; const float dim = isA ? 128.f : 64.f;
            const float inv = 1.0f / powf(10000.0f, (float)(2 * ii) / dim); const float ang = (float)s * inv;
            double r = (double)ang * 0.15915494309189533577; r -= floor(r); const float a2 = (float)(r * 6.28318530717958647692);
            const float cv = __cosf(a2), sv = __sinf(a2);
            if (isA) { cosA[s * 64 + ii] = cv; sinA[s * 64 + ii] = sv; } else { cosC[s * 32 + ii] = cv; sinC[s * 32 + ii] = sv; } } }
    bf16* WIN = (bf16*)(ws + WS_WIN); bf16* W1T = (bf16*)(ws + WS_W1); bf16* PT = (bf16*)(ws + WS_PT); bf16* WOUT = (bf16*)(ws + WS_WOUT); bf16* GU = (bf16*)(ws + WS_GU); bf16* DN = (bf16*)(ws + WS_DN);
    const float* w_in = inp(a, 3) + (size_t)l * D * IN_DIM;
    constexpr int I_IN0 = 32 * 40, I_IN1 = 32 * 40, I_IN2 = 32 * 20, I_IN3 = 32 * 96, I_W1 = 64 * 4, I_P = 16 * 32, I_O = 32 * 32, I_GU = 32 * 512, I_DN = 32 * 256;
    constexpr int NITEMS = I_IN0 + I_IN1 + I_IN2 + I_IN3 + 2 * I_W1 + 3 * I_P + I_O + I_GU + I_DN;
    for (int it = F.gw; it < NITEMS; it += F.NGW) {
        int r = it;
        if (r < I_IN0) { tr_item(w_in, IN_DIM, D, 0, WIN, 0, 40, scr, r, F.lane); continue; } r -= I_IN0;
        if (r < I_IN1) { tr_item(w_in, IN_DIM, D, 2584, WIN, 2560, 40, scr, r, F.lane); continue; } r -= I_IN1;
        if (r < I_IN2) { tr_item(w_in, IN_DIM, D, 5160, WIN, 5120, 20, scr, r, F.lane); continue; } r -= I_IN2;
        if (r < I_IN3) { tr_item8(w_in, IN_DIM, D, 6440, (unsigned char*)(ws + WS_WG8), 0, 96, 64.0f, scr, r, F.lane); continue; } r -= I_IN3;
        if (r < 2 * I_W1) { const int c = r / I_W1; tr_item(inp(a, 5) + (size_t)(l * 2 + c) * 4096 * 256, 256, 4096, 0, W1T + (size_t)c * 256 * 4096, 0, 4, scr, r - c * I_W1, F.lane); continue; } r -= 2 * I_W1;
        if (r < 3 * I_P) { const int i = r / I_P; tr_item((i == 0 ? inp(a, 15) : (i == 1 ? inp(a, 16) : inp(a, 17))) + (size_t)l * 1024 * 2048, 2048, 1024, 0, PT + (size_t)i * 2048 * 1024, 0, 32, scr, r - i * I_P, F.lane); continue; } r -= 3 * I_P;
        if (r < I_O) { tr_item(inp(a, 18) + (size_t)l * 2048 * 2048, 2048, 2048, 0, WOUT, 0, 32, scr, r, F.lane); continue; } r -= I_O;
        if (r < I_GU) { const int e = r >> 9, rr = r & 511, which = rr >> 8, t = (rr >> 6) & 3, i2 = rr & 63;
            tr_item((which == 0 ? inp(a, 23) : inp(a, 24)) + (size_t)(l * 32 + e) * 2048 * 512, 512, 2048, t * 128, GU + (size_t)e * 1024 * 2048, t * 256 + which * 128, 2, scr, i2, F.lane, inp(a, 2) + (size_t)l * D); continue; } r -= I_GU;
        { const int e = r >> 8, i2 = r & 255; tr_item(inp(a, 25) + (size_t)(l * 32 + e) * 512 * 2048, 2048, 512, 0, DN + (size_t)e * 2048 * 512, 0, 32, scr, i2, F.lane); }
    }
    { bf16* WRh = (bf16*)(ws + WS_WR); bf16* WRl = WRh + 64 * 2048; const float* nwf = inp(a, 2) + (size_t)l * D; const float* gr = inp(a, 19) + (size_t)l * D * 4; const float* er = inp(a, 21) + (size_t)l * D * 32;
      for (int idx = F.gtid; idx < 64 * 2048; idx += F.GT) { const int c = idx >> 11, k = idx & 2047; float v = 0.f; if (c < 4) v = nwf[k] * gr[(size_t)k * 4 + c]; else if (c < 36) v = nwf[k] * er[(size_t)k * 32 + (c - 4)];
          const unsigned hi = f2bf(v); const float rem = v - __uint_as_float(hi << 16); WRh[idx] = (bf16)hi; WRl[idx] = (bf16)f2bf(rem); } }
    { bf16* W2T = (bf16*)(ws + WS_W2T); const float* w2 = inp(a, 7) + (size_t)l * 2 * 256 * 128;
      for (int idx = F.gtid; idx < 2 * 128 * 256; idx += F.GT) { const int i = idx & 255, d = (idx >> 8) & 127, c = idx >> 15; W2T[idx] = (bf16)f2bf(w2[(size_t)(c * 256 + i) * 128 + d]); } }
    for (int idx = F.gtid; idx < 256 * 256; idx += F.GT) { const int n = idx >> 8, k8 = idx & 255; const int src = n < 24 ? 2560 + n : (n < 40 ? 5144 + (n - 24) : -1);
        float f[8];
#pragma unroll
        for (int j = 0; j < 8; ++j) f[j] = src >= 0 ? w_in[(size_t)(k8 * 8 + j) * IN_DIM + src] : 0.f;
        v4u o; o.x = pk2(f[0], f[1]); o.y = pk2(f[2], f[3]); o.z = pk2(f[4], f[5]); o.w = pk2(f[6], f[7]);
        *(v4u*)(WIN + (size_t)(6400 + n) * D + k8 * 8) = o; }
}

__device__ __forceinline__ void moe_tables(const Frame& F0, int ly) {
    const Frame F = refr(F0);
    LAS int* tab = (LAS int*)(F.lds + MOETAB_OFF); gu32* cnt = F.ctl + CW_ECNT + ly * 32 * 64;
    __syncthreads();
    if (F.tid < 32) tab[64 + F.tid] = (int)__hip_atomic_load(cnt + F.tid * 64, RLX_AGENT);
    __syncthreads();
    if (F.tid == 0) { int o = 0; for (int e = 0; e < 32; ++e) { tab[e] = o; o += (tab[64 + e] + 255) & ~255; } tab[32] = o; tab[128] = o >> 8; }
    __syncthreads();
    for (int p = F.tid; p < (tab[32] >> 8); p += NWAVES * 64) { int e = 0; for (int q = 1; q < 32; ++q) if (p * 256 >= tab[q]) e = q; tab[192 + p] = e; }
    __syncthreads();
}
__device__ __forceinline__ void phA(const Frame& F0, const Args& a, int l) {
    const Frame F = refr(F0);
    unsigned char* ws = wsp(a); const float* xin = (l == 0 ? inp(a, 0) : outp(a)); float* xo = outp(a); const float* w = inp(a, 1) + l * D;
    const unsigned* ROUTE = (const unsigned*)(ws + WS_ROUTE); const bf16* YG = (const bf16*)(ws + WS_XG); const LAS int* tab = (const LAS int*)(F.lds + MOETAB_OFF);
    if (l > 0) moe_tables(F, l - 1);
    for (int m = F.gw; m < T; m += F.NGW) { f32x4 v[8]; const f32x4* xr = (const f32x4*)(xin + (size_t)m * D) + F.lane;
#pragma unroll
        for (int j = 0; j < 8; ++j) v[j] = xr[64 * j];
        if (l > 0) { const v4u rr = *(const v4u*)(ROUTE + (size_t)m * 8); const unsigned s0 = tab[rr.x] + rr.z, s1 = tab[rr.y] + rr.w; const v2u* y0 = (const v2u*)(YG + (size_t)s0 * D) + F.lane; const v2u* y1 = (const v2u*)(YG + (size_t)s1 * D) + F.lane;
            f32x4* xw = (f32x4*)(xo + (size_t)m * D) + F.lane;
#pragma unroll
            for (int j = 0; j < 8; ++j) { const v2u a0 = y0[64 * j], a1 = y1[64 * j]; v[j].x += blo(a0.x) + blo(a1.x); v[j].y += bhi(a0.x) + bhi(a1.x); v[j].z += blo(a0.y) + blo(a1.y); v[j].w += bhi(a0.y) + bhi(a1.y); xw[64 * j] = v[j]; } }
        float ss = 0.f;
#pragma unroll
        for (int j = 0; j < 8; ++j) ss += (v[j].x * v[j].x + v[j].y * v[j].y) + (v[j].z * v[j].z + v[j].w * v[j].w);
        const float rinv = 1.0f / sqrtf(wave_sum(ss) * (1.f / D) + NORM_EPS); const f32x4* wr = (const f32x4*)w + F.lane;
#pragma unroll
        for (int j = 0; j < 8; ++j) { const f32x4 ww = wr[64 * j]; v[j] = v[j] * rinv * ww; }
        bf16* HN = (bf16*)(ws + (m < TH ? WS_HN : WS_HN1)); store_row_bf16(HN + (size_t)(m < TH ? m : m - TH) * D, F.lane, v);
        unsigned* h8 = (unsigned*)(ws + WS_HN8 + (size_t)m * D) + F.lane;
#pragma unroll
        for (int j = 0; j < 8; ++j) { const f32x4 c = __builtin_elementwise_min(__builtin_elementwise_max(v[j] * 16.f, (f32x4){-448.f, -448.f, -448.f, -448.f}), (f32x4){448.f, 448.f, 448.f, 448.f});
            unsigned w = __builtin_amdgcn_cvt_pk_fp8_f32(c.x, c.y, 0u, false); w = __builtin_amdgcn_cvt_pk_fp8_f32(c.z, c.w, w, true); h8[64 * j] = w; } }
}
__device__ __forceinline__ void ph_bias(const Frame& F0, const Args& a, int l) {
    const Frame F = refr(F0);
    if (F.vcu == 0) { unsigned char* ws = wsp(a); const float* part = (const float*)(ws + WS_CBG); float acc = inp(a, 6)[l * 512 + F.tid];
#pragma unroll 8
        for (int seg = 0; seg < 64; ++seg) acc += part[seg * 512 + F.tid];
        ((float*)(ws + WS_B1P))[F.tid] = acc; }
}
__device__ __forceinline__ void phFinal(const Frame& F0, const Args& a) {
    const Frame F = refr(F0);
    unsigned char* ws = wsp(a); float* xo = outp(a); const float* w = inp(a, 26); const unsigned* ROUTE = (const unsigned*)(ws + WS_ROUTE); const bf16* YG = (const bf16*)(ws + WS_XG); const LAS int* tab = (const LAS int*)(F.lds + MOETAB_OFF);
    moe_tables(F, 1);
    for (int m = F.gw; m < T; m += F.NGW) { f32x4 v[8]; f32x4* xr = (f32x4*)(xo + (size_t)m * D) + F.lane;
        const v4u rr = *(const v4u*)(ROUTE + (size_t)m * 8); const unsigned s0 = tab[rr.x] + rr.z, s1 = tab[rr.y] + rr.w; const v2u* y0 = (const v2u*)(YG + (size_t)s0 * D) + F.lane; const v2u* y1 = (const v2u*)(YG + (size_t)s1 * D) + F.lane;
        float ss = 0.f;
#pragma unroll
        for (int j = 0; j < 8; ++j) { v[j] = xr[64 * j]; const v2u a0 = y0[64 * j], a1 = y1[64 * j]; v[j].x += blo(a0.x) + blo(a1.x); v[j].y += bhi(a0.x) + bhi(a1.x); v[j].z += blo(a0.y) + blo(a1.y); v[j].w += bhi(a0.y) + bhi(a1.y);
            ss += (v[j].x * v[j].x + v[j].y * v[j].y) + (v[j].z * v[j].z + v[j].w * v[j].w); }
        const float rinv = 1.0f / sqrtf(wave_sum(ss) * (1.f / D) + NORM_EPS); const f32x4* wr = (const f32x4*)w + F.lane;
#pragma unroll
        for (int j = 0; j < 8; ++j) { const f32x4 ww = wr[64 * j]; xr[64 * j] = v[j] * rinv * ww; } }
}
__device__ __forceinline__ void rope_pair(bf16* p1, bf16* p2, bf16* o1, bf16* o2, float c, float s) { const float x1 = bf2f(*p1), x2 = bf2f(*p2); *o1 = (bf16)f2bf(x1 * c - x2 * s); *o2 = (bf16)f2bf(x2 * c + x1 * s); }
__device__ __forceinline__ void phC_elem(const Frame& F0, const Args& a, int l, bool split) {
    const Frame F = refr(F0);
    const int vb = split ? F.vcu - 64 : F.vcu, nb = split ? F.G - 64 : F.G; const int gtid = vb * 512 + F.tid, GT = nb * 512, gw = vb * 8 + F.wave, NGW = nb * 8;
    unsigned char* ws = wsp(a); bf16* U = (bf16*)(ws + WS_U); bf16* XC = (bf16*)(ws + WS_XC); const float* SM = (const float*)(ws + WS_SM);
    const float* cosA = (const float*)(ws + WS_TAB); const float* sinA = cosA + 4096 * 64; const float* cosC = sinA + 4096 * 64; const float* sinC = cosC + 4096 * 32;
#pragma unroll 2
    for (int idx = gtid; idx < TH * 40; idx += GT) { const int tok = idx / 40, it = idx - tok * 40, s = tok & 4095; bf16* ur = U + (size_t)tok * UP;
        if (it < 32) { const int blk = it >> 3, i8 = (it & 7) * 8; bf16* p = ur + (blk < 2 ? 1536 + blk * 128 : 2048 + (blk - 2) * 128) + i8;
            const v4u x1 = *(const v4u*)p, x2 = *(const v4u*)(p + 64); const f32x4 c0 = *(const f32x4*)(cosA + s * 64 + i8), c1 = *(const f32x4*)(cosA + s * 64 + i8 + 4), s0 = *(const f32x4*)(sinA + s * 64 + i8), s1 = *(const f32x4*)(sinA + s * 64 + i8 + 4);
            v4u o1, o2;
            o1.x = pk2(blo(x1.x) * c0.x - blo(x2.x) * s0.x, bhi(x1.x) * c0.y - bhi(x2.x) * s0.y); o2.x = pk2(blo(x2.x) * c0.x + blo(x1.x) * s0.x, bhi(x2.x) * c0.y + bhi(x1.x) * s0.y);
            o1.y = pk2(blo(x1.y) * c0.z - blo(x2.y) * s0.z, bhi(x1.y) * c0.w - bhi(x2.y) * s0.w); o2.y = pk2(blo(x2.y) * c0.z + blo(x1.y) * s0.z, bhi(x2.y) * c0.w + bhi(x1.y) * s0.w);
            o1.z = pk2(blo(x1.z) * c1.x - blo(x2.z) * s1.x, bhi(x1.z) * c1.y - bhi(x2.z) * s1.y); o2.z = pk2(blo(x2.z) * c1.x + blo(x1.z) * s1.x, bhi(x2.z) * c1.y + bhi(x1.z) * s1.y);
            o1.w = pk2(blo(x1.w) * c1.z - blo(x2.w) * s1.z, bhi(x1.w) * c1.w - bhi(x2.w) * s1.w); o2.w = pk2(blo(x2.w) * c1.z + blo(x1.w) * s1.z, bhi(x2.w) * c1.w + bhi(x1.w) * s1.w);
            *(v4u*)p = o1; *(v4u*)(p + 64) = o2; }
        else { const int q = it - 32, g = q >> 2, i8 = (q & 3) * 8; bf16* p = ur + UC_SKV + g * 64 + i8;
            const v4u x1 = *(const v4u*)p, x2 = *(const v4u*)(p + 32); const f32x4 c0 = *(const f32x4*)(cosC + s * 32 + i8), c1 = *(const f32x4*)(cosC + s * 32 + i8 + 4), s0 = *(const f32x4*)(sinC + s * 32 + i8), s1 = *(const f32x4*)(sinC + s * 32 + i8 + 4);
            v4u o1, o2;
            o1.x = pk2(blo(x1.x) * c0.x - blo(x2.x) * s0.x, bhi(x1.x) * c0.y - bhi(x2.x) * s0.y); o2.x = pk2(blo(x2.x) * c0.x + blo(x1.x) * s0.x, bhi(x2.x) * c0.y + bhi(x1.x) * s0.y);
            o1.y = pk2(blo(x1.y) * c0.z - blo(x2.y) * s0.z, bhi(x1.y) * c0.w - bhi(x2.y) * s0.w); o2.y = pk2(blo(x2.y) * c0.z + blo(x1.y) * s0.z, bhi(x2.y) * c0.w + bhi(x1.y) * s0.w);
            o1.z = pk2(blo(x1.z) * c1.x - blo(x2.z) * s1.x, bhi(x1.z) * c1.y - bhi(x2.z) * s1.y); o2.z = pk2(blo(x2.z) * c1.x + blo(x1.z) * s1.x, bhi(x2.z) * c1.y + bhi(x1.z) * s1.y);
            o1.w = pk2(blo(x1.w) * c1.z - blo(x2.w) * s1.z, bhi(x1.w) * c1.w - bhi(x2.w) * s1.w); o2.w = pk2(blo(x2.w) * c1.z + blo(x1.w) * s1.z, bhi(x2.w) * c1.w + bhi(x1.w) * s1.w);
            *(v4u*)p = o1; *(v4u*)(p + 32) = o2; } }
    const float* cw = inp(a, 8) + (size_t)l * 4 * 1536; const float* cb = inp(a, 9) + (size_t)l * 1536;
#pragma unroll 2
    for (int idx = gtid; idx < (TH / 4) * 192; idx += GT) { const int t4 = idx / 192, c8 = (idx - t4 * 192) * 8, tok = t4 * 4, s = tok & 4095;
        float w[4][8], bias[8];
#pragma unroll
        for (int k = 0; k < 4; ++k) { const f32x4 a0 = *(const f32x4*)(cw + k * 1536 + c8), a1 = *(const f32x4*)(cw + k * 1536 + c8 + 4); w[k][0] = a0.x; w[k][1] = a0.y; w[k][2] = a0.z; w[k][3] = a0.w; w[k][4] = a1.x; w[k][5] = a1.y; w[k][6] = a1.z; w[k][7] = a1.w; }
        { const f32x4 a0 = *(const f32x4*)(cb + c8), a1 = *(const f32x4*)(cb + c8 + 4); bias[0] = a0.x; bias[1] = a0.y; bias[2] = a0.z; bias[3] = a0.w; bias[4] = a1.x; bias[5] = a1.y; bias[6] = a1.z; bias[7] = a1.w; }
        float acc[4][8];
#pragma unroll
        for (int t = 0; t < 4; ++t)
#pragma unroll
            for (int e = 0; e < 8; ++e) acc[t][e] = bias[e];
#pragma unroll
        for (int r = 0; r < 7; ++r) { const int sp = s - 3 + r; v4u x = (v4u){0u, 0u, 0u, 0u}; if (sp >= 0) x = *(const v4u*)(U + (size_t)(tok - 3 + r) * UP + UC_XBC + c8);
            const float xf[8] = {blo(x.x), bhi(x.x), blo(x.y), bhi(x.y), blo(x.z), bhi(x.z), blo(x.w), bhi(x.w)};
#pragma unroll
            for (int t = 0; t < 4; ++t) { const int k = r - t; if (k >= 0 && k < 4) {
#pragma unroll
                for (int e = 0; e < 8; ++e) acc[t][e] += w[k][e] * xf[e]; } } }
#pragma unroll
        for (int t = 0; t < 4; ++t) { v4u o; o.x = pk2(acc[t][0] * sigmf(acc[t][0]), acc[t][1] * sigmf(acc[t][1])); o.y = pk2(acc[t][2] * sigmf(acc[t][2]), acc[t][3] * sigmf(acc[t][3]));
            o.z = pk2(acc[t][4] * sigmf(acc[t][4]), acc[t][5] * sigmf(acc[t][5])); o.w = pk2(acc[t][6] * sigmf(acc[t][6]), acc[t][7] * sigmf(acc[t][7])); *(v4u*)(XC + (size_t)(tok + t) * 1536 + c8) = o; } }
    float* DTV = (float*)(ws + WS_DTV); float* ACS = (float*)(ws + WS_ACS);
    for (int it = gw; it < HBN * 32 * 16; it += NGW) { const int b = it >> 9, c = (it >> 4) & 31, h = it & 15; const int tok0 = b * 4096 + c * 128 + 2 * F.lane;
        const float bias = inp(a, 10)[l * 16 + h], A = -__expf(inp(a, 11)[l * 16 + h]);
        const float r0 = SM[(size_t)tok0 * 64 + 24 + h] + bias, r1 = SM[(size_t)(tok0 + 1) * 64 + 24 + h] + bias;
        const float d0 = fmaxf(r0, 0.f) + log1pf(__expf(-fabsf(r0))), d1 = fmaxf(r1, 0.f) + log1pf(__expf(-fabsf(r1)));
        const float a0 = d0 * A, a1 = d1 * A; float x = a0 + a1;
#pragma unroll
        for (int o = 1; o < 64; o <<= 1) { const float t = __shfl_up(x, o); if (F.lane >= o) x += t; }
        DTV[(size_t)tok0 * 16 + h] = d0; DTV[(size_t)(tok0 + 1) * 16 + h] = d1; ACS[(size_t)tok0 * 16 + h] = x - a1; ACS[(size_t)(tok0 + 1) * 16 + h] = x; }
}


namespace fa {
typedef float f32x16 __attribute__((ext_vector_type(16)));
typedef short bf16x8 __attribute__((ext_vector_type(8)));
typedef short s16x4 __attribute__((ext_vector_type(4)));
typedef float f32x2_t __attribute__((ext_vector_type(2)));
typedef __bf16 bf16x2_t __attribute__((ext_vector_type(2)));
#define FA_MFMA(a, b, c) __builtin_amdgcn_mfma_f32_32x32x16_bf16((a), (b), (c), 0, 0, 0)
__device__ __forceinline__ unsigned cvtpk(float lo, float hi) { f32x2_t v = {lo, hi}; bf16x2_t b = __builtin_convertvector(v, bf16x2_t); return __builtin_bit_cast(unsigned, b); }
__device__ __forceinline__ float xhalf_max(float x) { const auto r = __builtin_amdgcn_permlane32_swap(__float_as_uint(x), __float_as_uint(x), false, false); return fmaxf(__uint_as_float(r[0]), __uint_as_float(r[1])); }
__device__ __forceinline__ float xhalf_sum(float x) { const auto r = __builtin_amdgcn_permlane32_swap(__float_as_uint(x), __float_as_uint(x), false, false); return __uint_as_float(r[0]) + __uint_as_float(r[1]); }
__device__ __forceinline__ float quad_sum(float x) { x += __builtin_bit_cast(float, __builtin_amdgcn_mov_dpp(__builtin_bit_cast(int, x), 0xB1, 0xF, 0xF, true)); x += __builtin_bit_cast(float, __builtin_amdgcn_mov_dpp(__builtin_bit_cast(int, x), 0x4E, 0xF, 0xF, true)); return x; }
__device__ __forceinline__ int crow(int reg, int h) { return (reg & 3) + 8 * (reg >> 2) + 4 * h; }
constexpr int VP = 144;
template <int DH> struct Geo { static constexpr int KP = DH * 2 + 16, KBYTES = 64 * KP, VBYTES = DH * VP, BUF = KBYTES + VBYTES, NCH = DH / 64  ; };

template <int DH> struct Stage { v4u k[Geo<DH>::NCH], v[Geo<DH>::NCH]; };
template <int DH>
__device__ __forceinline__ void tile_load(Stage<DH>& st, const bf16* Kb, int kpitch, const bf16* VTb, int vtpitch, int key0, int tid) {
#pragma unroll
    for (int i = 0; i < Geo<DH>::NCH; ++i) { const int c = tid + i * 512; const int row = c / (DH / 8), col8 = c % (DH / 8); st.k[i] = *(const v4u*)(Kb + (size_t)(key0 + row) * kpitch + col8 * 8);
        const int d = c >> 3, k8 = c & 7; st.v[i] = *(const v4u*)(VTb + (size_t)d * vtpitch + key0 + k8 * 8); }
}
template <int DH>
__device__ __forceinline__ void tile_store(const Stage<DH>& st, LAS unsigned char* buf, int tid) {
#pragma unroll
    for (int i = 0; i < Geo<DH>::NCH; ++i) { const int c = tid + i * 512; const int row = c / (DH / 8), col8 = c % (DH / 8); *(LAS v4u*)(buf + row * Geo<DH>::KP + col8 * 16) = st.k[i];
        const int d = c >> 3, k8 = c & 7; *(LAS v4u*)(buf + Geo<DH>::KBYTES + d * VP + k8 * 16) = st.v[i]; }
}
template <int DH>
__device__ __forceinline__ void qk_tile(const LAS unsigned char* buf, const bf16x8 (&qf)[DH / 16], int r32, int h, f32x16& s0, f32x16& s1) {
#pragma unroll
    for (int i = 0; i < 16; ++i) { s0[i] = 0.f; s1[i] = 0.f; }
    const LAS unsigned char* p0 = buf + r32 * Geo<DH>::KP + 16 * h; const LAS unsigned char* p1 = p0 + 32 * Geo<DH>::KP;
    constexpr int NG = DH / 32;
    bf16x8 a[2][2], b[2][2];
#pragma unroll
    for (int q = 0; q < 2; ++q) { a[0][q] = *(const LAS bf16x8*)(p0 + 32 * q); b[0][q] = *(const LAS bf16x8*)(p1 + 32 * q); }
    __builtin_amdgcn_sched_barrier(0);
#pragma unroll
    for (int g = 0; g < NG; ++g) {
        if (g + 1 < NG) {
#pragma unroll
            for (int q = 0; q < 2; ++q) { a[(g + 1) & 1][q] = *(const LAS bf16x8*)(p0 + 32 * (2 * (g + 1) + q)); b[(g + 1) & 1][q] = *(const LAS bf16x8*)(p1 + 32 * (2 * (g + 1) + q)); } }
        __builtin_amdgcn_sched_barrier(0);
#pragma unroll
        for (int q = 0; q < 2; ++q) { s0 = FA_MFMA(a[g & 1][q], qf[2 * g + q], s0); s1 = FA_MFMA(b[g & 1][q], qf[2 * g + q], s1); }
        __builtin_amdgcn_sched_barrier(0); }
}
template <int DH>
__device__ __forceinline__ void pv_tile(const LAS unsigned char* buf, const bf16x8 (&pf)[2][2], int r32, int h, f32x16 (&ot)[DH / 32]) {
    constexpr int NB = DH / 32; const LAS unsigned char* vb = buf + Geo<DH>::KBYTES + r32 * VP + 16 * h;
    bf16x8 a[2][NB];
#pragma unroll
    for (int db = 0; db < NB; ++db) a[0][db] = *(const LAS bf16x8*)(vb + 32 * db * VP);
    __builtin_amdgcn_sched_barrier(0);
#pragma unroll
    for (int t = 0; t < 4; ++t) {
        if (t < 3) {
#pragma unroll
            for (int db = 0; db < NB; ++db) a[(t + 1) & 1][db] = *(const LAS bf16x8*)(vb + 32 * db * VP + 32 * (t + 1)); }
        __builtin_amdgcn_sched_barrier(0);
#pragma unroll
        for (int db = 0; db < NB; ++db) ot[db] = FA_MFMA(a[t & 1][db], pf[t >> 1][t & 1], ot[db]);
        __builtin_amdgcn_sched_barrier(0); }
}
__device__ __forceinline__ void pack_p(const f32x16& p, bf16x8 (&pf)[2]) {
#pragma unroll
    for (int s = 0; s < 2; ++s) { v4u w; w.x = cvtpk(p[8 * s], p[8 * s + 1]); w.y = cvtpk(p[8 * s + 2], p[8 * s + 3]); w.z = cvtpk(p[8 * s + 4], p[8 * s + 5]); w.w = cvtpk(p[8 * s + 6], p[8 * s + 7]); pf[s] = __builtin_bit_cast(bf16x8, w); }
}
template <int DH>
__device__ __forceinline__ void load_qf(const bf16* qrow, int h, float sc, bf16x8 (&qf)[DH / 16]) {
#pragma unroll
    for (int ks = 0; ks < DH / 16; ++ks) { const v4u w = *(const v4u*)(qrow + 16 * ks + 8 * h); v4u o;
        o.x = cvtpk(blo(w.x) * sc, bhi(w.x) * sc); o.y = cvtpk(blo(w.y) * sc, bhi(w.y) * sc); o.z = cvtpk(blo(w.z) * sc, bhi(w.z) * sc); o.w = cvtpk(blo(w.w) * sc, bhi(w.w) * sc); qf[ks] = __builtin_bit_cast(bf16x8, o); }
}
template <int DH>
__device__ __forceinline__ void load_qf_rope(const bf16* qrow, int h, float sc, const float* cs, const float* sn, bf16x8 (&qf)[DH / 16]) {
#pragma unroll
    for (int ks = 0; ks < DH / 32; ++ks) { const int i0 = 16 * ks + 8 * h; const v4u a = *(const v4u*)(qrow + i0), b = *(const v4u*)(qrow + DH / 2 + i0);
        const f32x4 c0 = *(const f32x4*)(cs + i0), c1 = *(const f32x4*)(cs + i0 + 4), s0 = *(const f32x4*)(sn + i0), s1 = *(const f32x4*)(sn + i0 + 4);
        const float x1[8] = {blo(a.x), bhi(a.x), blo(a.y), bhi(a.y), blo(a.z), bhi(a.z), blo(a.w), bhi(a.w)}, x2[8] = {blo(b.x), bhi(b.x), blo(b.y), bhi(b.y), blo(b.z), bhi(b.z), blo(b.w), bhi(b.w)};
        const float c[8] = {c0.x, c0.y, c0.z, c0.w, c1.x, c1.y, c1.z, c1.w}, s[8] = {s0.x, s0.y, s0.z, s0.w, s1.x, s1.y, s1.z, s1.w};
        float y1[8], y2[8];
#pragma unroll
        for (int e = 0; e < 8; ++e) { y1[e] = (x1[e] * c[e] - x2[e] * s[e]) * sc; y2[e] = (x2[e] * c[e] + x1[e] * s[e]) * sc; }
        v4u o1, o2; o1.x = cvtpk(y1[0], y1[1]); o1.y = cvtpk(y1[2], y1[3]); o1.z = cvtpk(y1[4], y1[5]); o1.w = cvtpk(y1[6], y1[7]); o2.x = cvtpk(y2[0], y2[1]); o2.y = cvtpk(y2[2], y2[3]); o2.z = cvtpk(y2[4], y2[5]); o2.w = cvtpk(y2[6], y2[7]);
        qf[ks] = __builtin_bit_cast(bf16x8, o1); qf[ks + DH / 32] = __builtin_bit_cast(bf16x8, o2); }
}
template <int DH, class V>
__device__ __forceinline__ void softmax_step(f32x16& s0, f32x16& s1, int h, bool laneoff, bool domask, const V& valid, float& m, float& l, f32x16 (&ot)[DH / 32], bf16x8 (&pf)[2][2]) {
    if (domask) {
#pragma unroll
        for (int i = 0; i < 16; ++i) { if (!valid(crow(i, h))) s0[i] = -1e30f; if (!valid(32 + crow(i, h))) s1[i] = -1e30f; } }
    float mx = fmaxf(s0[0], s1[0]);
#pragma unroll
    for (int i = 1; i < 16; ++i) mx = fmaxf(mx, fmaxf(s0[i], s1[i]));
    mx = xhalf_max(mx);
    const float mn = laneoff ? m : fmaxf(m, mx); const float al = __builtin_amdgcn_exp2f(m - mn); m = mn;
    const float mb = laneoff ? 3e38f : mn;
    float sum = 0.f;
#pragma unroll
    for (int i = 0; i < 16; ++i) { float p0 = __builtin_amdgcn_exp2f(s0[i] - mb), p1 = __builtin_amdgcn_exp2f(s1[i] - mb);
        if (domask) { if (s0[i] <= -1e30f) p0 = 0.f; if (s1[i] <= -1e30f) p1 = 0.f; }
        s0[i] = p0; s1[i] = p1; sum += p0 + p1; }
    l = l * al + sum;
    if (__any(al != 1.0f)) {
#pragma unroll
        for (int db = 0; db < DH / 32; ++db)
#pragma unroll
            for (int i = 0; i < 16; ++i) ot[db][i] *= al; }
    pack_p(s0, pf[0]); pack_p(s1, pf[1]);
}
}

template <int DH, class MaskF>
__device__ __forceinline__ void fa_unit(LAS unsigned char* lds, int tid, const bf16* Kb, int kpitch, const bf16* VTb, int vtpitch, int jt0, int jt1,
                                        const bf16* qrow, float qscale, const float* rcs, const float* rsn, const MaskF& mf, float& m, float& l, fa::f32x16 (&ot)[DH / 32]) {
    const int lane = tid & 63, r32 = lane & 31, h = lane >> 5;
    fa::bf16x8 qf[DH / 16]; fa::load_qf_rope<DH>(qrow, h, qscale, rcs, rsn, qf);
    fa::Stage<DH> st; fa::tile_load<DH>(st, Kb, kpitch, VTb, vtpitch, jt0 * 64, tid);
    for (int j = jt0; j <= jt1; ++j) {
        LAS unsigned char* buf = lds + ((j - jt0) & 1) * fa::Geo<DH>::BUF;
        fa::tile_store<DH>(st, buf, tid);
        __syncthreads();
        if (j < jt1) fa::tile_load<DH>(st, Kb, kpitch, VTb, vtpitch, (j + 1) * 64, tid);
        if (!mf.skip(j)) {
            fa::f32x16 s0, s1; fa::qk_tile<DH>(buf, qf, r32, h, s0, s1);
            fa::bf16x8 pf[2][2];
            fa::softmax_step<DH>(s0, s1, h, mf.laneoff(j), mf.domask(j), [&](int kl) { return mf.valid(j, kl); }, m, l, ot, pf);
            fa::pv_tile<DH>(buf, pf, r32, h, ot);
        }
    }
    __syncthreads();
}
struct BandMask {
    int sq, sq0, W;
    __device__ __forceinline__ bool skip(int j) const { return 64 * j > sq0 + 31 || 64 * j + 63 + W <= sq0; }
    __device__ __forceinline__ bool laneoff(int) const { return false; }
    __device__ __forceinline__ bool domask(int j) const { return !(64 * j + 63 <= sq0 && 64 * j + W > sq0 + 31); }
    __device__ __forceinline__ bool valid(int j, int kl) const { const int key = 64 * j + kl; return key <= sq && key + W > sq; }
};
struct SlcMask {
    int sq, sq0; unsigned mlo, mhi;
    __device__ __forceinline__ bool sel(int j) const { return ((j < 32 ? (mlo >> j) : (mhi >> (j - 32))) & 1u) != 0u; }
    __device__ __forceinline__ bool skip(int j) const { return __ballot(sel(j)) == 0ull; }
    __device__ __forceinline__ bool laneoff(int j) const { return !sel(j); }
    __device__ __forceinline__ bool domask(int j) const { return 64 * j + 63 > sq0; }
    __device__ __forceinline__ bool valid(int j, int kl) const { return 64 * j + kl <= sq; }
};
constexpr float LOG2E = 1.4426950408889634f;
__device__ __forceinline__ bool unit_map(const Frame& F, int i, int nqt, bool zig, int& bg, int& qt) {
    if (F.G == 256) { if (32 * i >= nqt) return false; bg = F.vcu >> 5; const int q = F.vcu & 31; qt = 32 * i + ((zig && (i & 1)) ? 31 - q : q); return true; }
    const int u = i * F.G + F.vcu; if (u >= 8 * nqt) return false; bg = u & 7; qt = u >> 3; return true;
}

__device__ __forceinline__ void ph_win_mfma(const Frame& F0, const Args& a) {
    const Frame F = refr(F0);
    unsigned char* ws = wsp(a); const bf16* U = (const bf16*)(ws + WS_U); bf16* OA = (bf16*)(ws + WS_OA); const float* SM = (const float*)(ws + WS_SM); const bf16* VT = (const bf16*)(ws + WS_VTW); const float* cosA = (const float*)(ws + WS_TAB); const float* sinA = cosA + 4096 * 64;
    const int r32 = F.lane & 31, h = F.lane >> 5, r = F.wave >> 1, toff = (F.wave & 1) * 32 + r32;
    for (int ui = 0;; ++ui) { int bg, qt; if (!unit_map(F, ui, 64, false, bg, qt)) break; const int b = bg >> 1, g = bg & 1; const int sq = qt * 64 + toff, tok = b * 4096 + sq;
        float m = -1e30f, l = 0.f; fa::f32x16 ot[4];
#pragma unroll
        for (int db = 0; db < 4; ++db)
#pragma unroll
            for (int i = 0; i < 16; ++i) ot[db][i] = 0.f;
        const BandMask mf{sq, qt * 64 + (F.wave & 1) * 32, 512};
        fa_unit<128, BandMask>(F.lds, F.tid, U + (size_t)(b * 4096) * UP + 2048 + g * 128, UP, VT + (size_t)((b * 2 + g) * 128) * 4096, 4096, qt > 8 ? qt - 8 : 0, qt,
                               U + (size_t)tok * UP + UC_Q + (g * 4 + r) * 128, 0.08838834764831845f * LOG2E, cosA + sq * 64, sinA + sq * 64, mf, m, l, ot);
        l = fa::xhalf_sum(l); const float sc = sigmf(SM[(size_t)tok * 64 + (g * 4 + r) * 3 + 2]) / l; bf16* op = OA + (size_t)tok * 1024 + (g * 4 + r) * 128;
#pragma unroll
        for (int db = 0; db < 4; ++db)
#pragma unroll
            for (int q = 0; q < 4; ++q) { v2u w; w.x = fa::cvtpk(ot[db][4 * q] * sc, ot[db][4 * q + 1] * sc); w.y = fa::cvtpk(ot[db][4 * q + 2] * sc, ot[db][4 * q + 3] * sc); *(v2u*)(op + 32 * db + 8 * q + 4 * h) = w; } }
}
__device__ __forceinline__ void ph_slc_mfma(const Frame& F0, const Args& a, bf16* OA) {
    const Frame F = refr(F0);
    unsigned char* ws = wsp(a); const bf16* U = (const bf16*)(ws + WS_U); const float* SM = (const float*)(ws + WS_SM); const bf16* VT = (const bf16*)(ws + WS_VTS); const float* cosA = (const float*)(ws + WS_TAB); const float* sinA = cosA + 4096 * 64;
    const unsigned long long* SEL = (const unsigned long long*)(ws + WS_SEL);
    const int r32 = F.lane & 31, h = F.lane >> 5, r = F.wave >> 1, toff = (F.wave & 1) * 32 + r32; constexpr int NU = HBN * 2 * 64;
    for (int i = 0;; ++i) { int bg, qt; if (!unit_map(F, i, 64, true, bg, qt)) break; const int b = bg >> 1, g = bg & 1; const int sq = qt * 64 + toff, tok = b * 4096 + sq;
        const unsigned long long mk = SEL[(size_t)(b * 2 + g) * 4096 + sq];
        float m = -1e30f, l = 0.f; fa::f32x16 ot[4];
#pragma unroll
        for (int db = 0; db < 4; ++db)
#pragma unroll
            for (int i2 = 0; i2 < 16; ++i2) ot[db][i2] = 0.f;
        const SlcMask mf{sq, qt * 64 + (F.wave & 1) * 32, (unsigned)mk, (unsigned)(mk >> 32)};
        fa_unit<128, SlcMask>(F.lds, F.tid, U + (size_t)(b * 4096) * UP + 1536 + g * 128, UP, VT + (size_t)((b * 2 + g) * 128) * 4096, 4096, 0, qt,
                              U + (size_t)tok * UP + UC_Q + (g * 4 + r) * 128, 0.08838834764831845f * LOG2E, cosA + sq * 64, sinA + sq * 64, mf, m, l, ot);
        l = fa::xhalf_sum(l); const float sc = sigmf(SM[(size_t)tok * 64 + (g * 4 + r) * 3 + 1]) / l; bf16* op = OA + (size_t)tok * 1024 + (g * 4 + r) * 128;
#pragma unroll
        for (int db = 0; db < 4; ++db)
#pragma unroll
            for (int q = 0; q < 4; ++q) { v2u* p = (v2u*)(op + 32 * db + 8 * q + 4 * h); const v2u o = *p; v2u w;
                w.x = fa::cvtpk(blo(o.x) + ot[db][4 * q] * sc, bhi(o.x) + ot[db][4 * q + 1] * sc); w.y = fa::cvtpk(blo(o.y) + ot[db][4 * q + 2] * sc, bhi(o.y) + ot[db][4 * q + 3] * sc); *p = w; } }
}
__device__ __forceinline__ void ph_swa_mfma(const Frame& F0, const Args& a, int ly) {
    const Frame F = refr(F0);
    unsigned char* ws = wsp(a); const bf16* U = (const bf16*)(ws + WS_U); bf16* OC = (bf16*)(ws + WS_OC); const bf16* VT = (const bf16*)(ws + WS_VTC); const float* cosC = (const float*)(ws + WS_TAB) + 2 * 4096 * 64; const float* sinC = cosC + 4096 * 32;
    const int r32 = F.lane & 31, h = F.lane >> 5, r = F.wave;
    for (int ui = 0;; ++ui) { int bg, qt; if (!unit_map(F, ui, 128, false, bg, qt)) break; const int b = bg >> 1, g = bg & 1; const int sq = qt * 32 + r32, tok = b * 4096 + sq;
        float m = inp(a, 14)[ly * 16 + g * 8 + r] * LOG2E, l = h == 0 ? 1.f : 0.f; fa::f32x16 ot[2];
#pragma unroll
        for (int db = 0; db < 2; ++db)
#pragma unroll
            for (int i = 0; i < 16; ++i) ot[db][i] = 0.f;
        const BandMask mf{sq, qt * 32, 128}; const int jt1 = qt >> 1;
        fa_unit<64, BandMask>(F.lds, F.tid, U + (size_t)(b * 4096) * UP + UC_SKV + g * 64, UP, VT + (size_t)((b * 2 + g) * 64) * 4096, 4096, jt1 > 2 ? jt1 - 2 : 0, jt1,
                              U + (size_t)tok * UP + UC_SQ + (g * 8 + r) * 64, 0.125f * LOG2E, cosC + sq * 32, sinC + sq * 32, mf, m, l, ot);
        l = fa::xhalf_sum(l); const float sc = 1.0f / l; bf16* op = OC + (size_t)tok * 1024 + (g * 8 + r) * 64;
#pragma unroll
        for (int db = 0; db < 2; ++db)
#pragma unroll
            for (int q = 0; q < 4; ++q) { v2u w; w.x = fa::cvtpk(ot[db][4 * q] * sc, ot[db][4 * q + 1] * sc); w.y = fa::cvtpk(ot[db][4 * q + 2] * sc, ot[db][4 * q + 3] * sc); *(v2u*)(op + 32 * db + 8 * q + 4 * h) = w; } }
}
__device__ __forceinline__ void ph_cmp_mfma(const Frame& F0, const Args& a) {
    const Frame F = refr(F0);
    unsigned char* ws = wsp(a); const bf16* U = (const bf16*)(ws + WS_U); bf16* OA = (bf16*)(ws + WS_OA); const float* SM = (const float*)(ws + WS_SM);
    const bf16* KC = (const bf16*)(ws + WS_KC); const bf16* VCT = (const bf16*)(ws + WS_VCT); unsigned long long* SEL = (unsigned long long*)(ws + WS_SEL);
    const int lane = F.lane, r32 = lane & 31, h = lane >> 5, r = r32 & 3, tl = F.wave * 8 + (r32 >> 2);
    constexpr int BUF = fa::Geo<128>::BUF; constexpr int PP = 257;
    LAS float* psum = (LAS float*)(F.lds + 40960) + F.wave * 8 * PP;
    for (int ui = 0;; ++ui) { int bg, qt; if (!unit_map(F, ui, 64, true, bg, qt)) break; const int b = bg >> 1, g = bg & 1; const int sq = qt * 64 + tl, tok = b * 4096 + sq;
        const int nvis = sq >= 31 ? ((sq - 31) >> 4) + 1 : 0; const int nvmax = ((qt * 64 + 63 - 31) >> 4) + 1, jt1 = (nvmax - 1) >> 6;
        const int nvw = (qt * 64 + F.wave * 8 + 7 >= 31) ? ((qt * 64 + F.wave * 8 + 7 - 31) >> 4) + 1 : 0;
        const bf16* Kb = KC + (size_t)((b * 2 + g) * 256) * 128; const bf16* VTb = VCT + (size_t)((b * 2 + g) * 128) * 256;
        fa::bf16x8 qf[8]; fa::load_qf<128>(U + (size_t)tok * UP + UC_Q + (g * 4 + r) * 128, h, 0.08838834764831845f * LOG2E, qf);
        for (int i = lane; i < 8 * PP; i += 64) psum[i] = 0.f;
        float m = -1e30f, l = 0.f;
        fa::Stage<128> st; fa::tile_load<128>(st, Kb, 128, VTb, 256, 0, F.tid);
        for (int j = 0; j <= jt1; ++j) {
            __syncthreads(); fa::tile_store<128>(st, F.lds, F.tid); __syncthreads();
            fa::tile_load<128>(st, Kb, 128, VTb, 256, (j < jt1 ? j + 1 : 0) * 64, F.tid);
            if (64 * j < nvw) { fa::f32x16 s0, s1; fa::qk_tile<128>(F.lds, qf, r32, h, s0, s1); float mx = -1e30f;
#pragma unroll
                for (int i = 0; i < 16; ++i) { if (64 * j + fa::crow(i, h) >= nvis) s0[i] = -1e30f; if (64 * j + 32 + fa::crow(i, h) >= nvis) s1[i] = -1e30f; mx = fmaxf(mx, fmaxf(s0[i], s1[i])); }
                mx = fa::xhalf_max(mx); const float mn = fmaxf(m, mx); float sum = 0.f;
#pragma unroll
                for (int i = 0; i < 16; ++i) { sum += (s0[i] <= -1e30f ? 0.f : __builtin_amdgcn_exp2f(s0[i] - mn)) + (s1[i] <= -1e30f ? 0.f : __builtin_amdgcn_exp2f(s1[i] - mn)); }
                l = l * __builtin_amdgcn_exp2f(m - mn) + sum; m = mn; } }
        l = fa::xhalf_sum(l); const float linv = l > 0.f ? 1.0f / l : 0.f;
        fa::f32x16 ot[4];
#pragma unroll
        for (int db = 0; db < 4; ++db)
#pragma unroll
            for (int i = 0; i < 16; ++i) ot[db][i] = 0.f;
        for (int j = 0; j <= jt1; ++j) {
            __syncthreads(); fa::tile_store<128>(st, F.lds, F.tid); __syncthreads();
            if (j < jt1) fa::tile_load<128>(st, Kb, 128, VTb, 256, (j + 1) * 64, F.tid);
            if (64 * j < nvw) { fa::f32x16 s0, s1; fa::qk_tile<128>(F.lds, qf, r32, h, s0, s1);
#pragma unroll
                for (int i = 0; i < 16; ++i) { const int n0 = 64 * j + fa::crow(i, h), n1 = n0 + 32;
                    const float p0 = n0 < nvis ? __builtin_amdgcn_exp2f(s0[i] - m) * linv : 0.f, p1 = n1 < nvis ? __builtin_amdgcn_exp2f(s1[i] - m) * linv : 0.f; s0[i] = p0; s1[i] = p1;
                    const float t0 = fa::quad_sum(p0), t1 = fa::quad_sum(p1);
                    if (r == 0) { psum[(r32 >> 2) * PP + n0] = t0; psum[(r32 >> 2) * PP + n1] = t1; } }
                fa::bf16x8 pf[2][2]; fa::pack_p(s0, pf[0]); fa::pack_p(s1, pf[1]);
                fa::pv_tile<128>(F.lds, pf, r32, h, ot); } }
        { const float sc = sigmf(SM[(size_t)tok * 64 + (g * 4 + r) * 3 + 0]); bf16* op = OA + (size_t)tok * 1024 + (g * 4 + r) * 128;
#pragma unroll
          for (int db = 0; db < 4; ++db)
#pragma unroll
            for (int q = 0; q < 4; ++q) { v2u* p = (v2u*)(op + 32 * db + 8 * q + 4 * h); const v2u o = *p; v2u w;
                w.x = fa::cvtpk(blo(o.x) + ot[db][4 * q] * sc, bhi(o.x) + ot[db][4 * q + 1] * sc); w.y = fa::cvtpk(blo(o.y) + ot[db][4 * q + 2] * sc, bhi(o.y) + ot[db][4 * q + 3] * sc); *p = w; } }
        LDS_WAIT();
        for (int t = 0; t < 8; ++t) { const int s = qt * 64 + F.wave * 8 + t, qb = s >> 6; float imp = 0.f; const int n0 = 4 * lane - 1;
#pragma unroll
            for (int k = 0; k < 5; ++k) { const int n = n0 + k; if (n >= 0 && n <= 254) imp += psum[t * PP + n]; }
            unsigned long long mask;
            if (qb <= 15) mask = (2ull << qb) - 1ull;
            else { const bool cand = lane >= 1 && lane <= qb - 2; const float v = cand ? imp : -1.f; int rank = 0;
                for (int jj = 0; jj < 64; ++jj) { const float vj = __shfl(v, jj); rank += (vj > v || (vj == v && jj < lane)) ? 1 : 0; }
                mask = __ballot(cand && rank < 13) | 1ull | (1ull << qb) | (1ull << (qb - 1)); }
            if (lane == 0) SEL[(size_t)(b * 2 + g) * 4096 + s] = mask; }
        LDS_WAIT();
        __syncthreads();
    }
}


namespace ssd {
constexpr int TP = 136;
constexpr int TILE128 = 128 * TP * 2;
constexpr int XT_BYTES = 64 * TP * 2;
__device__ __forceinline__ void stage_rows(LAS unsigned char* dst, const bf16* src  , int tid) {
#pragma unroll
    for (int i = 0; i < 4; ++i) { const int c = tid + i * 512, row = c >> 4, c8 = c & 15; *(LAS v4u*)(dst + (row * TP + c8 * 8) * 2) = *(const v4u*)(src + (size_t)row * 1536 + c8 * 8); }
}
__device__ __forceinline__ void stage_rows_T(LAS unsigned char* dst, const bf16* src, int tid) {
#pragma unroll
    for (int i = 0; i < 4; ++i) { const int c = tid + i * 512, row = c & 127, c8 = c >> 7; const v4u w = *(const v4u*)(src + (size_t)row * 1536 + c8 * 8); LAS bf16* d = (LAS bf16*)dst + (c8 * 8) * TP + sw16(row);
        d[0] = (bf16)(w.x & 0xffffu); d[TP] = (bf16)(w.x >> 16); d[2 * TP] = (bf16)(w.y & 0xffffu); d[3 * TP] = (bf16)(w.y >> 16); d[4 * TP] = (bf16)(w.z & 0xffffu); d[5 * TP] = (bf16)(w.z >> 16); d[6 * TP] = (bf16)(w.w & 0xffffu); d[7 * TP] = (bf16)(w.w >> 16); }
}
__device__ __forceinline__ void xT_load(v4u (&r)[8], const bf16* src  , int t) {
#pragma unroll
    for (int i = 0; i < 8; ++i) r[i] = *(const v4u*)(src + (size_t)t * 1536 + i * 8);
}
__device__ __forceinline__ void xT_store(LAS unsigned char* dst, const v4u (&r)[8], int t) {
    LAS bf16* d = (LAS bf16*)dst + sw16(t);
#pragma unroll
    for (int i = 0; i < 8; ++i) { const v4u w = r[i]; LAS bf16* dd = d + (i * 8) * TP;
        dd[0] = (bf16)(w.x & 0xffffu); dd[TP] = (bf16)(w.x >> 16); dd[2 * TP] = (bf16)(w.y & 0xffffu); dd[3 * TP] = (bf16)(w.y >> 16); dd[4 * TP] = (bf16)(w.z & 0xffffu); dd[5 * TP] = (bf16)(w.z >> 16); dd[6 * TP] = (bf16)(w.w & 0xffffu); dd[7 * TP] = (bf16)(w.w >> 16); }
}
}

__device__ __forceinline__ void ph_states_mfma(const Frame& F0, const Args& a) {
    const Frame F = refr(F0);
    unsigned char* ws = wsp(a); const bf16* XC = (const bf16*)(ws + WS_XC); const float* DTV = (const float*)(ws + WS_DTV); const float* ACS = (const float*)(ws + WS_ACS); float* ST = (float*)(ws + WS_ST);
    const int lane = F.lane, r32 = lane & 31, h2 = lane >> 5, hq = F.wave >> 1, nh = F.wave & 1;
    LAS unsigned char* BT = F.lds; LAS unsigned char* XT = F.lds + ssd::TILE128; LAS float* WL = (LAS float*)(F.lds + ssd::TILE128 + 4 * ssd::XT_BYTES);
    for (int it = F.vcu; it < HBN * 32 * 2; it += F.G) { const int g = it & 1, bc = it >> 1; const size_t tok0 = (size_t)bc * 128;
        __syncthreads();
        v4u xr[8]; ssd::xT_load(xr, XC + tok0 * 1536 + (g * 8 + hq) * 64, nh * 64 + lane);
        ssd::stage_rows_T(BT, XC + tok0 * 1536 + 1024 + g * 128, F.tid);
#pragma unroll
        for (int i2 = 0; i2 < 2; ++i2) { const int i = F.tid + i2 * 512; const int hh = i >> 7, l = i & 127, h = g * 8 + hh; WL[hh * 128 + sw16(l)] = __expf(ACS[(tok0 + 127) * 16 + h] - ACS[(tok0 + l) * 16 + h]) * DTV[(tok0 + l) * 16 + h]; }
#pragma unroll 1
        for (int sub = 0; sub < 2; ++sub) { const int hh = sub * 4 + hq, h = g * 8 + hh;
            if (sub) __syncthreads();
            ssd::xT_store(XT + hq * ssd::XT_BYTES, xr, nh * 64 + lane);
            if (sub == 0) ssd::xT_load(xr, XC + tok0 * 1536 + (g * 8 + 4 + hq) * 64, nh * 64 + lane);
            __syncthreads();
            fa::f32x16 acc[2][2];
#pragma unroll
            for (int nb = 0; nb < 2; ++nb)
#pragma unroll
                for (int pb = 0; pb < 2; ++pb)
#pragma unroll
                    for (int i = 0; i < 16; ++i) acc[nb][pb][i] = 0.f;
            const LAS unsigned char* xt = XT + hq * ssd::XT_BYTES;
#pragma unroll 2
            for (int ks = 0; ks < 8; ++ks) { const int l0 = 16 * ks + 8 * h2; const f32x4 w0 = *(const LAS f32x4*)(WL + hh * 128 + l0), w1 = *(const LAS f32x4*)(WL + hh * 128 + l0 + 4);
                fa::bf16x8 A[2], B[2];
#pragma unroll
                for (int pb = 0; pb < 2; ++pb) { const v4u x = *(const LAS v4u*)(xt + ((32 * pb + r32) * ssd::TP + l0) * 2); v4u o;
                    o.x = fa::cvtpk(blo(x.x) * w0.x, bhi(x.x) * w0.y); o.y = fa::cvtpk(blo(x.y) * w0.z, bhi(x.y) * w0.w); o.z = fa::cvtpk(blo(x.z) * w1.x, bhi(x.z) * w1.y); o.w = fa::cvtpk(blo(x.w) * w1.z, bhi(x.w) * w1.w); A[pb] = __builtin_bit_cast(fa::bf16x8, o); }
#pragma unroll
                for (int nb = 0; nb < 2; ++nb) B[nb] = *(const LAS fa::bf16x8*)(BT + ((32 * (2 * nh + nb) + r32) * ssd::TP + l0) * 2);
#pragma unroll
                for (int nb = 0; nb < 2; ++nb)
#pragma unroll
                    for (int pb = 0; pb < 2; ++pb) acc[nb][pb] = FA_MFMA(A[pb], B[nb], acc[nb][pb]); }
            float* o = ST + ((size_t)bc * 16 + h) * 8192;
#pragma unroll
            for (int nb = 0; nb < 2; ++nb)
#pragma unroll
                for (int pb = 0; pb < 2; ++pb)
#pragma unroll
                    for (int i = 0; i < 16; ++i) o[(32 * pb + fa::crow(i, h2)) * 128 + 32 * (2 * nh + nb) + r32] = acc[nb][pb][i];
        }
    }
    __syncthreads();
}
__device__ __forceinline__ void ph_scan2(const Frame& F0, const Args& a) {
    const Frame F = refr(F0);
    const float* ACS = (const float*)(wsp(a) + WS_ACS); float* ST = (float*)(wsp(a) + WS_ST);
    for (int idx = F.gtid; idx < HBN * 16 * 8192; idx += F.GT) { const int np = idx & 8191, h = (idx >> 13) & 15, b = idx >> 17; float st[32], dec[32];
#pragma unroll
        for (int c = 0; c < 32; ++c) { st[c] = ST[((size_t)(b * 32 + c) * 16 + h) * 8192 + np]; dec[c] = ACS[((size_t)b * 4096 + c * 128 + 127) * 16 + h]; }
        float hc = 0.f;
#pragma unroll
        for (int c = 0; c < 32; ++c) { ST[((size_t)(b * 32 + c) * 16 + h) * 8192 + np] = hc; hc = hc * __expf(dec[c]) + st[c]; } }
}
__device__ __forceinline__ void ph_ssdy_mfma(const Frame& F0, const Args& a, int ly) {
    const Frame F = refr(F0);
    unsigned char* ws = wsp(a); const bf16* XC = (const bf16*)(ws + WS_XC); const float* DTV = (const float*)(ws + WS_DTV); const float* ACS = (const float*)(ws + WS_ACS); const float* ST = (const float*)(ws + WS_ST);
    const bf16* U = (const bf16*)(ws + WS_U); float* YD = (float*)(ws + WS_YD); bf16* OB = (bf16*)(ws + WS_OB);
    const int lane = F.lane, r32 = lane & 31, h2 = lane >> 5, hq = F.wave >> 1, wl = F.wave & 1;
    LAS unsigned char* BM = F.lds; LAS unsigned char* XT = F.lds + ssd::TILE128; LAS float* AC = (LAS float*)(F.lds + ssd::TILE128 + 4 * ssd::XT_BYTES); LAS float* DT = AC + 1024; LAS float* SSQ = DT + 1024; LAS float* RINV = SSQ + 1024;
    for (int it = F.vcu; it < HBN * 32 * 2; it += F.G) { const int g = it & 1, bc = it >> 1; const size_t tok0 = (size_t)bc * 128;
        __syncthreads();
        v4u xr[8]; ssd::xT_load(xr, XC + tok0 * 1536 + (g * 8 + hq) * 64, wl * 64 + lane);
        ssd::stage_rows(BM, XC + tok0 * 1536 + 1024 + g * 128, F.tid);
#pragma unroll
        for (int i2 = 0; i2 < 2; ++i2) { const int i = F.tid + i2 * 512; const int hh = i >> 7, l = i & 127, h = g * 8 + hh; AC[i] = ACS[(tok0 + l) * 16 + h]; DT[i] = DTV[(tok0 + l) * 16 + h]; }
#pragma unroll 1
        for (int sub = 0; sub < 2; ++sub) { const int hh = sub * 4 + hq, h = g * 8 + hh;
            if (sub) __syncthreads();
            ssd::xT_store(XT + hq * ssd::XT_BYTES, xr, wl * 64 + lane);
            if (sub == 0) ssd::xT_load(xr, XC + tok0 * 1536 + (g * 8 + 4 + hq) * 64, wl * 64 + lane);
            __syncthreads();
            const LAS unsigned char* xt = XT + hq * ssd::XT_BYTES; const float dsk = inp(a, 12)[ly * 16 + h];
            fa::bf16x8 hf[2][8]; { const float* hin = ST + ((size_t)bc * 16 + h) * 8192;
#pragma unroll
                for (int pb = 0; pb < 2; ++pb)
#pragma unroll
                    for (int ks = 0; ks < 8; ++ks) { const f32x4 v0 = *(const f32x4*)(hin + (32 * pb + r32) * 128 + 16 * ks + 8 * h2), v1 = *(const f32x4*)(hin + (32 * pb + r32) * 128 + 16 * ks + 8 * h2 + 4);
                        v4u o; o.x = fa::cvtpk(v0.x, v0.y); o.y = fa::cvtpk(v0.z, v0.w); o.z = fa::cvtpk(v1.x, v1.y); o.w = fa::cvtpk(v1.z, v1.w); hf[pb][ks] = __builtin_bit_cast(fa::bf16x8, o); } }
#pragma unroll 1
            for (int lbi = 0; lbi < 2; ++lbi) { const int lb = wl ? (lbi ? 2 : 1) : (lbi ? 3 : 0); const int l = 32 * lb + r32; const size_t tokl = tok0 + l;
                fa::bf16x8 qf[8];
#pragma unroll
                for (int ks = 0; ks < 8; ++ks) qf[ks] = *(const fa::bf16x8*)(XC + tokl * 1536 + 1280 + g * 128 + 16 * ks + 8 * h2);
                const float acsl = AC[hh * 128 + l];
                fa::f32x16 yT[2];
#pragma unroll
                for (int pb = 0; pb < 2; ++pb) {
#pragma unroll
                    for (int i = 0; i < 16; ++i) yT[pb][i] = 0.f;
#pragma unroll
                    for (int ks = 0; ks < 8; ++ks) yT[pb] = FA_MFMA(hf[pb][ks], qf[ks], yT[pb]);
                    const float e = __expf(acsl);
#pragma unroll
                    for (int i = 0; i < 16; ++i) yT[pb][i] *= e; }
                for (int sb = 0; sb <= lb; ++sb) { fa::f32x16 sT;
#pragma unroll
                    for (int i = 0; i < 16; ++i) sT[i] = 0.f;
#pragma unroll
                    for (int ks = 0; ks < 8; ++ks) { const fa::bf16x8 af = *(const LAS fa::bf16x8*)(BM + ((32 * sb + r32) * ssd::TP + 16 * ks + 8 * h2) * 2); sT = FA_MFMA(af, qf[ks], sT); }
#pragma unroll
                    for (int i = 0; i < 16; ++i) { const int sl = fa::crow(i, h2), s = 32 * sb + sl; const bool ok = sb < lb || sl <= r32; const float f = ok ? __expf(acsl - AC[hh * 128 + s]) * DT[hh * 128 + s] : 0.f; sT[i] = ok ? sT[i] * f : 0.f; }
                    fa::bf16x8 pf[2]; fa::pack_p(sT, pf);
#pragma unroll
                    for (int pb = 0; pb < 2; ++pb)
#pragma unroll
                        for (int st = 0; st < 2; ++st) { const fa::bf16x8 af = *(const LAS fa::bf16x8*)(xt + ((32 * pb + r32) * ssd::TP + 32 * sb + 16 * st + 8 * h2) * 2); yT[pb] = FA_MFMA(af, pf[st], yT[pb]); } }
                float ss = 0.f;
#pragma unroll
                for (int pb = 0; pb < 2; ++pb)
#pragma unroll
                    for (int q = 0; q < 4; ++q) { const int p = 32 * pb + 8 * q + 4 * h2; const v2u xv = *(const v2u*)(XC + tokl * 1536 + h * 64 + p), zv = *(const v2u*)(U + tokl * UP + UC_Z + h * 64 + p);
                        const float xs[4] = {blo(xv.x), bhi(xv.x), blo(xv.y), bhi(xv.y)}, zs[4] = {blo(zv.x), bhi(zv.x), blo(zv.y), bhi(zv.y)}; f32x4 y;
#pragma unroll
                        for (int e = 0; e < 4; ++e) { float v = yT[pb][4 * q + e] + xs[e] * dsk; v *= zs[e] * sigmf(zs[e]); y[e] = v; ss += v * v; }
                        *(f32x4*)(YD + tokl * 1024 + h * 64 + p) = y; }
                ss += __shfl_xor(ss, 32);
                if (h2 == 0) SSQ[hh * 128 + l] = ss;
            }
        }
        __syncthreads();
        if (F.tid < 128) { float s = 0.f;
#pragma unroll
            for (int hh = 0; hh < 8; ++hh) s += SSQ[hh * 128 + F.tid];
            RINV[F.tid] = 1.0f / sqrtf(s * (1.f / 512.f) + NORM_EPS); }
        __syncthreads();
        const float* nw = inp(a, 13) + (size_t)ly * 1024 + g * 512;
#pragma unroll 8
        for (int gi = F.tid; gi < 8192; gi += 512) { const int tl = gi >> 6, c8 = (gi & 63) * 8; const float ri = RINV[tl]; const float* yp = YD + (tok0 + tl) * 1024 + g * 512 + c8;
            const f32x4 y0 = *(const f32x4*)yp, y1 = *(const f32x4*)(yp + 4), n0 = *(const f32x4*)(nw + c8), n1 = *(const f32x4*)(nw + c8 + 4);
            v4u o; o.x = fa::cvtpk(y0.x * ri * n0.x, y0.y * ri * n0.y); o.y = fa::cvtpk(y0.z * ri * n0.z, y0.w * ri * n0.w); o.z = fa::cvtpk(y1.x * ri * n1.x, y1.y * ri * n1.y); o.w = fa::cvtpk(y1.z * ri * n1.z, y1.w * ri * n1.w);
            *(v4u*)(OB + (tok0 + tl) * 1024 + g * 512 + c8) = o; }
    }
    __syncthreads();
}

__device__ __forceinline__ void ph_route_mfma(const Frame& F0, const Args& a, int ly) {
    const Frame F = refr(F0);
    unsigned char* ws = wsp(a); unsigned* ROUTE = (unsigned*)(ws + WS_ROUTE); const float* x = outp(a); const bf16* WRh = (const bf16*)(ws + WS_WR); const bf16* WRl = WRh + 64 * 2048;
    int* ELT = (int*)(ws + WS_ELT); float* EWR = (float*)(ws + WS_EWR); bf16* XB = (bf16*)(ws + WS_XB);
    const float* gbias = inp(a, 20) + ly * 4; const float* ebias = inp(a, 22) + ly * 32; gu32* cnt = F.ctl + CW_ECNT + ly * 32 * 64;
    const int lane = F.lane, r32 = lane & 31, h = lane >> 5, kh = F.wave & 1, tq = F.wave >> 1; LAS float* LG = (LAS float*)(F.lds + tq * 8704);
    for (int it = F.vcu; it < T / 128; it += F.G) { const int tk = it * 128 + tq * 32 + r32; const float* xr = x + (size_t)tk * D + kh * 1024 + 8 * h;
        fa::f32x16 acc[2];
#pragma unroll
        for (int cb = 0; cb < 2; ++cb)
#pragma unroll
            for (int i = 0; i < 16; ++i) acc[cb][i] = 0.f;
        float ss = 0.f;
#pragma unroll 4
        for (int ks = 0; ks < 64; ++ks) { const f32x4 x0 = *(const f32x4*)(xr + 16 * ks), x1 = *(const f32x4*)(xr + 16 * ks + 4);
            ss += (x0.x * x0.x + x0.y * x0.y) + (x0.z * x0.z + x0.w * x0.w) + (x1.x * x1.x + x1.y * x1.y) + (x1.z * x1.z + x1.w * x1.w);
            v4u hi, lo; hi.x = fa::cvtpk(x0.x, x0.y); hi.y = fa::cvtpk(x0.z, x0.w); hi.z = fa::cvtpk(x1.x, x1.y); hi.w = fa::cvtpk(x1.z, x1.w);
            lo.x = fa::cvtpk(x0.x - blo(hi.x), x0.y - bhi(hi.x)); lo.y = fa::cvtpk(x0.z - blo(hi.y), x0.w - bhi(hi.y)); lo.z = fa::cvtpk(x1.x - blo(hi.z), x1.y - bhi(hi.z)); lo.w = fa::cvtpk(x1.z - blo(hi.w), x1.w - bhi(hi.w));
            const fa::bf16x8 xh = __builtin_bit_cast(fa::bf16x8, hi), xl = __builtin_bit_cast(fa::bf16x8, lo);
            *(v4u*)(XB + (size_t)tk * D + kh * 1024 + 16 * ks + 8 * h) = hi;
#pragma unroll
            for (int cb = 0; cb < 2; ++cb) { const size_t wo = (size_t)(32 * cb + r32) * 2048 + kh * 1024 + 16 * ks + 8 * h; const fa::bf16x8 wh = *(const fa::bf16x8*)(WRh + wo), wl = *(const fa::bf16x8*)(WRl + wo);
                acc[cb] = FA_MFMA(wh, xh, acc[cb]); acc[cb] = FA_MFMA(wl, xh, acc[cb]); acc[cb] = FA_MFMA(wh, xl, acc[cb]); } }
        ss += __shfl_xor(ss, 32);
        __syncthreads();
        if (kh == 1) {
#pragma unroll
            for (int cb = 0; cb < 2; ++cb)
#pragma unroll
                for (int i = 0; i < 16; ++i) LG[r32 * 68 + 32 * cb + fa::crow(i, h)] = acc[cb][i];
            if (h == 0) LG[r32 * 68 + 64] = ss; }
        __syncthreads();
        if (kh == 0) { ss += LG[r32 * 68 + 64]; const float rinv = 1.0f / sqrtf(ss * (1.f / D) + NORM_EPS);
#pragma unroll
            for (int cb = 0; cb < 2; ++cb)
#pragma unroll
                for (int i = 0; i < 16; ++i) { const int o = r32 * 68 + 32 * cb + fa::crow(i, h); LG[o] = (LG[o] + acc[cb][i]) * rinv; }
            LDS_WAIT();
            if (h == 0) { const LAS float* lg = LG + r32 * 68;
                float gl[4];
#pragma unroll
                for (int i = 0; i < 4; ++i) gl[i] = lg[i] + gbias[i];
                int gi = 0; float gm = gl[0];
#pragma unroll
                for (int i = 1; i < 4; ++i) if (gl[i] > gm) { gm = gl[i]; gi = i; }
                float gs = 0.f;
#pragma unroll
                for (int i = 0; i < 4; ++i) gs += __expf(gl[i] - gm);
                const float gwt = 1.0f / gs;
                float el[8];
#pragma unroll
                for (int e = 0; e < 8; ++e) el[e] = lg[4 + gi * 8 + e] + ebias[gi * 8 + e];
                int i1 = 0; float v1 = el[0];
#pragma unroll
                for (int e = 1; e < 8; ++e) if (el[e] > v1) { v1 = el[e]; i1 = e; }
                int i2 = -1; float v2 = -3.0e38f;
#pragma unroll
                for (int e = 0; e < 8; ++e) if (e != i1 && el[e] > v2) { v2 = el[e]; i2 = e; }
                const float ex = __expf(v2 - v1); const float w1 = 1.0f / (1.0f + ex), w2 = ex * w1;
                const int e0 = gi * 8 + i1, e1 = gi * 8 + i2;
                const unsigned p0 = __hip_atomic_fetch_add(cnt + e0 * 64, 1u, RLX_AGENT), p1 = __hip_atomic_fetch_add(cnt + e1 * 64, 1u, RLX_AGENT);
                v4u r0, r1; r0.x = (unsigned)e0; r0.y = (unsigned)e1; r0.z = p0; r0.w = p1; r1.x = __float_as_uint(gwt * w1); r1.y = __float_as_uint(gwt * w2); r1.z = __float_as_uint(rinv); r1.w = 0u;
                *(v4u*)(ROUTE + (size_t)tk * 8) = r0; *(v4u*)(ROUTE + (size_t)tk * 8 + 4) = r1;
                ELT[(size_t)e0 * T + p0] = tk; ELT[(size_t)e1 * T + p1] = tk; *(v2f*)(EWR + ((size_t)e0 * T + p0) * 2) = (v2f){gwt * w1, rinv}; *(v2f*)(EWR + ((size_t)e1 * T + p1) * 2) = (v2f){gwt * w2, rinv}; } }
    }
    __syncthreads();
}

__device__ __forceinline__ void ph_cmp2_mfma(const Frame& F0, const Args& a) {
    const Frame F = refr(F0);
    unsigned char* ws = wsp(a); const float* HP = (const float*)(ws + WS_CBG); const float* B1 = (const float*)(ws + WS_B1P); const bf16* W2T = (const bf16*)(ws + WS_W2T); bf16* KC = (bf16*)(ws + WS_KC); bf16* VCT = (bf16*)(ws + WS_VCT);
    const int lane = F.lane, r32 = lane & 31, h = lane >> 5;
    for (int it = F.gw; it < 128; it += F.NGW) { const int c = it >> 6, row = (it & 63) * 32 + r32;
        fa::f32x16 acc[4];
#pragma unroll
        for (int db = 0; db < 4; ++db)
#pragma unroll
            for (int i = 0; i < 16; ++i) acc[db][i] = 0.f;
#pragma unroll 8
        for (int ks = 0; ks < 16; ++ks) { const int i0 = 16 * ks + 8 * h; f32x4 v0 = *(const f32x4*)(B1 + c * 256 + i0), v1 = *(const f32x4*)(B1 + c * 256 + i0 + 4);
#pragma unroll
            for (int kq = 0; kq < 4; ++kq) { const float* p = HP + ((size_t)(c * 4 + kq) * 2048 + row) * 256 + i0; v0 = v0 + *(const f32x4*)p; v1 = v1 + *(const f32x4*)(p + 4); }
            v4u o; o.x = fa::cvtpk(v0.x * sigmf(v0.x), v0.y * sigmf(v0.y)); o.y = fa::cvtpk(v0.z * sigmf(v0.z), v0.w * sigmf(v0.w)); o.z = fa::cvtpk(v1.x * sigmf(v1.x), v1.y * sigmf(v1.y)); o.w = fa::cvtpk(v1.z * sigmf(v1.z), v1.w * sigmf(v1.w));
            const fa::bf16x8 bfr = __builtin_bit_cast(fa::bf16x8, o);
#pragma unroll
            for (int db = 0; db < 4; ++db) { const fa::bf16x8 af = *(const fa::bf16x8*)(W2T + ((size_t)(c * 128 + 32 * db + r32)) * 256 + i0); acc[db] = FA_MFMA(af, bfr, acc[db]); } }
#pragma unroll
        for (int db = 0; db < 4; ++db)
#pragma unroll
            for (int q = 0; q < 4; ++q) { const int d = 32 * db + 8 * q + 4 * h; v2u w; w.x = fa::cvtpk(acc[db][4 * q], acc[db][4 * q + 1]); w.y = fa::cvtpk(acc[db][4 * q + 2], acc[db][4 * q + 3]);
                *(v2u*)(KC + (size_t)(c * 2048 + row) * 128 + d) = w;
                if (c == 1) { bf16* vp = VCT + ((size_t)(row >> 8) * 128 + d) * 256 + sw16(row & 255); vp[0] = (bf16)(w.x & 0xffffu); vp[256] = (bf16)(w.x >> 16); vp[512] = (bf16)(w.y & 0xffffu); vp[768] = (bf16)(w.y >> 16); } }
    }
}

#ifndef EN_W
#define EN_W 1
#endif
#ifndef EN_A
#define EN_A 1
#endif
#ifndef EN_B
#define EN_B 1
#endif
#ifndef EN_C
#define EN_C 1
#endif
#ifndef EN_D
#define EN_D 1
#endif
#ifndef EN_E
#define EN_E 1
#endif
#ifndef EN_F
#define EN_F 1
#endif
#ifndef EN_G
#define EN_G 1
#endif
#ifndef EN_H
#define EN_H 1
#endif
#ifndef EN_I
#define EN_I 1
#endif
#ifndef EN_J
#define EN_J 1
#endif
#ifndef EN_K
#define EN_K 1
#endif
#ifndef EN_L
#define EN_L 1
#endif
#ifndef EN_M
#define EN_M 1
#endif
__global__ void __launch_bounds__(NWAVES * 64, 2) mk_fwd(Args a) {
    extern __shared__ __attribute__((aligned(16))) unsigned char lds_raw[];
    Frame F;
    F.lds = (LAS unsigned char*)lds_raw;
    F.MISC = (volatile LAS unsigned*)(F.lds + MISC_OFF);
    F.tid = threadIdx.x; F.lane = F.tid & 63; F.wave = __builtin_amdgcn_readfirstlane(F.tid >> 6);
    F.G = gridDim.x; { const int bx = blockIdx.x; F.vcu = (F.G % 8 == 0) ? (bx % 8) * (F.G / 8) + bx / 8 : bx; }
    F.gtid = F.vcu * (NWAVES * 64) + F.tid; F.GT = F.G * NWAVES * 64; F.gw = F.vcu * NWAVES + F.wave; F.NGW = F.G * NWAVES;
    F.ctl = (gu32*)(a.ws + WS_CTL);
    for (int u = F.tid; u < (LDS_BYTES - LDSCTL_OFF) / 4; u += NWAVES * 64) ((LAS unsigned*)(F.lds + LDSCTL_OFF))[u] = 0u;
    __syncthreads();
    const int lo = a.lo, hi = a.hi;
    XcdBarrier bar; bar.bar = (unsigned*)(F.ctl + CW_BAR); bar.x = 0; bar.st = nullptr;
    if (hi - lo > 1) bar = xcd_barrier_post((unsigned*)(F.ctl + CW_BAR), F.MISC + 8);
#define RUN(s) (lo <= (s) && (s) < hi)
#define SEAM(s) do { if (RUN(s) && RUN((s) + 1)) xcd_barrier(bar); else __syncthreads(); } while (0)
    int step = 0;
#pragma unroll 1
    for (int ly = 0; ly < 2; ++ly) {
        if (EN_W && RUN(step)) { phW(F, a, ly); phA(F, a, ly); }
        SEAM(step); ++step;
#pragma unroll 1
        for (int hb = 0; hb < 2; ++hb) {
            if (EN_B && RUN(step)) { unsigned char* ws = wsp(a); if (hb == 0) ph_bias(F, a, ly);
              {
                {
                  pg8::Gemm g{(const bf16*)(ws + WS_HN8 + (size_t)hb * TH * D), (const bf16*)(ws + WS_WG8), TH, NGATE, D / 2, D / 2, D / 2}; pg8::UnevenOrder S; S.init(TH, NGATE, F.G, (int)blockIdx.x);
                  if (F.G == 256) { S.kHi = 7; S.kLo = 5; } else { S.kHi = S.kLo = (1536 + F.G - 1) / F.G + 1; }
                  pg8::EpiGate E{(bf16*)(ws + WS_U) + UC_G, UP, 1.0f / 1024.0f};
                  pg8::gemm_phase<pg8::EpiGate, pg8::UnevenOrder, true, true>(F.lds + RING_OFF, g, S, E); }
                { pg8::Gemm g{(const bf16*)(ws + (hb ? WS_HN1 : WS_HN)), (const bf16*)(ws + WS_WIN), TH, NIN1, D, D, D}; pg8::StaticOrder S; S.init(TH, NIN1, F.G, (int)blockIdx.x);
                  pg8::EpiIn E{(bf16*)(ws + WS_U), UP, (bf16*)(ws + WS_KVC), KVC_CSTRIDE, (float*)(ws + WS_SM), (bf16*)(ws + WS_VTS), (bf16*)(ws + WS_VTW), (bf16*)(ws + WS_VTC)};
                  pg8::gemm_phase<pg8::EpiIn, pg8::StaticOrder, true>(F.lds + RING_OFF, g, S, E); }
              }
            }
            SEAM(step); ++step;
            if (EN_C && RUN(step)) { unsigned char* ws = wsp(a);
                const bool split = F.G > 128;
                if (!split || F.vcu >= 64) phC_elem(F, a, ly, split);
                if (!split || F.vcu < 64) {
#pragma unroll 1
                    for (int cq = 0; cq < 8; ++cq) { const int c = cq >> 2, kq = cq & 3;
                        pg8::Gemm g{(const bf16*)(ws + WS_KVC) + (size_t)c * KVC_CSTRIDE + kq * 1024, (const bf16*)(ws + WS_W1) + (size_t)c * 256 * 4096 + kq * 1024, 2048, 256, 1024, 2048, 4096};
                        pg8::PlainOrder S; S.init(2048, 256, F.G, split ? F.vcu - 8 * cq : F.vcu);
                        pg8::EpiPart E{(float*)(ws + WS_CBG) + (size_t)cq * 2048 * 256, 256};
                        pg8::gemm_phase<pg8::EpiPart, pg8::PlainOrder, false>(F.lds + RING_OFF, g, S, E);
                    }
                }
            }
            SEAM(step); ++step;
            if (EN_D && RUN(step)) {
                ph_cmp2_mfma(F, a); ph_states_mfma(F, a); ph_swa_mfma(F, a, ly); ph_win_mfma(F, a); }
            SEAM(step); ++step;
            if (EN_E && RUN(step)) { ph_scan2(F, a); ph_cmp_mfma(F, a); }
            SEAM(step); ++step;
            if (EN_F && RUN(step)) {
                ph_ssdy_mfma(F, a, ly); ph_slc_mfma(F, a, (bf16*)(wsp(a) + WS_OA)); }
            SEAM(step); ++step;
            if (EN_G && RUN(step)) { unsigned char* ws = wsp(a);
                pg8::Gemm g{(const bf16*)(ws + WS_OA), (const bf16*)(ws + WS_PT), 3 * TH, 3 * D, 1024, 1024, 1024}; pg8::ProjOrder S; S.init(TH, D, F.G, (int)blockIdx.x);
                pg8::EpiProj E{(bf16*)(ws + (hb ? WS_HN1 : WS_HN)), D, (const bf16*)(ws + WS_U) + UC_G, UP, TH / 256, D / 256, D};
                pg8::gemm_phase<pg8::EpiProj, pg8::ProjOrder, true>(F.lds + RING_OFF, g, S, E);
            }
            SEAM(step); ++step;
            if (EN_H && RUN(step)) { unsigned char* ws = wsp(a);
                pg8::Gemm g{(const bf16*)(ws + (hb ? WS_HN1 : WS_HN)), (const bf16*)(ws + WS_WOUT), TH, D, D, D, D}; pg8::StaticOrder S; S.init(TH, D, F.G, (int)blockIdx.x);
                pg8::EpiOut E{(ly == 0 ? inp(a, 0) : outp(a)) + (size_t)hb * TH * D, outp(a) + (size_t)hb * TH * D, D};
                pg8::gemm_phase<pg8::EpiOut, pg8::StaticOrder, true>(F.lds + RING_OFF, g, S, E);
            }
            SEAM(step); ++step;
        }
        if (EN_I && RUN(step)) ph_route_mfma(F, a, ly);
        SEAM(step); ++step;
        if (EN_K && RUN(step)) { unsigned char* ws = wsp(a); moe_tables(F, ly); const LAS int* tab = (const LAS int*)(F.lds + MOETAB_OFF);
            pg8::Gemm g{(const bf16*)(ws + WS_XB), (const bf16*)(ws + WS_GU), NSLOT, 32 * 1024, D, D, D}; pg8::GroupedOrder<4> S{tab, (const int*)(ws + WS_ELT), T, D * 2, F.G, F.vcu};
            pg8::EpiGU E{(bf16*)(ws + WS_HG), (const float*)(ws + WS_EWR), tab, T};
            pg8::gemm_phase<pg8::EpiGU, pg8::GroupedOrder<4>, true, false, true>(F.lds + RING_OFF, g, S, E);
        }
        SEAM(step); ++step;
        if (EN_L && RUN(step)) { unsigned char* ws = wsp(a); moe_tables(F, ly); const LAS int* tab = (const LAS int*)(F.lds + MOETAB_OFF);
            pg8::Gemm g{(const bf16*)(ws + WS_HG), (const bf16*)(ws + WS_DN), NSLOT, 32 * 2048, 512, 512, 512}; pg8::GroupedOrder<8> S{tab, nullptr, 0, 0, F.G, F.vcu};
            pg8::EpiDown E{(bf16*)(ws + WS_XG)};
            pg8::gemm_phase<pg8::EpiDown, pg8::GroupedOrder<8>, true>(F.lds + RING_OFF, g, S, E);
        }
        SEAM(step); ++step;
    }
    if (RUN(step)) phFinal(F, a);
#undef RUN
#undef SEAM
}

#ifndef MK_SINGLE
#define MK_SINGLE 1
#endif
extern "C" void kernel_launch(void* const* d_in, const int* in_sizes, int n_in, void* d_out, int out_size, void* d_ws, size_t ws_size, hipStream_t stream) {
    static int grid = 0;
    if (grid == 0) {
        if (n_in != 27 || out_size != T * D || ws_size < WS_END) { fprintf(stderr, "kernel_launch: unexpected sizes (n_in %d out %d ws %zu need %zu)\n", n_in, out_size, ws_size, (size_t)WS_END); grid = -1; return; }
        int dev = 0, cus = 0, per_cu = 0;
        if (hipGetDevice(&dev) != hipSuccess || hipDeviceGetAttribute(&cus, hipDeviceAttributeMultiprocessorCount, dev) != hipSuccess) { grid = -1; return; }
        if (hipFuncSetAttribute((const void*)mk_fwd, hipFuncAttributeMaxDynamicSharedMemorySize, LDS_BYTES) != hipSuccess) { grid = -1; return; }
        if (hipOccupancyMaxActiveBlocksPerMultiprocessor(&per_cu, (const void*)mk_fwd, NWAVES * 64, LDS_BYTES) != hipSuccess || per_cu < 1) { fprintf(stderr, "kernel_launch: occupancy query says %d\n", per_cu); }
        (void)hipGetLastError();
        grid = cus;
    }
    if (grid < 0) return;
    if (hipMemsetAsync((char*)d_ws + WS_CTL, 0, CTL_ZERO_BYTES, stream) != hipSuccess) return;
    Args a; memset(&a, 0, sizeof(a));
    for (int i = 0; i < 27; ++i) a.in[i] = (const float*)d_in[i];
    a.out = (float*)d_out; a.ws = (unsigned char*)d_ws;
#ifdef PROBE_K
    a.lo = 0; a.hi = PROBE_K;
    hipLaunchKernelGGL(mk_fwd, dim3(grid), dim3(NWAVES * 64), LDS_BYTES, stream, a);
    if (hipMemsetAsync((char*)d_ws + WS_CTL, 0, CTL_ZERO_BYTES, stream) != hipSuccess) return;
#endif
#if MK_SINGLE
    a.lo = 0; a.hi = NSTEPS;
    hipLaunchKernelGGL(mk_fwd, dim3(grid), dim3(NWAVES * 64), LDS_BYTES, stream, a);
#else
    for (int s = 0; s < NSTEPS; ++s) { a.lo = s; a.hi = s + 1; hipLaunchKernelGGL(mk_fwd, dim3(grid), dim3(NWAVES * 64), LDS_BYTES, stream, a); }
#endif
}
```

```cpp
#include <hip/hip_runtime.h>
#include <cstdio>
#include <cstdint>
#include <cstring>
namespace pg8 {
#define PG8_LAS __attribute__((address_space(3)))
typedef unsigned short bf16_t;
typedef short bf16x8 __attribute__((ext_vector_type(8)));
typedef float f32x4 __attribute__((ext_vector_type(4)));
typedef unsigned u32x4 __attribute__((ext_vector_type(4)));
typedef unsigned u32x2 __attribute__((ext_vector_type(2)));
constexpr int BM = 256, BK = 64, HALF = 128, HTB = HALF * BK * 2  , STAGE_BYTES = 8 * HTB, NXCD = 8, WGM = 4;

__host__ __device__ __forceinline__ int lds_byte(int r, int c) { const int st = (r >> 4) * 2 + (c >> 5), rr = r & 15, cc = c & 31, ob = rr * 64 + cc * 2; return st * 1024 + (ob ^ (((ob >> 9) & 1) << 5)); }
__host__ __device__ __forceinline__ void stage_rc(int b, int& R, int& C) { const int st = b / 1024, sb = b % 1024, swz = sb ^ (((sb >> 9) & 1) << 5); R = (st >> 1) * 16 + swz / 64; C = (st & 1) * 32 + (swz % 64) / 2; }
__host__ __device__ __forceinline__ int perm32(int rho) { const int n = rho >> 4, i = rho & 15; return 8 * (i >> 2) + 4 * n + (i & 3); }

struct Unit { int pm, pn; };
struct Gemm { const bf16_t* A; const bf16_t* Bt; int M, N, K, lda, ldb; };

struct StaticOrder {
    int nM, nN, nwg, G, c;
    __host__ __device__ void init(int M, int N, int G_, int c_) { nM = M / BM; nN = N / BM; nwg = nM * nN; G = G_; c = c_; }
    __host__ __device__ void tile(long L, Unit& u) const {
        int wgid = (int)L; { const int q = nwg / NXCD, r = nwg % NXCD, xcd = wgid % NXCD, off = wgid / NXCD; wgid = (xcd < r ? xcd * (q + 1) : r * (q + 1) + (xcd - r) * q) + off; }
        const int nig = WGM * nN, gid = wgid / nig, fm = gid * WGM, gsz = (nM - fm) < WGM ? (nM - fm) : WGM;
        u.pm = fm + ((wgid % nig) % gsz); u.pn = (wgid % nig) / gsz; }
    __host__ __device__ bool next(int i, Unit& u) const { const long L = (long)i * G + c; if (L >= nwg) return false; tile(L, u); return true; }
    __device__ __forceinline__ unsigned row_off(const Unit&, int) const { return 0u; }
    __device__ __forceinline__ void a_ready(const Unit&) const {}
    __device__ __forceinline__ void done(const Unit&) const {}
};
struct UnevenOrder : StaticOrder {
    int kHi, kLo;
    __device__ bool next(int i, Unit& u) const { const int hG = G >> 1; long L;
        if (c >= hG) { if (i >= kHi) return false; L = (long)i * hG + (c - hG); } else { if (i >= kLo) return false; L = (long)kHi * hG + (long)i * hG + c; }
        if (L >= nwg) return false; tile(L, u); return true; }
};
struct SkipOrder : StaticOrder {
    __device__ bool next(int i, Unit& u) const { const long L = (long)i * G + c; if (L >= nwg) return false; tile(L, u); if (u.pn >= 10) u.pn += 4; return true; }
};
struct ProjOrder : StaticOrder {
    __device__ bool next(int i, Unit& u) const { const int ti = i / 3, br = i - 3 * ti; const long L = (long)ti * G + c; if (L >= nwg) return false; tile(L, u); u.pm += br * nM; u.pn += br * nN; return true; }
};
struct PlainOrder {
    int nM, nN, G, c;
    __device__ void init(int M, int N, int G_, int c_) { nM = M / BM; nN = N / BM; G = G_; c = c_; }
    __device__ bool next(int i, Unit& u) const { const long L = (long)i * G + c; if (c < 0 || L >= (long)nM * nN) return false; u.pm = (int)(L % nM); u.pn = (int)(L / nM); return true; }
    __device__ __forceinline__ unsigned row_off(const Unit&, int) const { return 0u; }
    __device__ __forceinline__ void a_ready(const Unit&) const {}
    __device__ __forceinline__ void done(const Unit&) const {}
};
template <int NT> struct GroupedOrder {
    const PG8_LAS int* tab; const int* list; int cap, ldab, G, c;
    __device__ bool next(int i, Unit& u) const { const long L = (long)i * G + c; const int npan = tab[128]; if (L >= (long)npan * NT) return false; const int p = (int)(L / NT), t = (int)(L % NT); u.pm = p; u.pn = __builtin_amdgcn_readfirstlane(tab[192 + p]) * NT + t; return true; }
    __device__ __forceinline__ unsigned row_off(const Unit& u, int r) const { const int e = u.pn / NT, pos = u.pm * BM + r - tab[e]; const int tk = pos < tab[64 + e] ? list[(size_t)e * cap + pos] : 0; return (unsigned)tk * (unsigned)ldab; }
    __device__ __forceinline__ void a_ready(const Unit&) const {}
    __device__ __forceinline__ void done(const Unit&) const {}
};

typedef float f32x2_cv __attribute__((ext_vector_type(2)));
typedef __bf16 bf16x2_cv __attribute__((ext_vector_type(2)));
__device__ __forceinline__ unsigned cvt_pk_bf16(float lo, float hi) { const f32x2_cv v = {lo, hi}; const bf16x2_cv b = __builtin_convertvector(v, bf16x2_cv); return __builtin_bit_cast(unsigned, b); }
__device__ __forceinline__ float bflo(unsigned w) { return __uint_as_float(w << 16); }
__device__ __forceinline__ float bfhi(unsigned w) { return __uint_as_float(w & 0xffff0000u); }
__device__ __forceinline__ float sigm(float x) { return __builtin_amdgcn_rcpf(1.0f + __builtin_amdgcn_exp2f(x * -1.4426950408889634f)); }

typedef float f32x2 __attribute__((ext_vector_type(2)));
typedef int v8i_t __attribute__((ext_vector_type(8)));
typedef int v4i_t __attribute__((ext_vector_type(4)));
__host__ __device__ __forceinline__ int sw16(int x) { return (x & ~12) | ((x & 4) << 1) | ((x & 8) >> 1); }
__device__ __forceinline__ u32x4 pack8(const f32x4 v0, const f32x4 v1) { u32x4 w; w.x = cvt_pk_bf16(v0[0], v0[1]); w.y = cvt_pk_bf16(v0[2], v0[3]); w.z = cvt_pk_bf16(v1[0], v1[1]); w.w = cvt_pk_bf16(v1[2], v1[3]); return w; }

struct EpiIn {
    static constexpr bool PERM = true, AFTER_DRAIN = false;
    bf16_t* U; int up; bf16_t* KVC; size_t kvc_cstride; float* SM; bf16_t* VTS; bf16_t* VTW; bf16_t* VTC;
    __device__ __forceinline__ void operator()(const f32x4 (&acc)[2][2][4][2], const Unit& u, int wr, int wc, int fr, int fq) const {
        const int row0 = u.pm * BM + wr * 64 + fr; const int pn = u.pn;
        if (pn == 25) {
            if (wc < 2) {
#pragma unroll
                for (int ai = 0; ai < 2; ++ai)
#pragma unroll
                    for (int m = 0; m < 4; ++m) { float* rp = SM + (size_t)(row0 + ai * HALF + m * 16) * 64 + wc * 32 + 8 * fq;
                        *(f32x4*)(rp) = acc[ai][0][m][0]; *(f32x4*)(rp + 4) = acc[ai][0][m][1]; }
            }
            return;
        }
        if (pn == 4 || pn == 5) {
            bf16_t* base = KVC + (size_t)(pn - 4) * kvc_cstride;
#pragma unroll
            for (int ai = 0; ai < 2; ++ai)
#pragma unroll
                for (int m = 0; m < 4; ++m) { const int row = row0 + ai * HALF + m * 16; const int b = row >> 12, s = row & 4095;
#pragma unroll
                    for (int bj = 0; bj < 2; ++bj) { bf16_t* p = base + ((size_t)((b * 2 + bj) * 4096 + s)) * 128 + wc * 32 + 8 * fq;
                        *(u32x4*)p = pack8(acc[ai][bj][m][0], acc[ai][bj][m][1]); } }
            return;
        }
        if (pn == 7 || pn == 9) {
            bf16_t* vt = pn == 7 ? VTS : VTW;
#pragma unroll
            for (int ai = 0; ai < 2; ++ai)
#pragma unroll
                for (int m = 0; m < 4; ++m) { const int row = row0 + ai * HALF + m * 16; const int b = row >> 12, s = row & 4095;
#pragma unroll
                    for (int bj = 0; bj < 2; ++bj) { bf16_t* p = vt + ((size_t)((b * 2 + bj) * 128 + wc * 32 + 8 * fq)) * 4096 + sw16(s); const u32x4 w = pack8(acc[ai][bj][m][0], acc[ai][bj][m][1]);
                        p[0] = (bf16_t)(w.x & 0xffffu); p[4096] = (bf16_t)(w.x >> 16); p[2 * 4096] = (bf16_t)(w.y & 0xffffu); p[3 * 4096] = (bf16_t)(w.y >> 16);
                        p[4 * 4096] = (bf16_t)(w.z & 0xffffu); p[5 * 4096] = (bf16_t)(w.z >> 16); p[6 * 4096] = (bf16_t)(w.w & 0xffffu); p[7 * 4096] = (bf16_t)(w.w >> 16); } }
            return;
        }
        if (pn == 24) {
#pragma unroll
            for (int ai = 0; ai < 2; ++ai)
#pragma unroll
                for (int m = 0; m < 4; ++m) { const int row = row0 + ai * HALF + m * 16; const int b = row >> 12, s = row & 4095;
                    bf16_t* p = VTC + ((size_t)((b * 2 + (wc >> 1)) * 64 + (wc & 1) * 32 + 8 * fq)) * 4096 + sw16(s); const u32x4 w = pack8(acc[ai][1][m][0], acc[ai][1][m][1]);
                    p[0] = (bf16_t)(w.x & 0xffffu); p[4096] = (bf16_t)(w.x >> 16); p[2 * 4096] = (bf16_t)(w.y & 0xffffu); p[3 * 4096] = (bf16_t)(w.y >> 16);
                    p[4 * 4096] = (bf16_t)(w.z & 0xffffu); p[5 * 4096] = (bf16_t)(w.z >> 16); p[6 * 4096] = (bf16_t)(w.w & 0xffffu); p[7 * 4096] = (bf16_t)(w.w >> 16); }
        }
#pragma unroll
        for (int ai = 0; ai < 2; ++ai)
#pragma unroll
            for (int m = 0; m < 4; ++m) { bf16_t* rowp = U + (size_t)(row0 + ai * HALF + m * 16) * up + pn * BM + wc * 32 + 8 * fq;
#pragma unroll
                for (int bj = 0; bj < 2; ++bj) *(u32x4*)(rowp + bj * HALF) = pack8(acc[ai][bj][m][0], acc[ai][bj][m][1]); }
    }
};
struct EpiGate {
    static constexpr bool PERM = true, AFTER_DRAIN = false;
    unsigned char* G; int ldg; float scale; bf16_t* Uz; int up;
    __device__ __forceinline__ void operator()(const f32x4 (&acc)[2][2][4][2], const Unit& u, int wr, int wc, int fr, int fq) const {
        const int row0 = u.pm * BM + wr * 64 + fr;
        if (u.pn >= 24) {
#pragma unroll
            for (int ai = 0; ai < 2; ++ai)
#pragma unroll
                for (int m = 0; m < 4; ++m) { bf16_t* rowp = Uz + (size_t)(row0 + ai * HALF + m * 16) * up + (u.pn - 24) * BM + wc * 32 + 8 * fq;
#pragma unroll
                    for (int bj = 0; bj < 2; ++bj) *(u32x4*)(rowp + bj * HALF) = pack8(acc[ai][bj][m][0] * scale, acc[ai][bj][m][1] * scale); }
            return;
        }
#pragma unroll
        for (int ai = 0; ai < 2; ++ai)
#pragma unroll
            for (int m = 0; m < 4; ++m) { unsigned char* rowp = G + ((size_t)((u.pn >> 3) * ldg + u.pm) * 8 + (u.pn & 7)) * 65536 + (size_t)(wr * 64 + fr + ai * HALF + m * 16) * 256 + wc * 64 + 16 * fq;
                u32x4 o;
#pragma unroll
                for (int bj = 0; bj < 2; ++bj) { const f32x4 v0 = acc[ai][bj][m][0] * scale, v1 = acc[ai][bj][m][1] * scale; unsigned w0 = 0u, w1 = 0u;
#pragma unroll
                    for (int j = 0; j < 4; ++j) { w0 = __builtin_amdgcn_cvt_pk_u8_f32(sigm(v0[j]) * 255.0f, j, w0); w1 = __builtin_amdgcn_cvt_pk_u8_f32(sigm(v1[j]) * 255.0f, j, w1); }
                    if (bj == 0) { o.x = w0; o.y = w1; } else { o.z = w0; o.w = w1; } }
                *(u32x4*)rowp = o; }
    }
};
struct EpiSilu {
    static constexpr bool PERM = true, AFTER_DRAIN = false;
    bf16_t* O; int ldc; const float* bias;
    __device__ __forceinline__ void operator()(const f32x4 (&acc)[2][2][4][2], const Unit& u, int wr, int wc, int fr, int fq) const {
        const int row0 = u.pm * BM + wr * 64 + fr; const int col0 = u.pn * BM + wc * 32 + 8 * fq;
        f32x4 bv[2][2];
#pragma unroll
        for (int bj = 0; bj < 2; ++bj)
#pragma unroll
            for (int n = 0; n < 2; ++n) bv[bj][n] = *(const f32x4*)(bias + col0 + bj * HALF + 4 * n);
#pragma unroll
        for (int ai = 0; ai < 2; ++ai)
#pragma unroll
            for (int m = 0; m < 4; ++m) { bf16_t* rowp = O + (size_t)(row0 + ai * HALF + m * 16) * ldc + col0;
#pragma unroll
                for (int bj = 0; bj < 2; ++bj) { f32x4 v0 = acc[ai][bj][m][0] + bv[bj][0], v1 = acc[ai][bj][m][1] + bv[bj][1];
#pragma unroll
                    for (int j = 0; j < 4; ++j) { v0[j] = v0[j] * sigm(v0[j]); v1[j] = v1[j] * sigm(v1[j]); }
                    *(u32x4*)(rowp + bj * HALF) = pack8(v0, v1); } }
    }
};
#if defined(REP_B) || defined(REP_G)
#if REP_B == 1
#define REP_MM (-1)
#define REP_MN (-1)
#elif REP_B == 2
#define REP_MM 0
#define REP_MN 0
#else
#define REP_MM 3
#define REP_MN 7
#endif
struct ProbeOrder : StaticOrder { int mm, mn;
    __device__ bool next(int i, Unit& u) const { const long L = (long)i * G + c; if (L >= nwg) return false; tile(L, u); u.pm &= mm; u.pn &= mn; return true; } };
struct EpiSink {
    static constexpr bool PERM = false, AFTER_DRAIN = false;
    float* P;
    __device__ __forceinline__ void operator()(const f32x4 (&acc)[2][2][4][2], const Unit& u, int wr, int wc, int fr, int fq) const {
        float s = 0.f;
#pragma unroll
        for (int ai = 0; ai < 2; ++ai)
#pragma unroll
            for (int m = 0; m < 4; ++m)
#pragma unroll
                for (int bj = 0; bj < 2; ++bj)
#pragma unroll
                    for (int n = 0; n < 2; ++n) s += acc[ai][bj][m][n].x + acc[ai][bj][m][n].w;
        if (s == 1.2345e-30f) P[0] = s; }
};
#endif
struct EpiPart {
    static constexpr bool PERM = false, AFTER_DRAIN = false;
    float* P; int ldc;
    __device__ __forceinline__ void operator()(const f32x4 (&acc)[2][2][4][2], const Unit& u, int wr, int wc, int fr, int fq) const {
        const int row0 = u.pm * BM + wr * 64 + fr, col0 = u.pn * BM + wc * 32 + 4 * fq;
#pragma unroll
        for (int ai = 0; ai < 2; ++ai)
#pragma unroll
            for (int m = 0; m < 4; ++m) { float* rp = P + (size_t)(row0 + ai * HALF + m * 16) * ldc + col0;
#pragma unroll
                for (int bj = 0; bj < 2; ++bj)
#pragma unroll
                    for (int n = 0; n < 2; ++n) *(f32x4*)(rp + bj * HALF + n * 16) = acc[ai][bj][m][n]; }
    }
};
struct EpiProj {
    static constexpr bool PERM = true, AFTER_DRAIN = false, CHAIN = true;
    bf16_t* Y; int ldy; const unsigned char* Gt; int ldg; int npm, npn, gstride;
    __device__ __forceinline__ bool keep(const Unit& u) const { return u.pm / npm < 2; }
    __device__ __forceinline__ void operator()(f32x4 (&acc)[2][2][4][2], const Unit& u, int wr, int wc, int fr, int fq) const {
        const int br = u.pm / npm, pm = u.pm - br * npm, pn = u.pn - br * npn; const bool last = br == 2;
        const unsigned char* GT = Gt + ((size_t)(br * npm + pm) * npn + pn) * 65536; const unsigned char* GN = Gt + ((size_t)((last ? br : br + 1) * npm + pm) * npn + pn) * 65536;
        const int row0 = pm * BM + wr * 64 + fr; const int col0 = pn * BM + wc * 32 + 8 * fq;
#pragma unroll
        for (int ai = 0; ai < 2; ++ai) { u32x2 g[4][2], h[4][2];
#pragma unroll
            for (int m = 0; m < 4; ++m) { const size_t o = (size_t)(wr * 64 + fr + ai * HALF + m * 16) * 256 + wc * 64 + 16 * fq; const u32x4 gq = *(const u32x4*)(GT + o), hq = *(const u32x4*)(GN + o);
                g[m][0] = (u32x2){gq.x, gq.y}; g[m][1] = (u32x2){gq.z, gq.w}; h[m][0] = (u32x2){hq.x, hq.y}; h[m][1] = (u32x2){hq.z, hq.w}; }
#pragma unroll
            for (int m = 0; m < 4; ++m) { const size_t row = (size_t)(row0 + ai * HALF + m * 16);
#pragma unroll
                for (int bj = 0; bj < 2; ++bj) { const u32x2 gg = g[m][bj], hh = h[m][bj]; f32x4 s0, s1;
                    s0[0] = fmaxf((float)(gg.x & 0xffu), 1.f); s0[1] = fmaxf((float)((gg.x >> 8) & 0xffu), 1.f); s0[2] = fmaxf((float)((gg.x >> 16) & 0xffu), 1.f); s0[3] = fmaxf((float)(gg.x >> 24), 1.f);
                    s1[0] = fmaxf((float)(gg.y & 0xffu), 1.f); s1[1] = fmaxf((float)((gg.y >> 8) & 0xffu), 1.f); s1[2] = fmaxf((float)((gg.y >> 16) & 0xffu), 1.f); s1[3] = fmaxf((float)(gg.y >> 24), 1.f);
                    if (last) { *(u32x4*)(Y + row * ldy + col0 + bj * HALF) = pack8(acc[ai][bj][m][0] * s0 * (1.0f / 255.0f), acc[ai][bj][m][1] * s1 * (1.0f / 255.0f)); }
                    else { f32x4 d0, d1;
                        d0[0] = __builtin_amdgcn_rcpf(fmaxf((float)(hh.x & 0xffu), 1.f)); d0[1] = __builtin_amdgcn_rcpf(fmaxf((float)((hh.x >> 8) & 0xffu), 1.f)); d0[2] = __builtin_amdgcn_rcpf(fmaxf((float)((hh.x >> 16) & 0xffu), 1.f)); d0[3] = __builtin_amdgcn_rcpf(fmaxf((float)(hh.x >> 24), 1.f));
                        d1[0] = __builtin_amdgcn_rcpf(fmaxf((float)(hh.y & 0xffu), 1.f)); d1[1] = __builtin_amdgcn_rcpf(fmaxf((float)((hh.y >> 8) & 0xffu), 1.f)); d1[2] = __builtin_amdgcn_rcpf(fmaxf((float)((hh.y >> 16) & 0xffu), 1.f)); d1[3] = __builtin_amdgcn_rcpf(fmaxf((float)(hh.y >> 24), 1.f));
                        acc[ai][bj][m][0] = acc[ai][bj][m][0] * (s0 * d0); acc[ai][bj][m][1] = acc[ai][bj][m][1] * (s1 * d1); } } }
            asm volatile("" ::: "memory"); }
    }
};
struct EpiOut {
    static constexpr bool PERM = true, AFTER_DRAIN = false;
    const float* xf; bf16_t* xb; int ldc;
    __device__ __forceinline__ void operator()(const f32x4 (&acc)[2][2][4][2], const Unit& u, int wr, int wc, int fr, int fq) const {
        const int row0 = u.pm * BM + wr * 64 + fr, col0 = u.pn * BM + wc * 32 + 8 * fq;
        if (xf != nullptr) {
#pragma unroll
            for (int ai = 0; ai < 2; ++ai) { f32x4 b[4][2][2];
#pragma unroll
                for (int m = 0; m < 4; ++m) { const size_t off = (size_t)(row0 + ai * HALF + m * 16) * ldc + col0;
#pragma unroll
                    for (int bj = 0; bj < 2; ++bj)
#pragma unroll
                        for (int n = 0; n < 2; ++n) b[m][bj][n] = *(const f32x4*)(xf + off + bj * HALF + n * 4); }
#pragma unroll
                for (int m = 0; m < 4; ++m) { const size_t off = (size_t)(row0 + ai * HALF + m * 16) * ldc + col0;
#pragma unroll
                    for (int bj = 0; bj < 2; ++bj) *(u32x4*)(xb + off + bj * HALF) = pack8(b[m][bj][0] + acc[ai][bj][m][0], b[m][bj][1] + acc[ai][bj][m][1]); }
                asm volatile("" ::: "memory"); }
        } else {
#pragma unroll
            for (int ai = 0; ai < 2; ++ai) { u32x4 y[4][2];
#pragma unroll
                for (int m = 0; m < 4; ++m) { const size_t off = (size_t)(row0 + ai * HALF + m * 16) * ldc + col0;
#pragma unroll
                    for (int bj = 0; bj < 2; ++bj) y[m][bj] = *(const u32x4*)(xb + off + bj * HALF); }
#pragma unroll
                for (int m = 0; m < 4; ++m) { const size_t off = (size_t)(row0 + ai * HALF + m * 16) * ldc + col0;
#pragma unroll
                    for (int bj = 0; bj < 2; ++bj) { const u32x4 yy = y[m][bj]; f32x4 v0 = acc[ai][bj][m][0], v1 = acc[ai][bj][m][1];
                        v0[0] += bflo(yy.x); v0[1] += bfhi(yy.x); v0[2] += bflo(yy.y); v0[3] += bfhi(yy.y); v1[0] += bflo(yy.z); v1[1] += bfhi(yy.z); v1[2] += bflo(yy.w); v1[3] += bfhi(yy.w);
                        *(u32x4*)(xb + off + bj * HALF) = pack8(v0, v1); } }
                asm volatile("" ::: "memory"); }
        }
    }
};
struct EpiGU {
    static constexpr bool PERM = true, AFTER_DRAIN = false;
    bf16_t* HG; const float* ewr; const PG8_LAS int* tab; int cap;
    __device__ __forceinline__ void operator()(const f32x4 (&acc)[2][2][4][2], const Unit& u, int wr, int wc, int fr, int fq) const {
        const int row0 = u.pm * BM + wr * 64 + fr; const int col0 = (u.pn & 3) * HALF + wc * 32 + 8 * fq; const int e = u.pn >> 2, off = tab[e], cn = tab[64 + e];
#pragma unroll
        for (int ai = 0; ai < 2; ++ai)
#pragma unroll
            for (int m = 0; m < 4; ++m) { const int row = row0 + ai * HALF + m * 16, pos = row - off; float w = 0.f, ri = 0.f; if (pos < cn) { const f32x2 t = *(const f32x2*)(ewr + ((size_t)e * cap + pos) * 2); w = t.x; ri = t.y; }
                f32x4 v0, v1;
#pragma unroll
                for (int j = 0; j < 4; ++j) { const float g0 = acc[ai][0][m][0][j] * ri, g1 = acc[ai][0][m][1][j] * ri; v0[j] = g0 * sigm(g0) * acc[ai][1][m][0][j] * (ri * w); v1[j] = g1 * sigm(g1) * acc[ai][1][m][1][j] * (ri * w); }
                *(u32x4*)(HG + (size_t)row * 512 + col0) = pack8(v0, v1); }
    }
};
struct EpiDown {
    static constexpr bool PERM = true, AFTER_DRAIN = false;
    bf16_t* YG;
    __device__ __forceinline__ void operator()(const f32x4 (&acc)[2][2][4][2], const Unit& u, int wr, int wc, int fr, int fq) const {
        const int row0 = u.pm * BM + wr * 64 + fr, col0 = (u.pn & 7) * BM + wc * 32 + 8 * fq;
#pragma unroll
        for (int ai = 0; ai < 2; ++ai)
#pragma unroll
            for (int m = 0; m < 4; ++m) { bf16_t* rowp = YG + (size_t)(row0 + ai * HALF + m * 16) * 2048 + col0;
#pragma unroll
                for (int bj = 0; bj < 2; ++bj) __builtin_nontemporal_store(pack8(acc[ai][bj][m][0], acc[ai][bj][m][1]), (u32x4*)(rowp + bj * HALF)); }
    }
};

template <class T, class = void> struct epi_chain { static constexpr bool value = false; };
template <class T> struct epi_chain<T, decltype((void)T::CHAIN)> { static constexpr bool value = true; };
template <class Epi, class Sched, bool ALIGN_EPI = false, bool F8 = false, bool GATHER = false>
__device__ __forceinline__ void gemm_phase(PG8_LAS unsigned char* lds, const Gemm g, const Sched& S, const Epi& E) {
    int tid_ = threadIdx.x; asm volatile("" : "+v"(tid_));
    const int tid = tid_, wid = __builtin_amdgcn_readfirstlane(tid >> 6), lane = tid & 63, wr = wid >> 2, wc = wid & 3, fr = lane & 15, fq = lane >> 4;
    const int K = g.K, nt = K / BK, lda = g.lda, ldb = g.ldb;
    unsigned voffA[2], voffB[2];
#pragma unroll
    for (int i = 0; i < 2; ++i) { int R, C; stage_rc(tid * 16 + i * 8192, R, C); const int Rb = Epi::PERM ? ((R & ~31) + perm32(R & 31)) : R;
        voffA[i] = (unsigned)(R * lda + C) * 2u; voffB[i] = (unsigned)(Rb * ldb + C) * 2u; }
    const size_t kstep = (size_t)(BK * 2);
    const size_t hstepA = (size_t)HALF * lda * 2, hstepB = (size_t)HALF * ldb * 2;
    const size_t tstepB = 2 * hstepB;
    const size_t hstepAg = GATHER ? 0 : hstepA, tstepA = GATHER ? 0 : 2 * hstepA;
    const unsigned ldsw = (unsigned)wid * 1024u;
    const int aoff = lds_byte(wr * 64 + fr, fq * 8), boff = lds_byte(wc * 32 + fr, fq * 8);
#define PG8_SA(b, h) (((b) * 2 + (h)) * HTB)
#define PG8_SB(b, h) ((4 + (b) * 2 + (h)) * HTB)
#define PG8_VA(nx, h) (GATHER ? ((nx) ? vnx[h] : vcu[h]) : voffA)
#define PG8_STAGE(bufoff, gbase, voff) do { _Pragma("unroll") for (int _i = 0; _i < 2; ++_i) \
        __builtin_amdgcn_global_load_lds((const unsigned*)((const char*)(gbase) + (voff)[_i]), (PG8_LAS unsigned*)(lds + (bufoff) + ldsw + _i * 8192), 16, 0, 0); } while (0)
#define PG8_LDA(dst, b, h) do { _Pragma("unroll") for (int m = 0; m < 4; ++m) { if constexpr (F8) { dst##8[m].lo = *(const PG8_LAS v4i_t*)(lds + PG8_SA(b, h) + aoff + m * 2048); dst##8[m].hi = *(const PG8_LAS v4i_t*)(lds + PG8_SA(b, h) + aoff + m * 2048 + 1024); } \
        else { _Pragma("unroll") for (int k = 0; k < 2; ++k) dst[m][k] = *(const PG8_LAS bf16x8*)(lds + PG8_SA(b, h) + aoff + m * 2048 + k * 1024); } } } while (0)
#define PG8_LDB(dst, b, h) do { _Pragma("unroll") for (int n = 0; n < 2; ++n) { if constexpr (F8) { dst##8[n].lo = *(const PG8_LAS v4i_t*)(lds + PG8_SB(b, h) + boff + n * 2048); dst##8[n].hi = *(const PG8_LAS v4i_t*)(lds + PG8_SB(b, h) + boff + n * 2048 + 1024); } \
        else { _Pragma("unroll") for (int k = 0; k < 2; ++k) dst[n][k] = *(const PG8_LAS bf16x8*)(lds + PG8_SB(b, h) + boff + n * 2048 + k * 1024); } } } while (0)
#define PG8_MMA(ai, bj, At, Bt) do { __builtin_amdgcn_s_setprio(1); _Pragma("unroll") for (int m = 0; m < 4; ++m) _Pragma("unroll") for (int n = 0; n < 2; ++n) { \
        if constexpr (F8) asm volatile("v_mfma_f32_16x16x128_f8f6f4 %0, %1, %2, %0" : "+v"(acc[ai][bj][m][n]) : "v"(Bt##8[n]), "v"(At##8[m])); \
        else { _Pragma("unroll") for (int k = 0; k < 2; ++k) acc[ai][bj][m][n] = __builtin_amdgcn_mfma_f32_16x16x32_bf16(Bt[n][k], At[m][k], acc[ai][bj][m][n], 0, 0, 0); } } __builtin_amdgcn_s_setprio(0); } while (0)
#define PG8_WAIT_V(n) asm volatile("s_waitcnt vmcnt(" #n ")" ::: "memory")
#define PG8_WAIT_L(n) asm volatile("s_waitcnt lgkmcnt(" #n ")" ::: "memory")
#define PG8_BAR __builtin_amdgcn_s_barrier()
#define PG8_SCHED __builtin_amdgcn_sched_barrier(0)
    Unit cur, nxt; int ui = 0;
    if (!S.next(0, cur)) return;
    f32x4 acc[2][2][4][2];
#pragma unroll
    for (int a = 0; a < 2; ++a)
#pragma unroll
        for (int b = 0; b < 2; ++b)
#pragma unroll
            for (int m = 0; m < 4; ++m)
#pragma unroll
                for (int n = 0; n < 2; ++n) acc[a][b][m][n] = (f32x4){0.f, 0.f, 0.f, 0.f};
    bf16x8 At[4][2], B0[2][2], B1[2][2]; v8i_t At8[4], B08[2], B18[2];
    const char* cA = (const char*)g.A + (size_t)cur.pm * tstepA; const char* cB = (const char*)g.Bt + (size_t)cur.pn * tstepB;
    unsigned vcu[2][2], vnx[2][2];
#define PG8_GOFF(u, v) do { _Pragma("unroll") for (int _h = 0; _h < 2; ++_h) _Pragma("unroll") for (int _i = 0; _i < 2; ++_i) { int R, C; stage_rc(tid * 16 + _i * 8192, R, C); v[_h][_i] = S.row_off(u, _h * HALF + R) + (unsigned)C * 2u; } } while (0)
    if constexpr (GATHER) PG8_GOFF(cur, vcu);
    S.a_ready(cur);
    PG8_STAGE(PG8_SB(0, 0), cB, voffB); PG8_STAGE(PG8_SB(0, 1), cB + hstepB, voffB); PG8_STAGE(PG8_SA(0, 0), cA, PG8_VA(false, 0)); PG8_STAGE(PG8_SA(0, 1), cA + hstepAg, PG8_VA(false, 1));
    if (wr == 1) PG8_BAR;
    PG8_WAIT_V(2); PG8_BAR;
    PG8_STAGE(PG8_SB(1, 0), cB + kstep, voffB); PG8_STAGE(PG8_SA(1, 0), cA + kstep, PG8_VA(false, 0)); PG8_STAGE(PG8_SB(1, 1), cB + hstepB + kstep, voffB);
    PG8_WAIT_V(6); PG8_BAR;
    for (;;) {
        const bool has_next = S.next(ui + 1, nxt);
        if constexpr (GATHER) { if (has_next) PG8_GOFF(nxt, vnx); else {
#pragma unroll
            for (int _h = 0; _h < 2; ++_h)
#pragma unroll
                for (int _i = 0; _i < 2; ++_i) vnx[_h][_i] = vcu[_h][_i]; } }
        const char* nA = has_next ? (const char*)g.A + (size_t)nxt.pm * tstepA : cA; const char* nB = has_next ? (const char*)g.Bt + (size_t)nxt.pn * tstepB : cB;
        for (int t = 0; t < nt; t += 2) {
            const bool last = (t == nt - 2);
            const char* a1 = cA + (size_t)(t + 1) * kstep;
            const char* a2 = last ? nA : cA + (size_t)(t + 2) * kstep; const char* b2 = last ? nB : cB + (size_t)(t + 2) * kstep;
            const char* a3 = a2 + kstep; const char* b3 = b2 + kstep;
            if (last && has_next) S.a_ready(nxt);
            PG8_LDB(B0, 0, 0); PG8_LDB(B1, 0, 1); PG8_SCHED; PG8_LDA(At, 0, 0); PG8_STAGE(PG8_SA(1, 1), a1 + hstepAg, PG8_VA(false, 1));
            PG8_WAIT_V(8); PG8_WAIT_L(0); PG8_BAR; PG8_MMA(0, 0, At, B0); PG8_MMA(0, 1, At, B1); PG8_BAR; PG8_SCHED;
            PG8_LDA(At, 0, 1); PG8_STAGE(PG8_SB(0, 0), b2, voffB); PG8_STAGE(PG8_SB(0, 1), b2 + hstepB, voffB); PG8_STAGE(PG8_SA(0, 0), a2, PG8_VA(last, 0));
            PG8_WAIT_V(8); PG8_WAIT_L(0); PG8_BAR; PG8_MMA(1, 0, At, B0); PG8_MMA(1, 1, At, B1); PG8_BAR; PG8_SCHED;
            PG8_LDB(B0, 1, 0); PG8_LDB(B1, 1, 1); PG8_SCHED; PG8_LDA(At, 1, 0); PG8_STAGE(PG8_SA(0, 1), a2 + hstepAg, PG8_VA(last, 1));
            PG8_WAIT_V(8); PG8_WAIT_L(0); PG8_BAR; PG8_MMA(0, 0, At, B0); PG8_MMA(0, 1, At, B1); PG8_BAR; PG8_SCHED;
            PG8_LDA(At, 1, 1); PG8_STAGE(PG8_SB(1, 0), b3, voffB); PG8_STAGE(PG8_SB(1, 1), b3 + hstepB, voffB); PG8_STAGE(PG8_SA(1, 0), a3, PG8_VA(last, 0));
            PG8_WAIT_V(8); PG8_WAIT_L(0); PG8_BAR; PG8_MMA(1, 0, At, B0); PG8_MMA(1, 1, At, B1); PG8_BAR; PG8_SCHED;
        }
        if constexpr (ALIGN_EPI) { if (wr == 0) PG8_BAR; }
        if constexpr (F8) {
            asm volatile("s_nop 15\n\ts_nop 15" : "+v"(acc[0][0][0][0]), "+v"(acc[0][0][0][1]), "+v"(acc[0][0][1][0]), "+v"(acc[0][0][1][1]), "+v"(acc[0][0][2][0]), "+v"(acc[0][0][2][1]), "+v"(acc[0][0][3][0]), "+v"(acc[0][0][3][1]),
                                                    "+v"(acc[0][1][0][0]), "+v"(acc[0][1][0][1]), "+v"(acc[0][1][1][0]), "+v"(acc[0][1][1][1]), "+v"(acc[0][1][2][0]), "+v"(acc[0][1][2][1]), "+v"(acc[0][1][3][0]), "+v"(acc[0][1][3][1]));
            asm volatile("" : "+v"(acc[1][0][0][0]), "+v"(acc[1][0][0][1]), "+v"(acc[1][0][1][0]), "+v"(acc[1][0][1][1]), "+v"(acc[1][0][2][0]), "+v"(acc[1][0][2][1]), "+v"(acc[1][0][3][0]), "+v"(acc[1][0][3][1]),
                                "+v"(acc[1][1][0][0]), "+v"(acc[1][1][0][1]), "+v"(acc[1][1][1][0]), "+v"(acc[1][1][1][1]), "+v"(acc[1][1][2][0]), "+v"(acc[1][1][2][1]), "+v"(acc[1][1][3][0]), "+v"(acc[1][1][3][1])); }
        E(acc, cur, wr, wc, fr, fq); S.done(cur);
        if (!has_next) break;
        bool zero = true; if constexpr (epi_chain<Epi>::value) zero = !E.keep(cur);
        if (zero) {
#pragma unroll
        for (int a = 0; a < 2; ++a)
#pragma unroll
            for (int b = 0; b < 2; ++b)
#pragma unroll
                for (int m = 0; m < 4; ++m)
#pragma unroll
                    for (int n = 0; n < 2; ++n) acc[a][b][m][n] = (f32x4){0.f, 0.f, 0.f, 0.f};
        }
        cur = nxt; cA = nA; cB = nB; ++ui;
        if constexpr (GATHER) {
#pragma unroll
            for (int _h = 0; _h < 2; ++_h)
#pragma unroll
                for (int _i = 0; _i < 2; ++_i) vcu[_h][_i] = vnx[_h][_i]; }
        if constexpr (ALIGN_EPI) { if (wr == 1) PG8_BAR; }
    }
    PG8_WAIT_V(0);
    if constexpr (!ALIGN_EPI) { if (wr == 0) PG8_BAR; }
    PG8_BAR;
#undef PG8_SA
#undef PG8_VA
#undef PG8_GOFF
#undef PG8_SB
#undef PG8_STAGE
#undef PG8_LDA
#undef PG8_LDB
#undef PG8_MMA
#undef PG8_WAIT_V
#undef PG8_WAIT_L
#undef PG8_BAR
#undef PG8_SCHED
}
}
constexpr int NB = 8, S = 4096, D = 2048, T = NB * S;
constexpr int HBN = 4, TH = HBN * S;
constexpr int IN_DIM = 12584, NIN1 = 6656, NGATE = 6144, NF8 = NGATE + 1024, UP = 6400;
constexpr int UC_Q = 0, UC_KV = 1024, UC_Z = 2560, UC_XBC = 3584, UC_SQ = 5120, UC_SKV = 6144, UC_G = 6400;
constexpr int NSLOT = 73728;
constexpr float NORM_EPS = 1e-6f;

constexpr size_t MiB = 1u << 20;
constexpr size_t WS_CTL = 0, CTL_ZERO_BYTES = 1 * MiB;
constexpr size_t WS_TAB = 1 * MiB;
constexpr size_t WS_B1P = WS_TAB + 3 * MiB;
constexpr size_t WS_WR = WS_B1P + 64 * 1024;
constexpr size_t WS_W2T = WS_WR + 512 * 1024;
constexpr size_t WS_WIN = 5 * MiB;
constexpr size_t WS_WG8 = WS_WIN + 26 * MiB;
constexpr size_t WS_W1 = WS_WIN + 50 * MiB;
constexpr size_t WS_PT = WS_W1 + 4 * MiB;
constexpr size_t WS_WOUT = WS_PT + 12 * MiB;
constexpr size_t WS_GU = WS_WOUT + 8 * MiB;
constexpr size_t WS_DN = WS_GU + 128 * MiB;
constexpr size_t WS_ACT = WS_DN + 64 * MiB;
constexpr size_t WS_HN = WS_ACT;
constexpr size_t WS_U = WS_HN + 64 * MiB;
constexpr size_t WS_GT = WS_U + 200 * MiB;
constexpr size_t WS_KVC = WS_U + 296 * MiB;
constexpr size_t KVC_CSTRIDE = (size_t)(HBN * 2 * 4096 + 16) * 128;
constexpr size_t WS_SM = WS_KVC + 17 * MiB;
constexpr size_t WS_QR = WS_SM + 4 * MiB;
constexpr size_t WS_XC = WS_QR + 32 * MiB;
constexpr size_t WS_DTV = WS_XC + 48 * MiB;
constexpr size_t WS_ACS = WS_DTV + 1 * MiB;
constexpr size_t WS_HID = WS_ACS + 1 * MiB;
constexpr size_t WS_KC = WS_HID + 2 * MiB;
constexpr size_t WS_SEL = WS_KC + 1 * MiB;
constexpr size_t WS_OA = WS_SEL + 1 * MiB;
constexpr size_t WS_OB = WS_OA + 32 * MiB, WS_OC = WS_OB + 32 * MiB;
constexpr size_t WS_CBG = WS_OA + 96 * MiB;
constexpr size_t WS_YD = WS_CBG + 16 * MiB;
constexpr size_t WS_ST = WS_YD + 32 * MiB;
constexpr size_t WS_VTS = WS_ST + 64 * MiB;
constexpr size_t WS_VTW = WS_VTS + 8 * MiB;
constexpr size_t WS_VTC = WS_VTW + 8 * MiB;
constexpr size_t WS_VCT = WS_VTC + 4 * MiB;
constexpr size_t WS_HN1 = WS_VCT + 1 * MiB;
constexpr size_t WS_HN8 = WS_HN1 + 64 * MiB;
constexpr size_t WS_XB = WS_HN8 + 64 * MiB;
constexpr size_t WS_MIX_END = WS_XB + 128 * MiB;
constexpr size_t WS_ROUTE = WS_U;
constexpr size_t WS_ELT = WS_ROUTE + 1 * MiB;
constexpr size_t WS_EWR = WS_ELT + 4 * MiB;
constexpr size_t WS_HG = WS_EWR + 8 * MiB;
constexpr size_t WS_XG = WS_HG + 72 * MiB;
constexpr size_t WS_MOE_END = WS_XG + 288 * MiB;
static_assert(WS_MOE_END <= WS_CBG, "MoE buffers must stay inside the dead mixer buffers");
constexpr size_t WS_END = WS_MIX_END > WS_MOE_END ? WS_MIX_END : WS_MOE_END;
constexpr int CW_BAR = 4096;
constexpr int CW_ECNT = 16384;

constexpr int RING_OFF = 0, RING_BYTES = 131072;
constexpr int LDS_BYTES = 147456;
constexpr int LDSCTL_OFF = LDS_BYTES - 512, MISC_OFF = LDSCTL_OFF + 320;
constexpr int MOETAB_OFF = RING_BYTES;
constexpr int NWAVES = 8;

#define GAS __attribute__((address_space(1)))
#define LAS __attribute__((address_space(3)))
typedef unsigned short bf16;
typedef unsigned v4u __attribute__((ext_vector_type(4)));
typedef unsigned v2u __attribute__((ext_vector_type(2)));
typedef float f32x4 __attribute__((ext_vector_type(4)));
typedef float v2f __attribute__((ext_vector_type(2)));
typedef GAS unsigned gu32;
#define RLX_AGENT __ATOMIC_RELAXED, __HIP_MEMORY_SCOPE_AGENT
#define LDS_WAIT() asm volatile("s_waitcnt lgkmcnt(0)" ::: "memory")
#define VM_WAIT() asm volatile("s_waitcnt vmcnt(0)" ::: "memory")
__device__ __forceinline__ unsigned f2bf(float f) { unsigned u = __builtin_bit_cast(unsigned, f); return (u + 0x7fffu + ((u >> 16) & 1u)) >> 16; }
__device__ __forceinline__ unsigned pk2(float lo, float hi) { return f2bf(lo) | (f2bf(hi) << 16); }
__device__ __forceinline__ float bf2f(bf16 v) { return __uint_as_float(((unsigned)v) << 16); }
__device__ __forceinline__ float blo(unsigned w) { return __uint_as_float(w << 16); }
__device__ __forceinline__ float bhi(unsigned w) { return __uint_as_float(w & 0xffff0000u); }
__device__ __forceinline__ float sigmf(float x) { return __builtin_amdgcn_rcpf(1.0f + __builtin_amdgcn_exp2f(x * -1.4426950408889634f)); }
__host__ __device__ __forceinline__ int sw16(int x) { return (x & ~12) | ((x & 4) << 1) | ((x & 8) >> 1); }
__device__ __forceinline__ float wave_sum(float v) {
#pragma unroll
    for (int o = 1; o < 64; o <<= 1) v += __shfl_xor(v, o);
    return v;
}
__device__ __forceinline__ float wave_max(float v) {
#pragma unroll
    for (int o = 1; o < 64; o <<= 1) v = fmaxf(v, __shfl_xor(v, o));
    return v;
}

#define XB_TMO      128
#define XB_XCNT(j)  (256  + 64 * (j))
#define XB_XSUB(j)  (1280 + 64 * (j))
#define XB_XGEN(j)  (2304 + 64 * (j))
#define XB_TOP      3328
#define XB_TOPGEN   3392
#define XCD_BAR_WORDS 3456
#define XB_SPIN_CAP (1u << 18)

__device__ __forceinline__ unsigned xb_ld(unsigned* p)              { return __hip_atomic_load(p, __ATOMIC_RELAXED, __HIP_MEMORY_SCOPE_AGENT); }
__device__ __forceinline__ unsigned xb_add(unsigned* p, unsigned v) { return __hip_atomic_fetch_add(p, v, __ATOMIC_RELAXED, __HIP_MEMORY_SCOPE_AGENT); }
__device__ __forceinline__ unsigned xb_xcc_id() { return (unsigned)__builtin_amdgcn_s_getreg((3 << 11) | 20) & 0xFu; }
#define XB_SPIN(cond, bar) do { unsigned _sp = 0; while (cond) { __builtin_amdgcn_s_sleep(1); \
    if ((++_sp & 255u) == 0u) { if (xb_ld(&(bar)[XB_TMO])) break; if (_sp > XB_SPIN_CAP) { atomicAdd(&(bar)[XB_TMO], 1u); break; } } } } while (0)

struct XcdBarrier {
    unsigned* bar; unsigned x;
    volatile LAS unsigned* st;
};

__device__ __forceinline__ XcdBarrier xcd_barrier_post(unsigned* bar, volatile LAS unsigned* st) {
    XcdBarrier b; b.bar = bar; b.x = xb_xcc_id(); b.st = st;
    if (threadIdx.x == 0) (void)xb_add(&bar[XB_XCNT(b.x)], 1u);
    return b;
}
__device__ __forceinline__ void xcd_barrier_complete(unsigned* bar, unsigned x, unsigned& nloc, unsigned& nx) {
    const unsigned G = gridDim.x * gridDim.y * gridDim.z;
    unsigned sum, cnt, mine, sp = 0u;
    for (;;) {
        sum = 0u; cnt = 0u; mine = 0u;
#pragma unroll
        for (unsigned j = 0; j < 16; ++j) { const unsigned c = xb_ld(&bar[XB_XCNT(j)]); sum += c; cnt += (c > 0u) ? 1u : 0u; mine = (j == x) ? c : mine; }
        if (sum == G) break;
        __builtin_amdgcn_s_sleep(1);
        if ((++sp & 255u) == 0u) { if (xb_ld(&bar[XB_TMO])) break; if (sp > XB_SPIN_CAP) { atomicAdd(&bar[XB_TMO], 1u); break; } }
    }
    nloc = mine > 0u ? mine : 1u; nx = cnt > 0u ? cnt : 1u;
}

__device__ __forceinline__ void xcd_barrier(const XcdBarrier& b) {
    asm volatile("s_waitcnt vmcnt(0)" ::: "memory");
    __syncthreads();
    if (threadIdx.x == 0) {
        unsigned* bar = b.bar;
        __builtin_amdgcn_s_waitcnt(0);
        unsigned nloc = b.st[0], nx = b.st[1];
        if (nloc == 0u) { xcd_barrier_complete(bar, b.x, nloc, nx); b.st[0] = nloc; b.st[1] = nx; }
        const unsigned old = xb_add(&bar[XB_XSUB(b.x)], 1u);
        const unsigned gen = old / nloc;
        if (old + 1u == (gen + 1u) * nloc) {
            __builtin_amdgcn_fence(__ATOMIC_RELEASE, "agent");
            asm volatile("s_waitcnt vmcnt(0)" ::: "memory");
            const unsigned og = xb_add(&bar[XB_TOP], 1u);
            const unsigned tg = og / nx;
            if (og + 1u == (tg + 1u) * nx) xb_add(&bar[XB_TOPGEN], 1u);
            else XB_SPIN(xb_ld(&bar[XB_TOPGEN]) == tg, bar);
            __builtin_amdgcn_fence(__ATOMIC_ACQUIRE, "agent");
            xb_add(&bar[XB_XGEN(b.x)], 1u);
            asm volatile("s_waitcnt vmcnt(0)" ::: "memory");
        } else {
            XB_SPIN(xb_ld(&bar[XB_XGEN(b.x)]) == gen, bar);
            __builtin_amdgcn_fence(__ATOMIC_ACQUIRE, "agent");
            asm volatile("s_waitcnt vmcnt(0)" ::: "memory");
        }
    }
    __syncthreads();
}

struct Args { const float* in[27]; float* out; unsigned char* ws; int lo, hi; };
struct Frame {
    LAS unsigned char* lds;
    volatile LAS unsigned* MISC;
    gu32* ctl;
    int tid, lane, wave, vcu, G;
    int gtid, GT, gw, NGW;
};
constexpr int NSTEPS = 37;
#define LAUNDER_S(x) asm volatile("" : "+s"(x))
#define LAUNDER_V(x) asm volatile("" : "+v"(x))
#define inp(a, K) inp_<(K)>(a)
template <int K> __device__ __forceinline__ const float* inp_(const Args& a) { unsigned long long v = (unsigned long long)a.in[K]; LAUNDER_S(v); return (const float*)(GAS const float*)v; }
__device__ __forceinline__ unsigned char* wsp(const Args& a) { unsigned long long v = (unsigned long long)a.ws; LAUNDER_S(v); return (unsigned char*)(GAS unsigned char*)v; }
__device__ __forceinline__ float* outp(const Args& a) { unsigned long long v = (unsigned long long)a.out; LAUNDER_S(v); return (float*)(GAS float*)v; }
__device__ __forceinline__ Frame refr(const Frame& F0) { Frame F = F0; int tid = F0.tid; LAUNDER_V(tid); int v = F0.vcu; LAUNDER_S(v); F.tid = tid; F.lane = tid & 63; F.wave = __builtin_amdgcn_readfirstlane(tid >> 6); F.vcu = v; int G = F0.G; LAUNDER_S(G); F.G = G; F.GT = G * NWAVES * 64; F.NGW = G * NWAVES;
    F.gtid = v * (NWAVES * 64) + tid; F.gw = v * NWAVES + F.wave; return F; }

__device__ __forceinline__ void tr_item(const float* W, int ldw, int K, int col0, bf16* WT, int row0, int nblk, LAS float* scr, int item, int lane, const float* kscale = nullptr) {
    const int kb = item / nblk, nb = item - kb * nblk, k0 = 64 * kb, n0 = 64 * nb; const int kq = lane >> 4, n4 = (lane & 15) * 4;
    f32x4 v[16];
#pragma unroll
    for (int i = 0; i < 16; ++i) v[i] = *(const f32x4*)(W + (size_t)(k0 + 4 * i + kq) * ldw + col0 + n0 + n4);
    if (kscale) {
#pragma unroll
        for (int i = 0; i < 16; ++i) v[i] = v[i] * kscale[k0 + 4 * i + kq]; }
#pragma unroll
    for (int i = 0; i < 16; ++i) { LAS float* d = scr + (4 * i + kq) * 65 + n4; d[0] = v[i].x; d[1] = v[i].y; d[2] = v[i].z; d[3] = v[i].w; }
    LDS_WAIT();
    const int c = lane & 7;
#pragma unroll
    for (int j = 0; j < 8; ++j) { const int n = (lane >> 3) + 8 * j; const LAS float* s = scr + (8 * c) * 65 + n;
        v4u o; o.x = pk2(s[0 * 65], s[1 * 65]); o.y = pk2(s[2 * 65], s[3 * 65]); o.z = pk2(s[4 * 65], s[5 * 65]); o.w = pk2(s[6 * 65], s[7 * 65]);
        *(v4u*)(WT + (size_t)(row0 + n0 + n) * K + k0 + 8 * c) = o; }
    LDS_WAIT();
}
__device__ __forceinline__ void tr_item8(const float* W, int ldw, int K, int col0, unsigned char* WT, int row0, int nblk, float sc, LAS float* scr, int item, int lane) {
    const int kb = item / nblk, nb = item - kb * nblk, k0 = 64 * kb, n0 = 64 * nb; const int kq = lane >> 4, n4 = (lane & 15) * 4;
    f32x4 v[16];
#pragma unroll
    for (int i = 0; i < 16; ++i) v[i] = *(const f32x4*)(W + (size_t)(k0 + 4 * i + kq) * ldw + col0 + n0 + n4);
#pragma unroll
    for (int i = 0; i < 16; ++i) { LAS float* d = scr + (4 * i + kq) * 65 + n4; const f32x4 c = __builtin_elementwise_min(__builtin_elementwise_max(v[i] * sc, (f32x4){-448.f, -448.f, -448.f, -448.f}), (f32x4){448.f, 448.f, 448.f, 448.f}); d[0] = c.x; d[1] = c.y; d[2] = c.z; d[3] = c.w; }
    LDS_WAIT();
    const int c = lane & 7;
#pragma unroll
    for (int j = 0; j < 8; ++j) { const int n = (lane >> 3) + 8 * j; const LAS float* s = scr + (8 * c) * 65 + n;
        unsigned w0 = __builtin_amdgcn_cvt_pk_fp8_f32(s[0 * 65], s[1 * 65], 0u, false); w0 = __builtin_amdgcn_cvt_pk_fp8_f32(s[2 * 65], s[3 * 65], w0, true);
        unsigned w1 = __builtin_amdgcn_cvt_pk_fp8_f32(s[4 * 65], s[5 * 65], 0u, false); w1 = __builtin_amdgcn_cvt_pk_fp8_f32(s[6 * 65], s[7 * 65], w1, true);
        v2u o; o.x = w0; o.y = w1; *(v2u*)(WT + (size_t)(row0 + n0 + n) * K + k0 + 8 * c) = o; }
    LDS_WAIT();
}
__device__ __forceinline__ float rms_row_load(const float* xrow, const float* w, int lane, f32x4 (&v)[8]) {
    const f32x4* xr = (const f32x4*)xrow + lane; float ss = 0.f;
#pragma unroll
    for (int j = 0; j < 8; ++j) { v[j] = xr[64 * j]; ss += (v[j].x * v[j].x + v[j].y * v[j].y) + (v[j].z * v[j].z + v[j].w * v[j].w); }
    const float rinv = 1.0f / sqrtf(wave_sum(ss) * (1.f / D) + NORM_EPS);
    const f32x4* wr = (const f32x4*)w + lane;
#pragma unroll
    for (int j = 0; j < 8; ++j) { const f32x4 ww = wr[64 * j]; v[j] = v[j] * rinv * ww; }
    return rinv;
}
__device__ __forceinline__ void store_row_bf16(bf16* orow, int lane, const f32x4 (&v)[8]) {
    v2u* o8 = (v2u*)orow + lane;
#pragma unroll
    for (int j = 0; j < 8; ++j) { v2u w; w.x = pk2(v[j].x, v[j].y); w.y = pk2(v[j].z, v[j].w); o8[64 * j] = w; }
}

__device__ __forceinline__ void phW(const Frame& F0, const Args& a, int l) {
    const Frame F = refr(F0);
    unsigned char* ws = wsp(a);
    LAS float* scr = (LAS float*)(F.lds + F.wave * 16640);
    if (F.gw < 512) { const int c = F.gw >> 8, j = ((F.gw >> 6) & 3) * 64 + F.lane, seg = F.gw & 63;
        const float* w1 = inp(a, 5) + (size_t)(l * 2 + c) * 4096 * 256 + (size_t)seg * 64 * 256; const float* pos = inp(a, 4) + (size_t)(l * 2 + c) * 4096 + seg * 64;
        float a0 = 0.f, a1 = 0.f, a2 = 0.f, a3 = 0.f;
#pragma unroll 4
        for (int i = 0; i < 64; i += 4) { a0 += pos[i] * w1[(size_t)i * 256 + j]; a1 += pos[i + 1] * w1[(size_t)(i + 1) * 256 + j]; a2 += pos[i + 2] * w1[(size_t)(i + 2) * 256 + j]; a3 += pos[i + 3] * w1[(size_t)(i + 3) * 256 + j]; }
        ((float*)(ws + WS_CBG))[(seg * 2 + c) * 256 + j] = (a0 + a1) + (a2 + a3); }
    if (l == 0) { float* cosA = (float*)(ws + WS_TAB); float* sinA = cosA + 4096 * 64; float* cosC = sinA + 4096 * 64; float* sinC = cosC + 4096 * 32;
        for (int idx = F.gtid; idx < 4096 * 96; idx += F.GT) { const int s = idx / 96, i = idx - s * 96;
            const bool isA = i < 64; const int ii = isA ? i : i - 64; const float dim = isA ? 128.f : 64.f;
            const float inv = 1.0f / powf(10000.0f, (float)(2 * ii) / dim); const float ang = (float)s * inv;
            double r = (double)ang * 0.15915494309189533577; r -= floor(r); const float a2 = (float)(r * 6.28318530717958647692);
            const float cv = __cosf(a2), sv = __sinf(a2);
            if (isA) { cosA[s * 64 + ii] = cv; sinA[s * 64 + ii] = sv; } else { cosC[s * 32 + ii] = cv; sinC[s * 32 + ii] = sv; } } }
    bf16* WIN = (bf16*)(ws + WS_WIN); bf16* W1T = (bf16*)(ws + WS_W1); bf16* PT = (bf16*)(ws + WS_PT); bf16* WOUT = (bf16*)(ws + WS_WOUT); bf16* GU = (bf16*)(ws + WS_GU); bf16* DN = (bf16*)(ws + WS_DN);
    const float* w_in = inp(a, 3) + (size_t)l * D * IN_DIM;
    constexpr int I_IN0 = 32 * 40, I_IN1 = 32 * 24, I_IN2 = 32 * 20, I_IN3 = 32 * 96, I_Z8 = 32 * 16, I_W1 = 64 * 4, I_P = 16 * 32, I_O = 32 * 32, I_GU = 32 * 512, I_DN = 32 * 256;
    constexpr int NITEMS = I_IN0 + I_IN1 + I_IN2 + I_IN3 + I_Z8 + 2 * I_W1 + 3 * I_P + I_O + I_GU + I_DN;
    for (int it = F.gw; it < NITEMS; it += F.NGW) {
        int r = it;
        if (r < I_IN0) { tr_item(w_in, IN_DIM, D, 0, WIN, 0, 40, scr, r, F.lane); continue; } r -= I_IN0;
        if (r < I_IN1) { tr_item(w_in, IN_DIM, D, 3608, WIN, 3584, 24, scr, r, F.lane); continue; } r -= I_IN1;
        if (r < I_IN2) { tr_item(w_in, IN_DIM, D, 5160, WIN, 5120, 20, scr, r, F.lane); continue; } r -= I_IN2;
        if (r < I_IN3) { tr_item8(w_in, IN_DIM, D, 6440, (unsigned char*)(ws + WS_WG8), 0, 96, 64.0f, scr, r, F.lane); continue; } r -= I_IN3;
        if (r < I_Z8) { tr_item8(w_in, IN_DIM, D, 2584, (unsigned char*)(ws + WS_WG8), 6144, 16, 64.0f, scr, r, F.lane); continue; } r -= I_Z8;
        if (r < 2 * I_W1) { const int c = r / I_W1; tr_item(inp(a, 5) + (size_t)(l * 2 + c) * 4096 * 256, 256, 4096, 0, W1T + (size_t)c * 256 * 4096, 0, 4, scr, r - c * I_W1, F.lane); continue; } r -= 2 * I_W1;
        if (r < 3 * I_P) { const int i = r / I_P; tr_item((i == 0 ? inp(a, 15) : (i == 1 ? inp(a, 16) : inp(a, 17))) + (size_t)l * 1024 * 2048, 2048, 1024, 0, PT + (size_t)i * 2048 * 1024, 0, 32, scr, r - i * I_P, F.lane); continue; } r -= 3 * I_P;
        if (r < I_O) { tr_item(inp(a, 18) + (size_t)l * 2048 * 2048, 2048, 2048, 0, WOUT, 0, 32, scr, r, F.lane); continue; } r -= I_O;
        if (r < I_GU) { const int e = r >> 9, rr = r & 511, which = rr >> 8, t = (rr >> 6) & 3, i2 = rr & 63;
            tr_item((which == 0 ? inp(a, 23) : inp(a, 24)) + (size_t)(l * 32 + e) * 2048 * 512, 512, 2048, t * 128, GU + (size_t)e * 1024 * 2048, t * 256 + which * 128, 2, scr, i2, F.lane, inp(a, 2) + (size_t)l * D); continue; } r -= I_GU;
        { const int e = r >> 8, i2 = r & 255; tr_item(inp(a, 25) + (size_t)(l * 32 + e) * 512 * 2048, 2048, 512, 0, DN + (size_t)e * 2048 * 512, 0, 32, scr, i2, F.lane); }
    }
    { bf16* WRh = (bf16*)(ws + WS_WR); bf16* WRl = WRh + 64 * 2048; const float* nwf = inp(a, 2) + (size_t)l * D; const float* gr = inp(a, 19) + (size_t)l * D * 4; const float* er = inp(a, 21) + (size_t)l * D * 32;
      for (int idx = F.gtid; idx < 64 * 2048; idx += F.GT) { const int c = idx >> 11, k = idx & 2047; float v = 0.f; if (c < 4) v = nwf[k] * gr[(size_t)k * 4 + c]; else if (c < 36) v = nwf[k] * er[(size_t)k * 32 + (c - 4)];
          const unsigned hi = f2bf(v); const float rem = v - __uint_as_float(hi << 16); WRh[idx] = (bf16)hi; WRl[idx] = (bf16)f2bf(rem); } }
    { bf16* W2T = (bf16*)(ws + WS_W2T); const float* w2 = inp(a, 7) + (size_t)l * 2 * 256 * 128;
      for (int idx = F.gtid; idx < 2 * 128 * 256; idx += F.GT) { const int i = idx & 255, d = (idx >> 8) & 127, c = idx >> 15; W2T[idx] = (bf16)f2bf(w2[(size_t)(c * 256 + i) * 128 + d]); } }
    for (int idx = F.gtid; idx < 256 * 256; idx += F.GT) { const int n = idx >> 8, k8 = idx & 255; const int src = n < 24 ? 2560 + n : (n < 40 ? 5144 + (n - 24) : -1);
        float f[8];
#pragma unroll
        for (int j = 0; j < 8; ++j) f[j] = src >= 0 ? w_in[(size_t)(k8 * 8 + j) * IN_DIM + src] : 0.f;
        v4u o; o.x = pk2(f[0], f[1]); o.y = pk2(f[2], f[3]); o.z = pk2(f[4], f[5]); o.w = pk2(f[6], f[7]);
        *(v4u*)(WIN + (size_t)(6400 + n) * D + k8 * 8) = o; }
}

__device__ __forceinline__ void moe_tables(const Frame& F0, int ly) {
    const Frame F = refr(F0);
    LAS int* tab = (LAS int*)(F.lds + MOETAB_OFF); gu32* cnt = F.ctl + CW_ECNT + ly * 32 * 64;
    __syncthreads();
    if (F.tid < 32) tab[64 + F.tid] = (int)__hip_atomic_load(cnt + F.tid * 64, RLX_AGENT);
    __syncthreads();
    if (F.tid == 0) { int o = 0; for (int e = 0; e < 32; ++e) { tab[e] = o; o += (tab[64 + e] + 255) & ~255; } tab[32] = o; tab[128] = o >> 8; }
    __syncthreads();
    for (int p = F.tid; p < (tab[32] >> 8); p += NWAVES * 64) { int e = 0; for (int q = 1; q < 32; ++q) if (p * 256 >= tab[q]) e = q; tab[192 + p] = e; }
    __syncthreads();
}
__device__ __forceinline__ void phA(const Frame& F0, const Args& a, int l) {
    const Frame F = refr(F0);
    unsigned char* ws = wsp(a); const float* xin = inp(a, 0); bf16* XB = (bf16*)(ws + WS_XB); const float* w = inp(a, 1) + l * D;
    const unsigned* ROUTE = (const unsigned*)(ws + WS_ROUTE); const bf16* YG = (const bf16*)(ws + WS_XG); const LAS int* tab = (const LAS int*)(F.lds + MOETAB_OFF);
    if (l > 0) moe_tables(F, l - 1);
    for (int m = F.gw; m < T; m += F.NGW) { f32x4 v[8];
        if (l == 0) { const f32x4* xr = (const f32x4*)(xin + (size_t)m * D) + F.lane;
#pragma unroll
            for (int j = 0; j < 8; ++j) v[j] = xr[64 * j]; }
        else { const v4u rr = *(const v4u*)(ROUTE + (size_t)m * 8); const unsigned s0 = tab[rr.x] + rr.z, s1 = tab[rr.y] + rr.w; const v2u* y0 = (const v2u*)(YG + (size_t)s0 * D) + F.lane; const v2u* y1 = (const v2u*)(YG + (size_t)s1 * D) + F.lane;
            v2u* xw = (v2u*)(XB + (size_t)m * D) + F.lane; v2u xv[8];
#pragma unroll
            for (int j = 0; j < 8; ++j) xv[j] = xw[64 * j];
#pragma unroll
            for (int j = 0; j < 8; ++j) { const v2u a0 = y0[64 * j], a1 = y1[64 * j]; v[j].x = blo(xv[j].x) + (blo(a0.x) + blo(a1.x)); v[j].y = bhi(xv[j].x) + (bhi(a0.x) + bhi(a1.x)); v[j].z = blo(xv[j].y) + (blo(a0.y) + blo(a1.y)); v[j].w = bhi(xv[j].y) + (bhi(a0.y) + bhi(a1.y));
                v2u o; o.x = pk2(v[j].x, v[j].y); o.y = pk2(v[j].z, v[j].w); xw[64 * j] = o; } }
        float ss = 0.f;
#pragma unroll
        for (int j = 0; j < 8; ++j) ss += (v[j].x * v[j].x + v[j].y * v[j].y) + (v[j].z * v[j].z + v[j].w * v[j].w);
        const float rinv = 1.0f / sqrtf(wave_sum(ss) * (1.f / D) + NORM_EPS); const f32x4* wr = (const f32x4*)w + F.lane;
#pragma unroll
        for (int j = 0; j < 8; ++j) { const f32x4 ww = wr[64 * j]; v[j] = v[j] * rinv * ww; }
        bf16* HN = (bf16*)(ws + (m < TH ? WS_HN : WS_HN1)); store_row_bf16(HN + (size_t)(m < TH ? m : m - TH) * D, F.lane, v);
        unsigned* h8 = (unsigned*)(ws + WS_HN8 + (size_t)m * D) + F.lane;
#pragma unroll
        for (int j = 0; j < 8; ++j) { const f32x4 c = __builtin_elementwise_min(__builtin_elementwise_max(v[j] * 16.f, (f32x4){-448.f, -448.f, -448.f, -448.f}), (f32x4){448.f, 448.f, 448.f, 448.f});
            unsigned w = __builtin_amdgcn_cvt_pk_fp8_f32(c.x, c.y, 0u, false); w = __builtin_amdgcn_cvt_pk_fp8_f32(c.z, c.w, w, true); h8[64 * j] = w; } }
}
__device__ __forceinline__ void ph_bias(const Frame& F0, const Args& a, int l) {
    const Frame F = refr(F0);
    if (F.vcu == 0) { unsigned char* ws = wsp(a); const float* part = (const float*)(ws + WS_CBG); float acc = inp(a, 6)[l * 512 + F.tid];
#pragma unroll 8
        for (int seg = 0; seg < 64; ++seg) acc += part[seg * 512 + F.tid];
        ((float*)(ws + WS_B1P))[F.tid] = acc; }
}
__device__ __forceinline__ void phFinal(const Frame& F0, const Args& a) {
    const Frame F = refr(F0);
    unsigned char* ws = wsp(a); float* xo = outp(a); const bf16* XB = (const bf16*)(ws + WS_XB); const float* w = inp(a, 26); const unsigned* ROUTE = (const unsigned*)(ws + WS_ROUTE); const bf16* YG = (const bf16*)(ws + WS_XG); const LAS int* tab = (const LAS int*)(F.lds + MOETAB_OFF);
    moe_tables(F, 1);
    for (int m = F.gw; m < T; m += F.NGW) { f32x4 v[8]; f32x4* xr = (f32x4*)(xo + (size_t)m * D) + F.lane; const v2u* xb = (const v2u*)(XB + (size_t)m * D) + F.lane;
        const v4u rr = *(const v4u*)(ROUTE + (size_t)m * 8); const unsigned s0 = tab[rr.x] + rr.z, s1 = tab[rr.y] + rr.w; const v2u* y0 = (const v2u*)(YG + (size_t)s0 * D) + F.lane; const v2u* y1 = (const v2u*)(YG + (size_t)s1 * D) + F.lane;
        float ss = 0.f;
#pragma unroll
        for (int j = 0; j < 8; ++j) { const v2u xv = xb[64 * j]; const v2u a0 = y0[64 * j], a1 = y1[64 * j]; v[j].x = blo(xv.x) + (blo(a0.x) + blo(a1.x)); v[j].y = bhi(xv.x) + (bhi(a0.x) + bhi(a1.x)); v[j].z = blo(xv.y) + (blo(a0.y) + blo(a1.y)); v[j].w = bhi(xv.y) + (bhi(a0.y) + bhi(a1.y));
            ss += (v[j].x * v[j].x + v[j].y * v[j].y) + (v[j].z * v[j].z + v[j].w * v[j].w); }
        const float rinv = 1.0f / sqrtf(wave_sum(ss) * (1.f / D) + NORM_EPS); const f32x4* wr = (const f32x4*)w + F.lane;
#pragma unroll
        for (int j = 0; j < 8; ++j) { const f32x4 ww = wr[64 * j]; xr[64 * j] = v[j] * rinv * ww; } }
}
__device__ __forceinline__ void rope_pair(bf16* p1, bf16* p2, bf16* o1, bf16* o2, float c, float s) { const float x1 = bf2f(*p1), x2 = bf2f(*p2); *o1 = (bf16)f2bf(x1 * c - x2 * s); *o2 = (bf16)f2bf(x2 * c + x1 * s); }
__device__ __forceinline__ void phC_elem(const Frame& F0, const Args& a, int l, bool split) {
    const Frame F = refr(F0);
    const int vb = split ? F.vcu - 64 : F.vcu, nb = split ? F.G - 64 : F.G; const int gtid = vb * 512 + F.tid, GT = nb * 512, gw = vb * 8 + F.wave, NGW = nb * 8;
    unsigned char* ws = wsp(a); bf16* U = (bf16*)(ws + WS_U); bf16* XC = (bf16*)(ws + WS_XC); const float* SM = (const float*)(ws + WS_SM);
    const float* cosA = (const float*)(ws + WS_TAB); const float* sinA = cosA + 4096 * 64; const float* cosC = sinA + 4096 * 64; const float* sinC = cosC + 4096 * 32;
#pragma unroll 2
    for (int idx = gtid; idx < TH * 40; idx += GT) { const int tok = idx / 40, it = idx - tok * 40, s = tok & 4095; bf16* ur = U + (size_t)tok * UP;
        if (it < 32) { const int blk = it >> 3, i8 = (it & 7) * 8; bf16* p = ur + (blk < 2 ? 1536 + blk * 128 : 2048 + (blk - 2) * 128) + i8;
            const v4u x1 = *(const v4u*)p, x2 = *(const v4u*)(p + 64); const f32x4 c0 = *(const f32x4*)(cosA + s * 64 + i8), c1 = *(const f32x4*)(cosA + s * 64 + i8 + 4), s0 = *(const f32x4*)(sinA + s * 64 + i8), s1 = *(const f32x4*)(sinA + s * 64 + i8 + 4);
            v4u o1, o2;
            o1.x = pk2(blo(x1.x) * c0.x - blo(x2.x) * s0.x, bhi(x1.x) * c0.y - bhi(x2.x) * s0.y); o2.x = pk2(blo(x2.x) * c0.x + blo(x1.x) * s0.x, bhi(x2.x) * c0.y + bhi(x1.x) * s0.y);
            o1.y = pk2(blo(x1.y) * c0.z - blo(x2.y) * s0.z, bhi(x1.y) * c0.w - bhi(x2.y) * s0.w); o2.y = pk2(blo(x2.y) * c0.z + blo(x1.y) * s0.z, bhi(x2.y) * c0.w + bhi(x1.y) * s0.w);
            o1.z = pk2(blo(x1.z) * c1.x - blo(x2.z) * s1.x, bhi(x1.z) * c1.y - bhi(x2.z) * s1.y); o2.z = pk2(blo(x2.z) * c1.x + blo(x1.z) * s1.x, bhi(x2.z) * c1.y + bhi(x1.z) * s1.y);
            o1.w = pk2(blo(x1.w) * c1.z - blo(x2.w) * s1.z, bhi(x1.w) * c1.w - bhi(x2.w) * s1.w); o2.w = pk2(blo(x2.w) * c1.z + blo(x1.w) * s1.z, bhi(x2.w) * c1.w + bhi(x1.w) * s1.w);
            *(v4u*)p = o1; *(v4u*)(p + 64) = o2; }
        else { const int q = it - 32, g = q >> 2, i8 = (q & 3) * 8; bf16* p = ur + UC_SKV + g * 64 + i8;
            const v4u x1 = *(const v4u*)p, x2 = *(const v4u*)(p + 32); const f32x4 c0 = *(const f32x4*)(cosC + s * 32 + i8), c1 = *(const f32x4*)(cosC + s * 32 + i8 + 4), s0 = *(const f32x4*)(sinC + s * 32 + i8), s1 = *(const f32x4*)(sinC + s * 32 + i8 + 4);
            v4u o1, o2;
            o1.x = pk2(blo(x1.x) * c0.x - blo(x2.x) * s0.x, bhi(x1.x) * c0.y - bhi(x2.x) * s0.y); o2.x = pk2(blo(x2.x) * c0.x + blo(x1.x) * s0.x, bhi(x2.x) * c0.y + bhi(x1.x) * s0.y);
            o1.y = pk2(blo(x1.y) * c0.z - blo(x2.y) * s0.z, bhi(x1.y) * c0.w - bhi(x2.y) * s0.w); o2.y = pk2(blo(x2.y) * c0.z + blo(x1.y) * s0.z, bhi(x2.y) * c0.w + bhi(x1.y) * s0.w);
            o1.z = pk2(blo(x1.z) * c1.x - blo(x2.z) * s1.x, bhi(x1.z) * c1.y - bhi(x2.z) * s1.y); o2.z = pk2(blo(x2.z) * c1.x + blo(x1.z) * s1.x, bhi(x2.z) * c1.y + bhi(x1.z) * s1.y);
            o1.w = pk2(blo(x1.w) * c1.z - blo(x2.w) * s1.z, bhi(x1.w) * c1.w - bhi(x2.w) * s1.w); o2.w = pk2(blo(x2.w) * c1.z + blo(x1.w) * s1.z, bhi(x2.w) * c1.w + bhi(x1.w) * s1.w);
            *(v4u*)p = o1; *(v4u*)(p + 32) = o2; } }
    const float* cw = inp(a, 8) + (size_t)l * 4 * 1536; const float* cb = inp(a, 9) + (size_t)l * 1536;
#pragma unroll 2
    for (int idx = gtid; idx < (TH / 4) * 192; idx += GT) { const int t4 = idx / 192, c8 = (idx - t4 * 192) * 8, tok = t4 * 4, s = tok & 4095;
        float w[4][8], bias[8];
#pragma unroll
        for (int k = 0; k < 4; ++k) { const f32x4 a0 = *(const f32x4*)(cw + k * 1536 + c8), a1 = *(const f32x4*)(cw + k * 1536 + c8 + 4); w[k][0] = a0.x; w[k][1] = a0.y; w[k][2] = a0.z; w[k][3] = a0.w; w[k][4] = a1.x; w[k][5] = a1.y; w[k][6] = a1.z; w[k][7] = a1.w; }
        { const f32x4 a0 = *(const f32x4*)(cb + c8), a1 = *(const f32x4*)(cb + c8 + 4); bias[0] = a0.x; bias[1] = a0.y; bias[2] = a0.z; bias[3] = a0.w; bias[4] = a1.x; bias[5] = a1.y; bias[6] = a1.z; bias[7] = a1.w; }
        float acc[4][8];
#pragma unroll
        for (int t = 0; t < 4; ++t)
#pragma unroll
            for (int e = 0; e < 8; ++e) acc[t][e] = bias[e];
#pragma unroll
        for (int r = 0; r < 7; ++r) { const int sp = s - 3 + r; v4u x = (v4u){0u, 0u, 0u, 0u}; if (sp >= 0) x = *(const v4u*)(U + (size_t)(tok - 3 + r) * UP + UC_XBC + c8);
            const float xf[8] = {blo(x.x), bhi(x.x), blo(x.y), bhi(x.y), blo(x.z), bhi(x.z), blo(x.w), bhi(x.w)};
#pragma unroll
            for (int t = 0; t < 4; ++t) { const int k = r - t; if (k >= 0 && k < 4) {
#pragma unroll
                for (int e = 0; e < 8; ++e) acc[t][e] += w[k][e] * xf[e]; } } }
#pragma unroll
        for (int t = 0; t < 4; ++t) { v4u o; o.x = pk2(acc[t][0] * sigmf(acc[t][0]), acc[t][1] * sigmf(acc[t][1])); o.y = pk2(acc[t][2] * sigmf(acc[t][2]), acc[t][3] * sigmf(acc[t][3]));
            o.z = pk2(acc[t][4] * sigmf(acc[t][4]), acc[t][5] * sigmf(acc[t][5])); o.w = pk2(acc[t][6] * sigmf(acc[t][6]), acc[t][7] * sigmf(acc[t][7])); *(v4u*)(XC + (size_t)(tok + t) * 1536 + c8) = o; } }
    float* DTV = (float*)(ws + WS_DTV); float* ACS = (float*)(ws + WS_ACS);
    for (int it = gw; it < HBN * 32 * 16; it += NGW) { const int b = it >> 9, c = (it >> 4) & 31, h = it & 15; const int tok0 = b * 4096 + c * 128 + 2 * F.lane;
        const float bias = inp(a, 10)[l * 16 + h], A = -__expf(inp(a, 11)[l * 16 + h]);
        const float r0 = SM[(size_t)tok0 * 64 + 24 + h] + bias, r1 = SM[(size_t)(tok0 + 1) * 64 + 24 + h] + bias;
        const float d0 = fmaxf(r0, 0.f) + log1pf(__expf(-fabsf(r0))), d1 = fmaxf(r1, 0.f) + log1pf(__expf(-fabsf(r1)));
        const float a0 = d0 * A, a1 = d1 * A; float x = a0 + a1;
#pragma unroll
        for (int o = 1; o < 64; o <<= 1) { const float t = __shfl_up(x, o); if (F.lane >= o) x += t; }
        DTV[(size_t)tok0 * 16 + h] = d0; DTV[(size_t)(tok0 + 1) * 16 + h] = d1; ACS[(size_t)tok0 * 16 + h] = x - a1; ACS[(size_t)(tok0 + 1) * 16 + h] = x; }
}


namespace fa {
typedef float f32x16 __attribute__((ext_vector_type(16)));
typedef short bf16x8 __attribute__((ext_vector_type(8)));
typedef short s16x4 __attribute__((ext_vector_type(4)));
typedef float f32x2_t __attribute__((ext_vector_type(2)));
typedef __bf16 bf16x2_t __attribute__((ext_vector_type(2)));
#define FA_MFMA(a, b, c) __builtin_amdgcn_mfma_f32_32x32x16_bf16((a), (b), (c), 0, 0, 0)
__device__ __forceinline__ unsigned cvtpk(float lo, float hi) { f32x2_t v = {lo, hi}; bf16x2_t b = __builtin_convertvector(v, bf16x2_t); return __builtin_bit_cast(unsigned, b); }
__device__ __forceinline__ float xhalf_max(float x) { const auto r = __builtin_amdgcn_permlane32_swap(__float_as_uint(x), __float_as_uint(x), false, false); return fmaxf(__uint_as_float(r[0]), __uint_as_float(r[1])); }
__device__ __forceinline__ float xhalf_sum(float x) { const auto r = __builtin_amdgcn_permlane32_swap(__float_as_uint(x), __float_as_uint(x), false, false); return __uint_as_float(r[0]) + __uint_as_float(r[1]); }
__device__ __forceinline__ float quad_sum(float x) { x += __builtin_bit_cast(float, __builtin_amdgcn_mov_dpp(__builtin_bit_cast(int, x), 0xB1, 0xF, 0xF, true)); x += __builtin_bit_cast(float, __builtin_amdgcn_mov_dpp(__builtin_bit_cast(int, x), 0x4E, 0xF, 0xF, true)); return x; }
__device__ __forceinline__ int crow(int reg, int h) { return (reg & 3) + 8 * (reg >> 2) + 4 * h; }
constexpr int VP = 144;
template <int DH> struct Geo { static constexpr int KP = DH * 2 + 16, KBYTES = 64 * KP, VBYTES = DH * VP, BUF = KBYTES + VBYTES, NCH = DH / 64  ; };

template <int DH> struct Stage { v4u k[Geo<DH>::NCH], v[Geo<DH>::NCH]; };
template <int DH>
__device__ __forceinline__ void tile_load(Stage<DH>& st, const bf16* Kb, int kpitch, const bf16* VTb, int vtpitch, int key0, int tid) {
#pragma unroll
    for (int i = 0; i < Geo<DH>::NCH; ++i) { const int c = tid + i * 512; const int row = c / (DH / 8), col8 = c % (DH / 8); st.k[i] = *(const v4u*)(Kb + (size_t)(key0 + row) * kpitch + col8 * 8);
        const int d = c >> 3, k8 = c & 7; st.v[i] = *(const v4u*)(VTb + (size_t)d * vtpitch + key0 + k8 * 8); }
}
template <int DH>
__device__ __forceinline__ void tile_store(const Stage<DH>& st, LAS unsigned char* buf, int tid) {
#pragma unroll
    for (int i = 0; i < Geo<DH>::NCH; ++i) { const int c = tid + i * 512; const int row = c / (DH / 8), col8 = c % (DH / 8); *(LAS v4u*)(buf + row * Geo<DH>::KP + col8 * 16) = st.k[i];
        const int d = c >> 3, k8 = c & 7; *(LAS v4u*)(buf + Geo<DH>::KBYTES + d * VP + k8 * 16) = st.v[i]; }
}
template <int DH>
__device__ __forceinline__ void qk_tile(const LAS unsigned char* buf, const bf16x8 (&qf)[DH / 16], int r32, int h, f32x16& s0, f32x16& s1) {
#pragma unroll
    for (int i = 0; i < 16; ++i) { s0[i] = 0.f; s1[i] = 0.f; }
    const LAS unsigned char* p0 = buf + r32 * Geo<DH>::KP + 16 * h; const LAS unsigned char* p1 = p0 + 32 * Geo<DH>::KP;
    constexpr int NG = DH / 32;
    bf16x8 a[2][2], b[2][2];
#pragma unroll
    for (int q = 0; q < 2; ++q) { a[0][q] = *(const LAS bf16x8*)(p0 + 32 * q); b[0][q] = *(const LAS bf16x8*)(p1 + 32 * q); }
    __builtin_amdgcn_sched_barrier(0);
#pragma unroll
    for (int g = 0; g < NG; ++g) {
        if (g + 1 < NG) {
#pragma unroll
            for (int q = 0; q < 2; ++q) { a[(g + 1) & 1][q] = *(const LAS bf16x8*)(p0 + 32 * (2 * (g + 1) + q)); b[(g + 1) & 1][q] = *(const LAS bf16x8*)(p1 + 32 * (2 * (g + 1) + q)); } }
        __builtin_amdgcn_sched_barrier(0);
#pragma unroll
        for (int q = 0; q < 2; ++q) { s0 = FA_MFMA(a[g & 1][q], qf[2 * g + q], s0); s1 = FA_MFMA(b[g & 1][q], qf[2 * g + q], s1); }
        __builtin_amdgcn_sched_barrier(0); }
}
template <int DH>
__device__ __forceinline__ void pv_tile(const LAS unsigned char* buf, const bf16x8 (&pf)[2][2], int r32, int h, f32x16 (&ot)[DH / 32]) {
    constexpr int NB = DH / 32; const LAS unsigned char* vb = buf + Geo<DH>::KBYTES + r32 * VP + 16 * h;
    bf16x8 a[2][NB];
#pragma unroll
    for (int db = 0; db < NB; ++db) a[0][db] = *(const LAS bf16x8*)(vb + 32 * db * VP);
    __builtin_amdgcn_sched_barrier(0);
#pragma unroll
    for (int t = 0; t < 4; ++t) {
        if (t < 3) {
#pragma unroll
            for (int db = 0; db < NB; ++db) a[(t + 1) & 1][db] = *(const LAS bf16x8*)(vb + 32 * db * VP + 32 * (t + 1)); }
        __builtin_amdgcn_sched_barrier(0);
#pragma unroll
        for (int db = 0; db < NB; ++db) ot[db] = FA_MFMA(a[t & 1][db], pf[t >> 1][t & 1], ot[db]);
        __builtin_amdgcn_sched_barrier(0); }
}
__device__ __forceinline__ void pack_p(const f32x16& p, bf16x8 (&pf)[2]) {
#pragma unroll
    for (int s = 0; s < 2; ++s) { v4u w; w.x = cvtpk(p[8 * s], p[8 * s + 1]); w.y = cvtpk(p[8 * s + 2], p[8 * s + 3]); w.z = cvtpk(p[8 * s + 4], p[8 * s + 5]); w.w = cvtpk(p[8 * s + 6], p[8 * s + 7]); pf[s] = __builtin_bit_cast(bf16x8, w); }
}
template <int DH>
__device__ __forceinline__ void load_qf(const bf16* qrow, int h, float sc, bf16x8 (&qf)[DH / 16]) {
#pragma unroll
    for (int ks = 0; ks < DH / 16; ++ks) { const v4u w = *(const v4u*)(qrow + 16 * ks + 8 * h); v4u o;
        o.x = cvtpk(blo(w.x) * sc, bhi(w.x) * sc); o.y = cvtpk(blo(w.y) * sc, bhi(w.y) * sc); o.z = cvtpk(blo(w.z) * sc, bhi(w.z) * sc); o.w = cvtpk(blo(w.w) * sc, bhi(w.w) * sc); qf[ks] = __builtin_bit_cast(bf16x8, o); }
}
template <int DH>
__device__ __forceinline__ void load_qf_rope(const bf16* qrow, int h, float sc, const float* cs, const float* sn, bf16x8 (&qf)[DH / 16]) {
#pragma unroll
    for (int ks = 0; ks < DH / 32; ++ks) { const int i0 = 16 * ks + 8 * h; const v4u a = *(const v4u*)(qrow + i0), b = *(const v4u*)(qrow + DH / 2 + i0);
        const f32x4 c0 = *(const f32x4*)(cs + i0), c1 = *(const f32x4*)(cs + i0 + 4), s0 = *(const f32x4*)(sn + i0), s1 = *(const f32x4*)(sn + i0 + 4);
        const float x1[8] = {blo(a.x), bhi(a.x), blo(a.y), bhi(a.y), blo(a.z), bhi(a.z), blo(a.w), bhi(a.w)}, x2[8] = {blo(b.x), bhi(b.x), blo(b.y), bhi(b.y), blo(b.z), bhi(b.z), blo(b.w), bhi(b.w)};
        const float c[8] = {c0.x, c0.y, c0.z, c0.w, c1.x, c1.y, c1.z, c1.w}, s[8] = {s0.x, s0.y, s0.z, s0.w, s1.x, s1.y, s1.z, s1.w};
        float y1[8], y2[8];
#pragma unroll
        for (int e = 0; e < 8; ++e) { y1[e] = (x1[e] * c[e] - x2[e] * s[e]) * sc; y2[e] = (x2[e] * c[e] + x1[e] * s[e]) * sc; }
        v4u o1, o2; o1.x = cvtpk(y1[0], y1[1]); o1.y = cvtpk(y1[2], y1[3]); o1.z = cvtpk(y1[4], y1[5]); o1.w = cvtpk(y1[6], y1[7]); o2.x = cvtpk(y2[0], y2[1]); o2.y = cvtpk(y2[2], y2[3]); o2.z = cvtpk(y2[4], y2[5]); o2.w = cvtpk(y2[6], y2[7]);
        qf[ks] = __builtin_bit_cast(bf16x8, o1); qf[ks + DH / 32] = __builtin_bit_cast(bf16x8, o2); }
}
template <int DH, class V>
__device__ __forceinline__ void softmax_step(f32x16& s0, f32x16& s1, int h, bool laneoff, bool domask, const V& valid, float& m, float& l, f32x16 (&ot)[DH / 32], bf16x8 (&pf)[2][2]) {
    if (domask) {
#pragma unroll
        for (int i = 0; i < 16; ++i) { if (!valid(crow(i, h))) s0[i] = -3e38f; if (!valid(32 + crow(i, h))) s1[i] = -3e38f; } }
    float mx = fmaxf(s0[0], s1[0]);
#pragma unroll
    for (int i = 1; i < 16; ++i) mx = fmaxf(mx, fmaxf(s0[i], s1[i]));
    mx = xhalf_max(mx);
    const float mn = (!laneoff && mx > m + 8.0f) ? mx : m; const float al = __builtin_amdgcn_exp2f(m - mn); m = mn;
    const float mb = laneoff ? 3e38f : mn;
    f32x2_t sum2 = {0.f, 0.f}; const f32x2_t mb2 = {mb, mb};
#pragma unroll
    for (int i = 0; i < 16; i += 2) { const f32x2_t d0 = (f32x2_t){s0[i], s0[i + 1]} - mb2, d1 = (f32x2_t){s1[i], s1[i + 1]} - mb2;
        f32x2_t p0, p1; p0.x = __builtin_amdgcn_exp2f(d0.x); p0.y = __builtin_amdgcn_exp2f(d0.y); p1.x = __builtin_amdgcn_exp2f(d1.x); p1.y = __builtin_amdgcn_exp2f(d1.y);
        s0[i] = p0.x; s0[i + 1] = p0.y; s1[i] = p1.x; s1[i + 1] = p1.y; sum2 += p0; sum2 += p1; }
    l = l * al + (sum2.x + sum2.y);
    if (__any(al != 1.0f)) {
#pragma unroll
        for (int db = 0; db < DH / 32; ++db)
#pragma unroll
            for (int i = 0; i < 16; ++i) ot[db][i] *= al; }
    pack_p(s0, pf[0]); pack_p(s1, pf[1]);
}
}

template <int DH, class MaskF>
__device__ __forceinline__ void fa_unit(LAS unsigned char* lds, int tid, const bf16* Kb, int kpitch, const bf16* VTb, int vtpitch, int jt0, int jt1,
                                        const bf16* qrow, float qscale, const float* rcs, const float* rsn, const MaskF& mf, float& m, float& l, fa::f32x16 (&ot)[DH / 32]) {
    const int lane = tid & 63, r32 = lane & 31, h = lane >> 5;
    fa::bf16x8 qf[DH / 16]; fa::load_qf_rope<DH>(qrow, h, qscale, rcs, rsn, qf);
    fa::Stage<DH> st; fa::tile_load<DH>(st, Kb, kpitch, VTb, vtpitch, jt0 * 64, tid);
    for (int j = jt0; j <= jt1; ++j) {
        LAS unsigned char* buf = lds + ((j - jt0) & 1) * fa::Geo<DH>::BUF;
        fa::tile_store<DH>(st, buf, tid);
        __syncthreads();
        if (j < jt1) fa::tile_load<DH>(st, Kb, kpitch, VTb, vtpitch, (j + 1) * 64, tid);
        if (!mf.skip(j)) {
            fa::f32x16 s0, s1; fa::qk_tile<DH>(buf, qf, r32, h, s0, s1);
            fa::bf16x8 pf[2][2];
            fa::softmax_step<DH>(s0, s1, h, mf.laneoff(j), mf.domask(j), [&](int kl) { return mf.valid(j, kl); }, m, l, ot, pf);
            fa::pv_tile<DH>(buf, pf, r32, h, ot);
        }
    }
    __syncthreads();
}
struct BandMask {
    int sq, sq0, W;
    __device__ __forceinline__ bool skip(int j) const { return 64 * j > sq0 + 31 || 64 * j + 63 + W <= sq0; }
    __device__ __forceinline__ bool laneoff(int) const { return false; }
    __device__ __forceinline__ bool domask(int j) const { return !(64 * j + 63 <= sq0 && 64 * j + W > sq0 + 31); }
    __device__ __forceinline__ bool valid(int j, int kl) const { const int key = 64 * j + kl; return key <= sq && key + W > sq; }
};
struct SlcMask {
    int sq, sq0; unsigned mlo, mhi;
    __device__ __forceinline__ bool sel(int j) const { return ((j < 32 ? (mlo >> j) : (mhi >> (j - 32))) & 1u) != 0u; }
    __device__ __forceinline__ bool skip(int j) const { return __ballot(sel(j)) == 0ull; }
    __device__ __forceinline__ bool laneoff(int j) const { return !sel(j); }
    __device__ __forceinline__ bool domask(int j) const { return 64 * j + 63 > sq0; }
    __device__ __forceinline__ bool valid(int j, int kl) const { return 64 * j + kl <= sq; }
};
constexpr float LOG2E = 1.4426950408889634f;
__device__ __forceinline__ bool unit_map(const Frame& F, int i, int nqt, bool zig, int& bg, int& qt) {
    if (F.G == 256) { if (32 * i >= nqt) return false; bg = F.vcu >> 5; const int q = F.vcu & 31; qt = 32 * i + ((zig && (i & 1)) ? 31 - q : q); return true; }
    const int u = i * F.G + F.vcu; if (u >= 8 * nqt) return false; bg = u & 7; qt = u >> 3; return true;
}

__device__ __forceinline__ void ph_win_mfma(const Frame& F0, const Args& a) {
    const Frame F = refr(F0);
    unsigned char* ws = wsp(a); const bf16* U = (const bf16*)(ws + WS_U); bf16* OA = (bf16*)(ws + WS_OA); const float* SM = (const float*)(ws + WS_SM); const bf16* VT = (const bf16*)(ws + WS_VTW); const float* cosA = (const float*)(ws + WS_TAB); const float* sinA = cosA + 4096 * 64;
    const int r32 = F.lane & 31, h = F.lane >> 5, r = F.wave >> 1, toff = (F.wave & 1) * 32 + r32;
    for (int ui = 0;; ++ui) { int bg, qt; if (!unit_map(F, ui, 64, false, bg, qt)) break; const int b = bg >> 1, g = bg & 1; const int sq = qt * 64 + toff, tok = b * 4096 + sq;
        float m = -1e30f, l = 0.f; fa::f32x16 ot[4];
#pragma unroll
        for (int db = 0; db < 4; ++db)
#pragma unroll
            for (int i = 0; i < 16; ++i) ot[db][i] = 0.f;
        const BandMask mf{sq, qt * 64 + (F.wave & 1) * 32, 512};
        fa_unit<128, BandMask>(F.lds, F.tid, U + (size_t)(b * 4096) * UP + 2048 + g * 128, UP, VT + (size_t)((b * 2 + g) * 128) * 4096, 4096, qt > 8 ? qt - 8 : 0, qt,
                               U + (size_t)tok * UP + UC_Q + (g * 4 + r) * 128, 0.08838834764831845f * LOG2E, cosA + sq * 64, sinA + sq * 64, mf, m, l, ot);
        l = fa::xhalf_sum(l); const float sc = sigmf(SM[(size_t)tok * 64 + (g * 4 + r) * 3 + 2]) / l; bf16* op = OA + (size_t)tok * 1024 + (g * 4 + r) * 128;
#pragma unroll
        for (int db = 0; db < 4; ++db)
#pragma unroll
            for (int q = 0; q < 4; ++q) { v2u w; w.x = fa::cvtpk(ot[db][4 * q] * sc, ot[db][4 * q + 1] * sc); w.y = fa::cvtpk(ot[db][4 * q + 2] * sc, ot[db][4 * q + 3] * sc); *(v2u*)(op + 32 * db + 8 * q + 4 * h) = w; } }
}
__device__ __forceinline__ void ph_slc_mfma(const Frame& F0, const Args& a, bf16* OA) {
    const Frame F = refr(F0);
    unsigned char* ws = wsp(a); const bf16* U = (const bf16*)(ws + WS_U); const float* SM = (const float*)(ws + WS_SM); const bf16* VT = (const bf16*)(ws + WS_VTS); const float* cosA = (const float*)(ws + WS_TAB); const float* sinA = cosA + 4096 * 64;
    const unsigned long long* SEL = (const unsigned long long*)(ws + WS_SEL);
    const int r32 = F.lane & 31, h = F.lane >> 5, r = F.wave >> 1, toff = (F.wave & 1) * 32 + r32; constexpr int NU = HBN * 2 * 64;
    for (int i = 0;; ++i) { int bg, qt; if (!unit_map(F, i, 64, true, bg, qt)) break; const int b = bg >> 1, g = bg & 1; const int sq = qt * 64 + toff, tok = b * 4096 + sq;
        const unsigned long long mk = SEL[(size_t)(b * 2 + g) * 4096 + sq];
        float m = -1e30f, l = 0.f; fa::f32x16 ot[4];
#pragma unroll
        for (int db = 0; db < 4; ++db)
#pragma unroll
            for (int i2 = 0; i2 < 16; ++i2) ot[db][i2] = 0.f;
        const SlcMask mf{sq, qt * 64 + (F.wave & 1) * 32, (unsigned)mk, (unsigned)(mk >> 32)};
        fa_unit<128, SlcMask>(F.lds, F.tid, U + (size_t)(b * 4096) * UP + 1536 + g * 128, UP, VT + (size_t)((b * 2 + g) * 128) * 4096, 4096, 0, qt,
                              U + (size_t)tok * UP + UC_Q + (g * 4 + r) * 128, 0.08838834764831845f * LOG2E, cosA + sq * 64, sinA + sq * 64, mf, m, l, ot);
        l = fa::xhalf_sum(l); const float sc = sigmf(SM[(size_t)tok * 64 + (g * 4 + r) * 3 + 1]) / l; bf16* op = OA + (size_t)tok * 1024 + (g * 4 + r) * 128;
#pragma unroll
        for (int db = 0; db < 4; ++db)
#pragma unroll
            for (int q = 0; q < 4; ++q) { v2u* p = (v2u*)(op + 32 * db + 8 * q + 4 * h); const v2u o = *p; v2u w;
                w.x = fa::cvtpk(blo(o.x) + ot[db][4 * q] * sc, bhi(o.x) + ot[db][4 * q + 1] * sc); w.y = fa::cvtpk(blo(o.y) + ot[db][4 * q + 2] * sc, bhi(o.y) + ot[db][4 * q + 3] * sc); *p = w; } }
}
__device__ __forceinline__ void ph_swa_mfma(const Frame& F0, const Args& a, int ly) {
    const Frame F = refr(F0);
    unsigned char* ws = wsp(a); const bf16* U = (const bf16*)(ws + WS_U); bf16* OC = (bf16*)(ws + WS_OC); const bf16* VT = (const bf16*)(ws + WS_VTC); const float* cosC = (const float*)(ws + WS_TAB) + 2 * 4096 * 64; const float* sinC = cosC + 4096 * 32;
    const int r32 = F.lane & 31, h = F.lane >> 5, r = F.wave;
    for (int ui = 0;; ++ui) { int bg, qt; if (!unit_map(F, ui, 128, false, bg, qt)) break; const int b = bg >> 1, g = bg & 1; const int sq = qt * 32 + r32, tok = b * 4096 + sq;
        float m = inp(a, 14)[ly * 16 + g * 8 + r] * LOG2E, l = h == 0 ? 1.f : 0.f; fa::f32x16 ot[2];
#pragma unroll
        for (int db = 0; db < 2; ++db)
#pragma unroll
            for (int i = 0; i < 16; ++i) ot[db][i] = 0.f;
        const BandMask mf{sq, qt * 32, 128}; const int jt1 = qt >> 1;
        fa_unit<64, BandMask>(F.lds, F.tid, U + (size_t)(b * 4096) * UP + UC_SKV + g * 64, UP, VT + (size_t)((b * 2 + g) * 64) * 4096, 4096, jt1 > 2 ? jt1 - 2 : 0, jt1,
                              U + (size_t)tok * UP + UC_SQ + (g * 8 + r) * 64, 0.125f * LOG2E, cosC + sq * 32, sinC + sq * 32, mf, m, l, ot);
        l = fa::xhalf_sum(l); const float sc = 1.0f / l; bf16* op = OC + (size_t)tok * 1024 + (g * 8 + r) * 64;
#pragma unroll
        for (int db = 0; db < 2; ++db)
#pragma unroll
            for (int q = 0; q < 4; ++q) { v2u w; w.x = fa::cvtpk(ot[db][4 * q] * sc, ot[db][4 * q + 1] * sc); w.y = fa::cvtpk(ot[db][4 * q + 2] * sc, ot[db][4 * q + 3] * sc); *(v2u*)(op + 32 * db + 8 * q + 4 * h) = w; } }
}
__device__ __forceinline__ void ph_cmp_mfma(const Frame& F0, const Args& a) {
    const Frame F = refr(F0);
    unsigned char* ws = wsp(a); const bf16* U = (const bf16*)(ws + WS_U); bf16* OA = (bf16*)(ws + WS_OA); const float* SM = (const float*)(ws + WS_SM);
    const bf16* KC = (const bf16*)(ws + WS_KC); const bf16* VCT = (const bf16*)(ws + WS_VCT); unsigned long long* SEL = (unsigned long long*)(ws + WS_SEL);
    const int lane = F.lane, r32 = lane & 31, h = lane >> 5, r = r32 & 3, tl = F.wave * 8 + (r32 >> 2);
    constexpr int BUF = fa::Geo<128>::BUF; constexpr int PP = 257;
    LAS float* psum = (LAS float*)(F.lds + 40960) + F.wave * 8 * PP;
    for (int ui = 0;; ++ui) { int bg, qt; if (!unit_map(F, ui, 64, true, bg, qt)) break; const int b = bg >> 1, g = bg & 1; const int sq = qt * 64 + tl, tok = b * 4096 + sq;
        const int nvis = sq >= 31 ? ((sq - 31) >> 4) + 1 : 0; const int nvmax = ((qt * 64 + 63 - 31) >> 4) + 1, jt1 = (nvmax - 1) >> 6;
        const int nvw = (qt * 64 + F.wave * 8 + 7 >= 31) ? ((qt * 64 + F.wave * 8 + 7 - 31) >> 4) + 1 : 0;
        const bf16* Kb = KC + (size_t)((b * 2 + g) * 256) * 128; const bf16* VTb = VCT + (size_t)((b * 2 + g) * 128) * 256;
        fa::bf16x8 qf[8]; fa::load_qf<128>(U + (size_t)tok * UP + UC_Q + (g * 4 + r) * 128, h, 0.08838834764831845f * LOG2E, qf);
        for (int i = lane; i < 8 * PP; i += 64) psum[i] = 0.f;
        float m = -1e30f, l = 0.f;
        fa::Stage<128> st; fa::tile_load<128>(st, Kb, 128, VTb, 256, 0, F.tid);
        for (int j = 0; j <= jt1; ++j) {
            __syncthreads(); fa::tile_store<128>(st, F.lds, F.tid); __syncthreads();
            fa::tile_load<128>(st, Kb, 128, VTb, 256, (j < jt1 ? j + 1 : 0) * 64, F.tid);
            if (64 * j < nvw) { fa::f32x16 s0, s1; fa::qk_tile<128>(F.lds, qf, r32, h, s0, s1); float mx = -1e30f;
#pragma unroll
                for (int i = 0; i < 16; ++i) { if (64 * j + fa::crow(i, h) >= nvis) s0[i] = -3e38f; if (64 * j + 32 + fa::crow(i, h) >= nvis) s1[i] = -3e38f; mx = fmaxf(mx, fmaxf(s0[i], s1[i])); }
                mx = fa::xhalf_max(mx); const float mn = fmaxf(m, mx); float sum = 0.f;
#pragma unroll
                for (int i = 0; i < 16; ++i) { sum += __builtin_amdgcn_exp2f(s0[i] - mn) + __builtin_amdgcn_exp2f(s1[i] - mn); }
                l = l * __builtin_amdgcn_exp2f(m - mn) + sum; m = mn; } }
        l = fa::xhalf_sum(l); const float linv = l > 0.f ? 1.0f / l : 0.f;
        fa::f32x16 ot[4];
#pragma unroll
        for (int db = 0; db < 4; ++db)
#pragma unroll
            for (int i = 0; i < 16; ++i) ot[db][i] = 0.f;
        for (int j = 0; j <= jt1; ++j) {
            __syncthreads(); fa::tile_store<128>(st, F.lds, F.tid); __syncthreads();
            if (j < jt1) fa::tile_load<128>(st, Kb, 128, VTb, 256, (j + 1) * 64, F.tid);
            if (64 * j < nvw) { fa::f32x16 s0, s1; fa::qk_tile<128>(F.lds, qf, r32, h, s0, s1);
#pragma unroll
                for (int i = 0; i < 16; ++i) { const int n0 = 64 * j + fa::crow(i, h), n1 = n0 + 32;
                    const float p0 = n0 < nvis ? __builtin_amdgcn_exp2f(s0[i] - m) * linv : 0.f, p1 = n1 < nvis ? __builtin_amdgcn_exp2f(s1[i] - m) * linv : 0.f; s0[i] = p0; s1[i] = p1;
                    const float t0 = fa::quad_sum(p0), t1 = fa::quad_sum(p1);
                    if (r == 0) { psum[(r32 >> 2) * PP + n0] = t0; psum[(r32 >> 2) * PP + n1] = t1; } }
                fa::bf16x8 pf[2][2]; fa::pack_p(s0, pf[0]); fa::pack_p(s1, pf[1]);
                fa::pv_tile<128>(F.lds, pf, r32, h, ot); } }
        { const float sc = sigmf(SM[(size_t)tok * 64 + (g * 4 + r) * 3 + 0]); bf16* op = OA + (size_t)tok * 1024 + (g * 4 + r) * 128;
#pragma unroll
          for (int db = 0; db < 4; ++db)
#pragma unroll
            for (int q = 0; q < 4; ++q) { v2u* p = (v2u*)(op + 32 * db + 8 * q + 4 * h); const v2u o = *p; v2u w;
                w.x = fa::cvtpk(blo(o.x) + ot[db][4 * q] * sc, bhi(o.x) + ot[db][4 * q + 1] * sc); w.y = fa::cvtpk(blo(o.y) + ot[db][4 * q + 2] * sc, bhi(o.y) + ot[db][4 * q + 3] * sc); *p = w; } }
        LDS_WAIT();
        for (int t = 0; t < 8; ++t) { const int s = qt * 64 + F.wave * 8 + t, qb = s >> 6; float imp = 0.f; const int n0 = 4 * lane - 1;
#pragma unroll
            for (int k = 0; k < 5; ++k) { const int n = n0 + k; if (n >= 0 && n <= 254) imp += psum[t * PP + n]; }
            unsigned long long mask;
            if (qb <= 15) mask = (2ull << qb) - 1ull;
            else { const bool cand = lane >= 1 && lane <= qb - 2; const float v = cand ? imp : -1.f; int rank = 0;
                for (int jj = 0; jj < 64; ++jj) { const float vj = __shfl(v, jj); rank += (vj > v || (vj == v && jj < lane)) ? 1 : 0; }
                mask = __ballot(cand && rank < 13) | 1ull | (1ull << qb) | (1ull << (qb - 1)); }
            if (lane == 0) SEL[(size_t)(b * 2 + g) * 4096 + s] = mask; }
        LDS_WAIT();
        __syncthreads();
    }
}


namespace ssd {
constexpr int TP = 136;
constexpr int TILE128 = 128 * TP * 2;
constexpr int XT_BYTES = 64 * TP * 2;
__device__ __forceinline__ void stage_rows(LAS unsigned char* dst, const bf16* src  , int tid) {
#pragma unroll
    for (int i = 0; i < 4; ++i) { const int c = tid + i * 512, row = c >> 4, c8 = c & 15; *(LAS v4u*)(dst + (row * TP + c8 * 8) * 2) = *(const v4u*)(src + (size_t)row * 1536 + c8 * 8); }
}
__device__ __forceinline__ void stage_rows_T(LAS unsigned char* dst, const bf16* src, int tid) {
#pragma unroll
    for (int i = 0; i < 4; ++i) { const int c = tid + i * 512, row = c & 127, c8 = c >> 7; const v4u w = *(const v4u*)(src + (size_t)row * 1536 + c8 * 8); LAS bf16* d = (LAS bf16*)dst + (c8 * 8) * TP + sw16(row);
        d[0] = (bf16)(w.x & 0xffffu); d[TP] = (bf16)(w.x >> 16); d[2 * TP] = (bf16)(w.y & 0xffffu); d[3 * TP] = (bf16)(w.y >> 16); d[4 * TP] = (bf16)(w.z & 0xffffu); d[5 * TP] = (bf16)(w.z >> 16); d[6 * TP] = (bf16)(w.w & 0xffffu); d[7 * TP] = (bf16)(w.w >> 16); }
}
__device__ __forceinline__ void xT_load(v4u (&r)[8], const bf16* src  , int t) {
#pragma unroll
    for (int i = 0; i < 8; ++i) r[i] = *(const v4u*)(src + (size_t)t * 1536 + i * 8);
}
__device__ __forceinline__ void xT_store(LAS unsigned char* dst, const v4u (&r)[8], int t) {
    LAS bf16* d = (LAS bf16*)dst + sw16(t);
#pragma unroll
    for (int i = 0; i < 8; ++i) { const v4u w = r[i]; LAS bf16* dd = d + (i * 8) * TP;
        dd[0] = (bf16)(w.x & 0xffffu); dd[TP] = (bf16)(w.x >> 16); dd[2 * TP] = (bf16)(w.y & 0xffffu); dd[3 * TP] = (bf16)(w.y >> 16); dd[4 * TP] = (bf16)(w.z & 0xffffu); dd[5 * TP] = (bf16)(w.z >> 16); dd[6 * TP] = (bf16)(w.w & 0xffffu); dd[7 * TP] = (bf16)(w.w >> 16); }
}
}

__device__ __forceinline__ void ph_states_mfma(const Frame& F0, const Args& a) {
    const Frame F = refr(F0);
    unsigned char* ws = wsp(a); const bf16* XC = (const bf16*)(ws + WS_XC); const float* DTV = (const float*)(ws + WS_DTV); const float* ACS = (const float*)(ws + WS_ACS); float* ST = (float*)(ws + WS_ST);
    const int lane = F.lane, r32 = lane & 31, h2 = lane >> 5, hq = F.wave >> 1, nh = F.wave & 1;
    LAS unsigned char* BT = F.lds; LAS unsigned char* XT = F.lds + ssd::TILE128; LAS float* WL = (LAS float*)(F.lds + ssd::TILE128 + 4 * ssd::XT_BYTES);
    for (int it = F.vcu; it < HBN * 32 * 2; it += F.G) { const int g = it & 1, bc = it >> 1; const size_t tok0 = (size_t)bc * 128;
        __syncthreads();
        v4u xr[8]; ssd::xT_load(xr, XC + tok0 * 1536 + (g * 8 + hq) * 64, nh * 64 + lane);
        ssd::stage_rows_T(BT, XC + tok0 * 1536 + 1024 + g * 128, F.tid);
#pragma unroll
        for (int i2 = 0; i2 < 2; ++i2) { const int i = F.tid + i2 * 512; const int hh = i >> 7, l = i & 127, h = g * 8 + hh; WL[hh * 128 + sw16(l)] = __expf(ACS[(tok0 + 127) * 16 + h] - ACS[(tok0 + l) * 16 + h]) * DTV[(tok0 + l) * 16 + h]; }
#pragma unroll 1
        for (int sub = 0; sub < 2; ++sub) { const int hh = sub * 4 + hq, h = g * 8 + hh;
            if (sub) __syncthreads();
            ssd::xT_store(XT + hq * ssd::XT_BYTES, xr, nh * 64 + lane);
            if (sub == 0) ssd::xT_load(xr, XC + tok0 * 1536 + (g * 8 + 4 + hq) * 64, nh * 64 + lane);
            __syncthreads();
            fa::f32x16 acc[2][2];
#pragma unroll
            for (int nb = 0; nb < 2; ++nb)
#pragma unroll
                for (int pb = 0; pb < 2; ++pb)
#pragma unroll
                    for (int i = 0; i < 16; ++i) acc[nb][pb][i] = 0.f;
            const LAS unsigned char* xt = XT + hq * ssd::XT_BYTES;
#pragma unroll 2
            for (int ks = 0; ks < 8; ++ks) { const int l0 = 16 * ks + 8 * h2; const f32x4 w0 = *(const LAS f32x4*)(WL + hh * 128 + l0), w1 = *(const LAS f32x4*)(WL + hh * 128 + l0 + 4);
                fa::bf16x8 A[2], B[2];
#pragma unroll
                for (int pb = 0; pb < 2; ++pb) { const v4u x = *(const LAS v4u*)(xt + ((32 * pb + r32) * ssd::TP + l0) * 2); v4u o;
                    o.x = fa::cvtpk(blo(x.x) * w0.x, bhi(x.x) * w0.y); o.y = fa::cvtpk(blo(x.y) * w0.z, bhi(x.y) * w0.w); o.z = fa::cvtpk(blo(x.z) * w1.x, bhi(x.z) * w1.y); o.w = fa::cvtpk(blo(x.w) * w1.z, bhi(x.w) * w1.w); A[pb] = __builtin_bit_cast(fa::bf16x8, o); }
#pragma unroll
                for (int nb = 0; nb < 2; ++nb) B[nb] = *(const LAS fa::bf16x8*)(BT + ((32 * (2 * nh + nb) + r32) * ssd::TP + l0) * 2);
#pragma unroll
                for (int nb = 0; nb < 2; ++nb)
#pragma unroll
                    for (int pb = 0; pb < 2; ++pb) acc[nb][pb] = FA_MFMA(A[pb], B[nb], acc[nb][pb]); }
            float* o = ST + ((size_t)bc * 16 + h) * 8192;
#pragma unroll
            for (int nb = 0; nb < 2; ++nb)
#pragma unroll
                for (int pb = 0; pb < 2; ++pb)
#pragma unroll
                    for (int i = 0; i < 16; ++i) o[(32 * pb + fa::crow(i, h2)) * 128 + 32 * (2 * nh + nb) + r32] = acc[nb][pb][i];
        }
    }
    __syncthreads();
}
__device__ __forceinline__ void ph_scan2(const Frame& F0, const Args& a) {
    const Frame F = refr(F0);
    const float* ACS = (const float*)(wsp(a) + WS_ACS); const float* ST = (const float*)(wsp(a) + WS_ST); unsigned* HB = (unsigned*)(wsp(a) + WS_QR);
    for (int idx = F.gtid; idx < HBN * 16 * 4096; idx += F.GT) { const int np2 = idx & 4095, h = (idx >> 12) & 15, b = idx >> 16; v2f st[32]; float dec[32];
#pragma unroll
        for (int c = 0; c < 32; ++c) { st[c] = *(const v2f*)(ST + ((size_t)(b * 32 + c) * 16 + h) * 8192 + 2 * np2); dec[c] = ACS[((size_t)b * 4096 + c * 128 + 127) * 16 + h]; }
        float h0 = 0.f, h1 = 0.f;
#pragma unroll
        for (int c = 0; c < 32; ++c) { HB[((size_t)(b * 32 + c) * 16 + h) * 4096 + np2] = fa::cvtpk(h0, h1); const float d = __expf(dec[c]); h0 = h0 * d + st[c].x; h1 = h1 * d + st[c].y; } }
}
__device__ __forceinline__ void ph_ssdy_mfma(const Frame& F0, const Args& a, int ly) {
    const Frame F = refr(F0);
    unsigned char* ws = wsp(a); const bf16* XC = (const bf16*)(ws + WS_XC); const float* DTV = (const float*)(ws + WS_DTV); const float* ACS = (const float*)(ws + WS_ACS); const float* ST = (const float*)(ws + WS_ST);
    const bf16* U = (const bf16*)(ws + WS_U); bf16* YD = (bf16*)(ws + WS_YD); bf16* OB = (bf16*)(ws + WS_OB);
    const int lane = F.lane, r32 = lane & 31, h2 = lane >> 5, hq = F.wave >> 1, wl = F.wave & 1;
    LAS unsigned char* BM = F.lds; LAS unsigned char* XT = F.lds + ssd::TILE128; LAS float* AC = (LAS float*)(F.lds + ssd::TILE128 + 4 * ssd::XT_BYTES); LAS float* DT = AC + 1024; LAS float* SSQ = DT + 1024; LAS float* RINV = SSQ + 1024;
    for (int it = F.vcu; it < HBN * 32 * 2; it += F.G) { const int g = it & 1, bc = it >> 1; const size_t tok0 = (size_t)bc * 128;
        __syncthreads();
        v4u xr[8]; ssd::xT_load(xr, XC + tok0 * 1536 + (g * 8 + hq) * 64, wl * 64 + lane);
        ssd::stage_rows(BM, XC + tok0 * 1536 + 1024 + g * 128, F.tid);
#pragma unroll
        for (int i2 = 0; i2 < 2; ++i2) { const int i = F.tid + i2 * 512; const int hh = i >> 7, l = i & 127, h = g * 8 + hh; AC[i] = ACS[(tok0 + l) * 16 + h]; DT[i] = DTV[(tok0 + l) * 16 + h]; }
#pragma unroll 1
        for (int sub = 0; sub < 2; ++sub) { const int hh = sub * 4 + hq, h = g * 8 + hh;
            if (sub) __syncthreads();
            ssd::xT_store(XT + hq * ssd::XT_BYTES, xr, wl * 64 + lane);
            if (sub == 0) ssd::xT_load(xr, XC + tok0 * 1536 + (g * 8 + 4 + hq) * 64, wl * 64 + lane);
            __syncthreads();
            const LAS unsigned char* xt = XT + hq * ssd::XT_BYTES; const float dsk = inp(a, 12)[ly * 16 + h];
            fa::bf16x8 hf[2][8]; { const bf16* hin = (const bf16*)(ws + WS_QR) + ((size_t)bc * 16 + h) * 8192;
#pragma unroll
                for (int pb = 0; pb < 2; ++pb)
#pragma unroll
                    for (int ks = 0; ks < 8; ++ks) hf[pb][ks] = *(const fa::bf16x8*)(hin + (32 * pb + r32) * 128 + 16 * ks + 8 * h2); }
#pragma unroll 1
            for (int lbi = 0; lbi < 2; ++lbi) { const int lb = wl ? (lbi ? 2 : 1) : (lbi ? 3 : 0); const int l = 32 * lb + r32; const size_t tokl = tok0 + l;
                fa::bf16x8 qf[8];
#pragma unroll
                for (int ks = 0; ks < 8; ++ks) qf[ks] = *(const fa::bf16x8*)(XC + tokl * 1536 + 1280 + g * 128 + 16 * ks + 8 * h2);
                const float acsl = AC[hh * 128 + l];
                fa::f32x16 yT[2];
#pragma unroll
                for (int pb = 0; pb < 2; ++pb) {
#pragma unroll
                    for (int i = 0; i < 16; ++i) yT[pb][i] = 0.f;
#pragma unroll
                    for (int ks = 0; ks < 8; ++ks) yT[pb] = FA_MFMA(hf[pb][ks], qf[ks], yT[pb]);
                    const float e = __expf(acsl);
#pragma unroll
                    for (int i = 0; i < 16; ++i) yT[pb][i] *= e; }
                for (int sb = 0; sb <= lb; ++sb) { fa::f32x16 sT;
#pragma unroll
                    for (int i = 0; i < 16; ++i) sT[i] = 0.f;
#pragma unroll
                    for (int ks = 0; ks < 8; ++ks) { const fa::bf16x8 af = *(const LAS fa::bf16x8*)(BM + ((32 * sb + r32) * ssd::TP + 16 * ks + 8 * h2) * 2); sT = FA_MFMA(af, qf[ks], sT); }
#pragma unroll
                    for (int i = 0; i < 16; ++i) { const int sl = fa::crow(i, h2), s = 32 * sb + sl; const bool ok = sb < lb || sl <= r32; const float f = ok ? __expf(acsl - AC[hh * 128 + s]) * DT[hh * 128 + s] : 0.f; sT[i] = ok ? sT[i] * f : 0.f; }
                    fa::bf16x8 pf[2]; fa::pack_p(sT, pf);
#pragma unroll
                    for (int pb = 0; pb < 2; ++pb)
#pragma unroll
                        for (int st = 0; st < 2; ++st) { const fa::bf16x8 af = *(const LAS fa::bf16x8*)(xt + ((32 * pb + r32) * ssd::TP + 32 * sb + 16 * st + 8 * h2) * 2); yT[pb] = FA_MFMA(af, pf[st], yT[pb]); } }
                float ss = 0.f;
#pragma unroll
                for (int pb = 0; pb < 2; ++pb)
#pragma unroll
                    for (int q = 0; q < 4; ++q) { const int p = 32 * pb + 8 * q + 4 * h2; const v2u xv = *(const v2u*)(XC + tokl * 1536 + h * 64 + p), zv = *(const v2u*)(U + tokl * UP + UC_Z + h * 64 + p);
                        const float xs[4] = {blo(xv.x), bhi(xv.x), blo(xv.y), bhi(xv.y)}, zs[4] = {blo(zv.x), bhi(zv.x), blo(zv.y), bhi(zv.y)}; f32x4 y;
#pragma unroll
                        for (int e = 0; e < 4; ++e) { float v = yT[pb][4 * q + e] + xs[e] * dsk; v *= zs[e] * sigmf(zs[e]); y[e] = v; ss += v * v; }
                        v2u yw; yw.x = fa::cvtpk(y.x, y.y); yw.y = fa::cvtpk(y.z, y.w); *(v2u*)(YD + tokl * 1024 + h * 64 + p) = yw; }
                ss += __shfl_xor(ss, 32);
                if (h2 == 0) SSQ[hh * 128 + l] = ss;
            }
        }
        __syncthreads();
        if (F.tid < 128) { float s = 0.f;
#pragma unroll
            for (int hh = 0; hh < 8; ++hh) s += SSQ[hh * 128 + F.tid];
            RINV[F.tid] = 1.0f / sqrtf(s * (1.f / 512.f) + NORM_EPS); }
        __syncthreads();
        const float* nw = inp(a, 13) + (size_t)ly * 1024 + g * 512;
#pragma unroll 8
        for (int gi = F.tid; gi < 8192; gi += 512) { const int tl = gi >> 6, c8 = (gi & 63) * 8; const float ri = RINV[tl]; const v4u yv = *(const v4u*)(YD + (tok0 + tl) * 1024 + g * 512 + c8);
            const f32x4 y0 = {blo(yv.x), bhi(yv.x), blo(yv.y), bhi(yv.y)}, y1 = {blo(yv.z), bhi(yv.z), blo(yv.w), bhi(yv.w)}, n0 = *(const f32x4*)(nw + c8), n1 = *(const f32x4*)(nw + c8 + 4);
            v4u o; o.x = fa::cvtpk(y0.x * ri * n0.x, y0.y * ri * n0.y); o.y = fa::cvtpk(y0.z * ri * n0.z, y0.w * ri * n0.w); o.z = fa::cvtpk(y1.x * ri * n1.x, y1.y * ri * n1.y); o.w = fa::cvtpk(y1.z * ri * n1.z, y1.w * ri * n1.w);
            *(v4u*)(OB + (tok0 + tl) * 1024 + g * 512 + c8) = o; }
    }
    __syncthreads();
}

__device__ __forceinline__ void ph_route_mfma(const Frame& F0, const Args& a, int ly) {
    const Frame F = refr(F0);
    unsigned char* ws = wsp(a); unsigned* ROUTE = (unsigned*)(ws + WS_ROUTE); const bf16* WRh = (const bf16*)(ws + WS_WR); const bf16* WRl = WRh + 64 * 2048;
    int* ELT = (int*)(ws + WS_ELT); float* EWR = (float*)(ws + WS_EWR); const bf16* XB = (const bf16*)(ws + WS_XB);
    const float* gbias = inp(a, 20) + ly * 4; const float* ebias = inp(a, 22) + ly * 32; gu32* cnt = F.ctl + CW_ECNT + ly * 32 * 64;
    const int lane = F.lane, r32 = lane & 31, h = lane >> 5, kh = F.wave & 1, tq = F.wave >> 1; LAS float* LG = (LAS float*)(F.lds + tq * 8704);
    for (int it = F.vcu; it < T / 128; it += F.G) { const int tk = it * 128 + tq * 32 + r32; const bf16* xr = XB + (size_t)tk * D + kh * 1024 + 8 * h;
        fa::f32x16 acc[2];
#pragma unroll
        for (int cb = 0; cb < 2; ++cb)
#pragma unroll
            for (int i = 0; i < 16; ++i) acc[cb][i] = 0.f;
        float ss = 0.f;
#pragma unroll 4
        for (int ks = 0; ks < 64; ++ks) { const v4u hi = *(const v4u*)(xr + 16 * ks);
            { const float e0 = blo(hi.x), e1 = bhi(hi.x), e2 = blo(hi.y), e3 = bhi(hi.y), e4 = blo(hi.z), e5 = bhi(hi.z), e6 = blo(hi.w), e7 = bhi(hi.w); ss += (e0 * e0 + e1 * e1) + (e2 * e2 + e3 * e3) + (e4 * e4 + e5 * e5) + (e6 * e6 + e7 * e7); }
            const fa::bf16x8 xh = __builtin_bit_cast(fa::bf16x8, hi);
#pragma unroll
            for (int cb = 0; cb < 2; ++cb) { const size_t wo = (size_t)(32 * cb + r32) * 2048 + kh * 1024 + 16 * ks + 8 * h; const fa::bf16x8 wh = *(const fa::bf16x8*)(WRh + wo), wl = *(const fa::bf16x8*)(WRl + wo);
                acc[cb] = FA_MFMA(wh, xh, acc[cb]); acc[cb] = FA_MFMA(wl, xh, acc[cb]); } }
        ss += __shfl_xor(ss, 32);
        __syncthreads();
        if (kh == 1) {
#pragma unroll
            for (int cb = 0; cb < 2; ++cb)
#pragma unroll
                for (int i = 0; i < 16; ++i) LG[r32 * 68 + 32 * cb + fa::crow(i, h)] = acc[cb][i];
            if (h == 0) LG[r32 * 68 + 64] = ss; }
        __syncthreads();
        if (kh == 0) { ss += LG[r32 * 68 + 64]; const float rinv = 1.0f / sqrtf(ss * (1.f / D) + NORM_EPS);
#pragma unroll
            for (int cb = 0; cb < 2; ++cb)
#pragma unroll
                for (int i = 0; i < 16; ++i) { const int o = r32 * 68 + 32 * cb + fa::crow(i, h); LG[o] = (LG[o] + acc[cb][i]) * rinv; }
            LDS_WAIT();
            if (h == 0) { const LAS float* lg = LG + r32 * 68;
                float gl[4];
#pragma unroll
                for (int i = 0; i < 4; ++i) gl[i] = lg[i] + gbias[i];
                int gi = 0; float gm = gl[0];
#pragma unroll
                for (int i = 1; i < 4; ++i) if (gl[i] > gm) { gm = gl[i]; gi = i; }
                float gs = 0.f;
#pragma unroll
                for (int i = 0; i < 4; ++i) gs += __expf(gl[i] - gm);
                const float gwt = 1.0f / gs;
                float el[8];
#pragma unroll
                for (int e = 0; e < 8; ++e) el[e] = lg[4 + gi * 8 + e] + ebias[gi * 8 + e];
                int i1 = 0; float v1 = el[0];
#pragma unroll
                for (int e = 1; e < 8; ++e) if (el[e] > v1) { v1 = el[e]; i1 = e; }
                int i2 = -1; float v2 = -3.0e38f;
#pragma unroll
                for (int e = 0; e < 8; ++e) if (e != i1 && el[e] > v2) { v2 = el[e]; i2 = e; }
                const float ex = __expf(v2 - v1); const float w1 = 1.0f / (1.0f + ex), w2 = ex * w1;
                const int e0 = gi * 8 + i1, e1 = gi * 8 + i2;
                const unsigned p0 = __hip_atomic_fetch_add(cnt + e0 * 64, 1u, RLX_AGENT), p1 = __hip_atomic_fetch_add(cnt + e1 * 64, 1u, RLX_AGENT);
                v4u r0, r1; r0.x = (unsigned)e0; r0.y = (unsigned)e1; r0.z = p0; r0.w = p1; r1.x = __float_as_uint(gwt * w1); r1.y = __float_as_uint(gwt * w2); r1.z = __float_as_uint(rinv); r1.w = 0u;
                *(v4u*)(ROUTE + (size_t)tk * 8) = r0; *(v4u*)(ROUTE + (size_t)tk * 8 + 4) = r1;
                ELT[(size_t)e0 * T + p0] = tk; ELT[(size_t)e1 * T + p1] = tk; *(v2f*)(EWR + ((size_t)e0 * T + p0) * 2) = (v2f){gwt * w1, rinv}; *(v2f*)(EWR + ((size_t)e1 * T + p1) * 2) = (v2f){gwt * w2, rinv}; } }
    }
    __syncthreads();
}

__device__ __forceinline__ void ph_cmp2_mfma(const Frame& F0, const Args& a) {
    const Frame F = refr(F0);
    unsigned char* ws = wsp(a); const float* HP = (const float*)(ws + WS_CBG); const float* B1 = (const float*)(ws + WS_B1P); const bf16* W2T = (const bf16*)(ws + WS_W2T); bf16* KC = (bf16*)(ws + WS_KC); bf16* VCT = (bf16*)(ws + WS_VCT);
    const int lane = F.lane, r32 = lane & 31, h = lane >> 5;
    for (int it = F.gw; it < 128; it += F.NGW) { const int c = it >> 6, row = (it & 63) * 32 + r32;
        fa::f32x16 acc[4];
#pragma unroll
        for (int db = 0; db < 4; ++db)
#pragma unroll
            for (int i = 0; i < 16; ++i) acc[db][i] = 0.f;
#pragma unroll 8
        for (int ks = 0; ks < 16; ++ks) { const int i0 = 16 * ks + 8 * h; f32x4 v0 = *(const f32x4*)(B1 + c * 256 + i0), v1 = *(const f32x4*)(B1 + c * 256 + i0 + 4);
#pragma unroll
            for (int kq = 0; kq < 4; ++kq) { const float* p = HP + ((size_t)(c * 4 + kq) * 2048 + row) * 256 + i0; v0 = v0 + *(const f32x4*)p; v1 = v1 + *(const f32x4*)(p + 4); }
            v4u o; o.x = fa::cvtpk(v0.x * sigmf(v0.x), v0.y * sigmf(v0.y)); o.y = fa::cvtpk(v0.z * sigmf(v0.z), v0.w * sigmf(v0.w)); o.z = fa::cvtpk(v1.x * sigmf(v1.x), v1.y * sigmf(v1.y)); o.w = fa::cvtpk(v1.z * sigmf(v1.z), v1.w * sigmf(v1.w));
            const fa::bf16x8 bfr = __builtin_bit_cast(fa::bf16x8, o);
#pragma unroll
            for (int db = 0; db < 4; ++db) { const fa::bf16x8 af = *(const fa::bf16x8*)(W2T + ((size_t)(c * 128 + 32 * db + r32)) * 256 + i0); acc[db] = FA_MFMA(af, bfr, acc[db]); } }
#pragma unroll
        for (int db = 0; db < 4; ++db)
#pragma unroll
            for (int q = 0; q < 4; ++q) { const int d = 32 * db + 8 * q + 4 * h; v2u w; w.x = fa::cvtpk(acc[db][4 * q], acc[db][4 * q + 1]); w.y = fa::cvtpk(acc[db][4 * q + 2], acc[db][4 * q + 3]);
                *(v2u*)(KC + (size_t)(c * 2048 + row) * 128 + d) = w;
                if (c == 1) { bf16* vp = VCT + ((size_t)(row >> 8) * 128 + d) * 256 + sw16(row & 255); vp[0] = (bf16)(w.x & 0xffffu); vp[256] = (bf16)(w.x >> 16); vp[512] = (bf16)(w.y & 0xffffu); vp[768] = (bf16)(w.y >> 16); } }
    }
}


#ifndef EN_W
#define EN_W 1
#endif
#ifndef EN_A
#define EN_A 1
#endif
#ifndef EN_B
#define EN_B 1
#endif
#ifndef EN_C
#define EN_C 1
#endif
#ifndef EN_D
#define EN_D 1
#endif
#ifndef EN_E
#define EN_E 1
#endif
#ifndef EN_F
#define EN_F 1
#endif
#ifndef EN_G
#define EN_G 1
#endif
#ifndef EN_H
#define EN_H 1
#endif
#ifndef EN_I
#define EN_I 1
#endif
#ifndef EN_J
#define EN_J 1
#endif
#ifndef EN_K
#define EN_K 1
#endif
#ifndef EN_L
#define EN_L 1
#endif
#ifndef EN_M
#define EN_M 1
#endif
__global__ void __launch_bounds__(NWAVES * 64, 2) mk_fwd(Args a) {
    extern __shared__ __attribute__((aligned(16))) unsigned char lds_raw[];
    Frame F;
    F.lds = (LAS unsigned char*)lds_raw;
    F.MISC = (volatile LAS unsigned*)(F.lds + MISC_OFF);
    F.tid = threadIdx.x; F.lane = F.tid & 63; F.wave = __builtin_amdgcn_readfirstlane(F.tid >> 6);
    F.G = gridDim.x; { const int bx = blockIdx.x; F.vcu = (F.G % 8 == 0) ? (bx % 8) * (F.G / 8) + bx / 8 : bx; }
    F.gtid = F.vcu * (NWAVES * 64) + F.tid; F.GT = F.G * NWAVES * 64; F.gw = F.vcu * NWAVES + F.wave; F.NGW = F.G * NWAVES;
    F.ctl = (gu32*)(a.ws + WS_CTL);
    for (int u = F.tid; u < (LDS_BYTES - LDSCTL_OFF) / 4; u += NWAVES * 64) ((LAS unsigned*)(F.lds + LDSCTL_OFF))[u] = 0u;
    __syncthreads();
    const int lo = a.lo, hi = a.hi;
    XcdBarrier bar; bar.bar = (unsigned*)(F.ctl + CW_BAR); bar.x = 0; bar.st = nullptr;
    if (hi - lo > 1) bar = xcd_barrier_post((unsigned*)(F.ctl + CW_BAR), F.MISC + 8);
#define RUN(s) (lo <= (s) && (s) < hi)
#define SEAM(s) do { if (RUN(s) && RUN((s) + 1)) xcd_barrier(bar); else __syncthreads(); } while (0)
    int step = 0;
#pragma unroll 1
    for (int ly = 0; ly < 2; ++ly) {
        if (EN_W && RUN(step)) { phW(F, a, ly); phA(F, a, ly); }
        SEAM(step); ++step;
#pragma unroll 1
        for (int hb = 0; hb < 2; ++hb) {
            if (EN_B && RUN(step)) { unsigned char* ws = wsp(a); if (hb == 0) ph_bias(F, a, ly);
              {
                {
                  pg8::Gemm g{(const bf16*)(ws + WS_HN8 + (size_t)hb * TH * D), (const bf16*)(ws + WS_WG8), TH, NF8, D / 2, D / 2, D / 2}; pg8::UnevenOrder S; S.init(TH, NF8, F.G, (int)blockIdx.x);
                  if (F.G == 256) { S.kHi = 8; S.kLo = 6; } else { S.kHi = S.kLo = (1792 + F.G - 1) / F.G + 1; }
                  pg8::EpiGate E{(unsigned char*)(ws + WS_GT), TH / 256, 1.0f / 1024.0f, (bf16*)(ws + WS_U) + UC_Z, UP};
                  pg8::gemm_phase<pg8::EpiGate, pg8::UnevenOrder, true, true>(F.lds + RING_OFF, g, S, E); }
                { pg8::Gemm g{(const bf16*)(ws + (hb ? WS_HN1 : WS_HN)), (const bf16*)(ws + WS_WIN), TH, NIN1, D, D, D}; pg8::SkipOrder S; S.init(TH, NIN1 - 1024, F.G, (int)blockIdx.x);
                  pg8::EpiIn E{(bf16*)(ws + WS_U), UP, (bf16*)(ws + WS_KVC), KVC_CSTRIDE, (float*)(ws + WS_SM), (bf16*)(ws + WS_VTS), (bf16*)(ws + WS_VTW), (bf16*)(ws + WS_VTC)};
                  pg8::gemm_phase<pg8::EpiIn, pg8::SkipOrder, true>(F.lds + RING_OFF, g, S, E); }
#ifdef REP_B
                { pg8::Gemm g{(const bf16*)(ws + (hb ? WS_HN1 : WS_HN)), (const bf16*)(ws + WS_WIN), TH, NIN1, D, D, D}; pg8::ProbeOrder S; S.init(TH, NIN1, F.G, (int)blockIdx.x); S.mm = REP_MM; S.mn = REP_MN;
                  pg8::EpiSink E{(float*)(ws + WS_CBG)};
                  pg8::gemm_phase<pg8::EpiSink, pg8::ProbeOrder, true>(F.lds + RING_OFF, g, S, E); }
#endif
              }
            }
            SEAM(step); ++step;
            if (EN_C && RUN(step)) { unsigned char* ws = wsp(a);
                const bool split = F.G > 128;
                if (!split || F.vcu >= 64) phC_elem(F, a, ly, split);
                if (!split || F.vcu < 64) {
#pragma unroll 1
                    for (int cq = 0; cq < 8; ++cq) { const int c = cq >> 2, kq = cq & 3;
                        pg8::Gemm g{(const bf16*)(ws + WS_KVC) + (size_t)c * KVC_CSTRIDE + kq * 1024, (const bf16*)(ws + WS_W1) + (size_t)c * 256 * 4096 + kq * 1024, 2048, 256, 1024, 2048, 4096};
                        pg8::PlainOrder S; S.init(2048, 256, F.G, split ? F.vcu - 8 * cq : F.vcu);
                        pg8::EpiPart E{(float*)(ws + WS_CBG) + (size_t)cq * 2048 * 256, 256};
                        pg8::gemm_phase<pg8::EpiPart, pg8::PlainOrder, false>(F.lds + RING_OFF, g, S, E);
                    }
                }
            }
            SEAM(step); ++step;
            if (EN_D && RUN(step)) {
                ph_cmp2_mfma(F, a); ph_states_mfma(F, a); ph_swa_mfma(F, a, ly); ph_win_mfma(F, a); }
            SEAM(step); ++step;
            if (EN_E && RUN(step)) { ph_scan2(F, a); ph_cmp_mfma(F, a); }
            SEAM(step); ++step;
            if (EN_F && RUN(step)) {
                ph_ssdy_mfma(F, a, ly); ph_slc_mfma(F, a, (bf16*)(wsp(a) + WS_OA)); }
            SEAM(step); ++step;
            if (EN_G && RUN(step)) { unsigned char* ws = wsp(a);
                pg8::Gemm g{(const bf16*)(ws + WS_OA), (const bf16*)(ws + WS_PT), 3 * TH, 3 * D, 1024, 1024, 1024}; pg8::ProjOrder S; S.init(TH, D, F.G, (int)blockIdx.x);
                pg8::EpiProj E{(bf16*)(ws + (hb ? WS_HN1 : WS_HN)), D, (const unsigned char*)(ws + WS_GT), 0, TH / 256, D / 256, 0};
                pg8::gemm_phase<pg8::EpiProj, pg8::ProjOrder, true>(F.lds + RING_OFF, g, S, E);
#ifdef REP_G
                { pg8::EpiSink E2{(float*)(ws + WS_CBG)}; pg8::gemm_phase<pg8::EpiSink, pg8::ProjOrder, true>(F.lds + RING_OFF, g, S, E2); }
#endif
            }
            SEAM(step); ++step;
            if (EN_H && RUN(step)) { unsigned char* ws = wsp(a);
                pg8::Gemm g{(const bf16*)(ws + (hb ? WS_HN1 : WS_HN)), (const bf16*)(ws + WS_WOUT), TH, D, D, D, D}; pg8::StaticOrder S; S.init(TH, D, F.G, (int)blockIdx.x);
                pg8::EpiOut E{ly == 0 ? inp(a, 0) + (size_t)hb * TH * D : (const float*)nullptr, (bf16*)(ws + WS_XB) + (size_t)hb * TH * D, D};
                pg8::gemm_phase<pg8::EpiOut, pg8::StaticOrder, true>(F.lds + RING_OFF, g, S, E);
            }
            if (hb == 0) __syncthreads(); else SEAM(step);
            ++step;
        }
        if (EN_I && RUN(step)) ph_route_mfma(F, a, ly);
        SEAM(step); ++step;
        if (EN_K && RUN(step)) { unsigned char* ws = wsp(a); moe_tables(F, ly); const LAS int* tab = (const LAS int*)(F.lds + MOETAB_OFF);
            pg8::Gemm g{(const bf16*)(ws + WS_XB), (const bf16*)(ws + WS_GU), NSLOT, 32 * 1024, D, D, D}; pg8::GroupedOrder<4> S{tab, (const int*)(ws + WS_ELT), T, D * 2, F.G, F.vcu};
            pg8::EpiGU E{(bf16*)(ws + WS_HG), (const float*)(ws + WS_EWR), tab, T};
            pg8::gemm_phase<pg8::EpiGU, pg8::GroupedOrder<4>, true, false, true>(F.lds + RING_OFF, g, S, E);
        }
        SEAM(step); ++step;
        if (EN_L && RUN(step)) { unsigned char* ws = wsp(a); moe_tables(F, ly); const LAS int* tab = (const LAS int*)(F.lds + MOETAB_OFF);
            pg8::Gemm g{(const bf16*)(ws + WS_HG), (const bf16*)(ws + WS_DN), NSLOT, 32 * 2048, 512, 512, 512}; pg8::GroupedOrder<8> S{tab, nullptr, 0, 0, F.G, F.vcu};
            pg8::EpiDown E{(bf16*)(ws + WS_XG)};
            pg8::gemm_phase<pg8::EpiDown, pg8::GroupedOrder<8>, true>(F.lds + RING_OFF, g, S, E);
        }
        SEAM(step); ++step;
    }
    if (RUN(step)) phFinal(F, a);
#undef RUN
#undef SEAM
}

#ifndef MK_SINGLE
#define MK_SINGLE 1
#endif
extern "C" void kernel_launch(void* const* d_in, const int* in_sizes, int n_in, void* d_out, int out_size, void* d_ws, size_t ws_size, hipStream_t stream) {
    static int grid = 0;
    if (grid == 0) {
        if (n_in != 27 || out_size != T * D || ws_size < WS_END) { fprintf(stderr, "kernel_launch: unexpected sizes (n_in %d out %d ws %zu need %zu)\n", n_in, out_size, ws_size, (size_t)WS_END); grid = -1; return; }
        int dev = 0, cus = 0, per_cu = 0;
        if (hipGetDevice(&dev) != hipSuccess || hipDeviceGetAttribute(&cus, hipDeviceAttributeMultiprocessorCount, dev) != hipSuccess) { grid = -1; return; }
        if (hipFuncSetAttribute((const void*)mk_fwd, hipFuncAttributeMaxDynamicSharedMemorySize, LDS_BYTES) != hipSuccess) { grid = -1; return; }
        if (hipOccupancyMaxActiveBlocksPerMultiprocessor(&per_cu, (const void*)mk_fwd, NWAVES * 64, LDS_BYTES) != hipSuccess || per_cu < 1) { fprintf(stderr, "kernel_launch: occupancy query says %d\n", per_cu); }
        (void)hipGetLastError();
        grid = cus;
    }
    if (grid < 0) return;
    if (hipMemsetAsync((char*)d_ws + WS_CTL, 0, CTL_ZERO_BYTES, stream) != hipSuccess) return;
    Args a; memset(&a, 0, sizeof(a));
    for (int i = 0; i < 27; ++i) a.in[i] = (const float*)d_in[i];
    a.out = (float*)d_out; a.ws = (unsigned char*)d_ws;
#ifdef PROBE_K
    a.lo = 0; a.hi = PROBE_K;
    hipLaunchKernelGGL(mk_fwd, dim3(grid), dim3(NWAVES * 64), LDS_BYTES, stream, a);
    if (hipMemsetAsync((char*)d_ws + WS_CTL, 0, CTL_ZERO_BYTES, stream) != hipSuccess) return;
#endif
#if MK_SINGLE
    a.lo = 0; a.hi = NSTEPS;
    hipLaunchKernelGGL(mk_fwd, dim3(grid), dim3(NWAVES * 64), LDS_BYTES, stream, a);
#else
    for (int s = 0; s < NSTEPS; ++s) { a.lo = s; a.hi = s + 1; hipLaunchKernelGGL(mk_fwd, dim3(grid), dim3(NWAVES * 64), LDS_BYTES, stream, a); }
#endif
}
```
